# Optimizing an MI355X kernel written in HIP

```python
import math
import jax, jax.numpy as jnp
from jax import lax
import numpy as np

D_MODEL = 1024
BATCH = 8
SEQ = 2048
DEPTH = 2

HEAD_DIM = 64
N_A_LAYERS = DEPTH // 2
N_B_LAYERS = DEPTH - N_A_LAYERS
FOX_HEADS = D_MODEL // HEAD_DIM
SWA_Q_HEADS = D_MODEL // HEAD_DIM
SWA_KV_HEADS = SWA_Q_HEADS // 8
SWA_GROUP = SWA_Q_HEADS // SWA_KV_HEADS
WINDOW = 128
Q_BLOCK = 128
D_FF = 4 * D_MODEL
N_BUCKETS = 32
REL_MAX_DIST = 128
NORM_EPS = 1e-6

kernel_name = "yoco_fox_swa_sink_hybrid"


def _rmsnorm(x, g):
    xf = x.astype(jnp.float32)
    y = xf * lax.rsqrt(jnp.mean(xf * xf, axis=-1, keepdims=True) + NORM_EPS)
    return (y * g.astype(jnp.float32)).astype(x.dtype)


def _t5_causal_bucket(dist):
    n = np.maximum(dist, 0)
    max_exact = N_BUCKETS // 2
    large = max_exact + (np.log(np.maximum(n, 1) / max_exact)
                         / np.log(REL_MAX_DIST / max_exact)
                         * (N_BUCKETS - max_exact)).astype(np.int32)
    large = np.minimum(large, N_BUCKETS - 1)
    return np.where(n < max_exact, n, large).astype(np.int32)


def _sq_relu_mlp(h, w_up, w_down):
    u = h @ w_up
    return (jnp.square(jax.nn.relu(u))) @ w_down


def _fox_attention(h, w_in, b_f, g_q, g_k, w_out):
    bsz, seq, _ = h.shape
    hw = FOX_HEADS * HEAD_DIM
    proj = h @ w_in
    q = _rmsnorm(proj[..., :hw].reshape(bsz, seq, FOX_HEADS, HEAD_DIM), g_q)
    k = _rmsnorm(proj[..., hw:2 * hw].reshape(bsz, seq, FOX_HEADS, HEAD_DIM), g_k)
    v = proj[..., 2 * hw:3 * hw].reshape(bsz, seq, FOX_HEADS, HEAD_DIM)
    log_f = jax.nn.log_sigmoid(proj[..., 3 * hw:].astype(jnp.float32)
                               + b_f.astype(jnp.float32))
    c = jnp.cumsum(log_f, axis=1).transpose(0, 2, 1)
    scale = HEAD_DIM ** -0.5
    outs = []
    for blk in range(seq // Q_BLOCK):
        t0, t1 = blk * Q_BLOCK, (blk + 1) * Q_BLOCK
        s = jnp.einsum('bqhd,bkhd->bhqk', q[:, t0:t1], k[:, :t1]).astype(jnp.float32) * scale
        s = s + c[:, :, t0:t1, None] - c[:, :, None, :t1]
        mask = np.arange(t1)[None, :] <= np.arange(t0, t1)[:, None]
        s = jnp.where(mask, s, -jnp.inf)
        p = jax.nn.softmax(s, axis=-1).astype(v.dtype)
        outs.append(jnp.einsum('bhqk,bkhd->bqhd', p, v[:, :t1]))
    o = jnp.concatenate(outs, axis=1).reshape(bsz, seq, hw)
    return o @ w_out


def _shared_kv(h, g_kv, w_kv, g_k):
    bsz, seq, _ = h.shape
    kvw = SWA_KV_HEADS * HEAD_DIM
    kv = _rmsnorm(h, g_kv) @ w_kv
    k = _rmsnorm(kv[..., :kvw].reshape(bsz, seq, SWA_KV_HEADS, HEAD_DIM), g_k)
    v = kv[..., kvw:].reshape(bsz, seq, SWA_KV_HEADS, HEAD_DIM)
    return k, v


def _band(x):
    bsz, seq = x.shape[:2]
    xb = x.reshape(bsz, seq // WINDOW, WINDOW, *x.shape[2:])
    prev = jnp.pad(xb[:, :-1], ((0, 0), (1, 0), (0, 0), (0, 0), (0, 0)))
    return jnp.concatenate([prev, xb], axis=2)


def _swa_sink_attention(h, w_q, g_q, k_band, v_band, sinks, rel_bias, w_out):
    bsz, seq, _ = h.shape
    nblk = seq // WINDOW
    q = _rmsnorm((h @ w_q).reshape(bsz, seq, SWA_Q_HEADS, HEAD_DIM), g_q)
    qb = q.reshape(bsz, nblk, WINDOW, SWA_KV_HEADS, SWA_GROUP, HEAD_DIM)
    s = jnp.einsum('bnqkgd,bnjkd->bnkgqj', qb, k_band).astype(jnp.float32) * (HEAD_DIM ** -0.5)
    dist = np.arange(WINDOW)[:, None] + WINDOW - np.arange(2 * WINDOW)[None, :]
    bias = rel_bias.astype(jnp.float32)[_t5_causal_bucket(dist)]
    bias = bias.transpose(2, 0, 1).reshape(SWA_KV_HEADS, SWA_GROUP, WINDOW, 2 * WINDOW)
    s = s + bias[None, None]
    valid = (dist >= 0) & (dist < WINDOW)
    blk_ok = (np.arange(nblk)[:, None] > 0) | (np.arange(2 * WINDOW)[None, :] >= WINDOW)
    mask = valid[None, :, :] & blk_ok[:, None, :]
    s = jnp.where(mask[None, :, None, None], s, -jnp.inf)
    sink = jnp.broadcast_to(
        sinks.astype(jnp.float32).reshape(1, 1, SWA_KV_HEADS, SWA_GROUP, 1, 1),
        s.shape[:-1] + (1,))
    p = jax.nn.softmax(jnp.concatenate([s, sink], axis=-1), axis=-1)[..., :-1]
    o = jnp.einsum('bnkgqj,bnjkd->bnqkgd', p.astype(v_band.dtype), v_band)
    return o.reshape(bsz, seq, SWA_Q_HEADS * HEAD_DIM) @ w_out


def setup_inputs(seed: int = 0) -> dict:
    key = jax.random.key(seed)
    ks = jax.random.split(key, 20)
    f32 = jnp.float32
    hw = FOX_HEADS * HEAD_DIM
    qw = SWA_Q_HEADS * HEAD_DIM
    kvw = SWA_KV_HEADS * HEAD_DIM

    def nrm(k, shape, fan_in):
        return jax.random.normal(k, shape, f32) * (fan_in ** -0.5)

    def gain(k, shape):
        return 1.0 + 0.05 * jax.random.normal(k, shape, f32)

    return {
        "x": jax.random.normal(ks[0], (BATCH, SEQ, D_MODEL), f32),
        "g_attn": gain(ks[1], (DEPTH, D_MODEL)),
        "g_mlp": gain(ks[2], (DEPTH, D_MODEL)),
        "w_in_a": nrm(ks[3], (N_A_LAYERS, D_MODEL, 3 * hw + FOX_HEADS), D_MODEL),
        "b_f": 3.0 + 0.5 * jax.random.normal(ks[4], (N_A_LAYERS, FOX_HEADS), f32),
        "gq_a": gain(ks[5], (N_A_LAYERS, HEAD_DIM)),
        "gk_a": gain(ks[6], (N_A_LAYERS, HEAD_DIM)),
        "w_out_a": nrm(ks[7], (N_A_LAYERS, hw, D_MODEL), hw),
        "g_kv": gain(ks[8], (D_MODEL,)),
        "w_kv": nrm(ks[9], (D_MODEL, 2 * kvw), D_MODEL),
        "gk_b": gain(ks[10], (HEAD_DIM,)),
        "w_q_b": nrm(ks[11], (N_B_LAYERS, D_MODEL, qw), D_MODEL),
        "gq_b": gain(ks[12], (N_B_LAYERS, HEAD_DIM)),
        "sinks": 0.5 * jax.random.normal(ks[13], (N_B_LAYERS, SWA_Q_HEADS), f32),
        "rel_bias": 0.2 * jax.random.normal(ks[14], (N_BUCKETS, SWA_Q_HEADS), f32),
        "w_out_b": nrm(ks[15], (N_B_LAYERS, qw, D_MODEL), qw),
        "w_up": nrm(ks[16], (DEPTH, D_MODEL, D_FF), D_MODEL),
        "w_down": nrm(ks[17], (DEPTH, D_FF, D_MODEL), D_FF),
    }


def reference(x, g_attn, g_mlp, w_in_a, b_f, gq_a, gk_a, w_out_a, g_kv, w_kv, gk_b,
              w_q_b, gq_b, sinks, rel_bias, w_out_b, w_up, w_down):
    h = x
    k_band = None
    v_band = None
    for layer in range(DEPTH):
        if layer < N_A_LAYERS:
            a = layer
            h = h + _fox_attention(_rmsnorm(h, g_attn[layer]), w_in_a[a], b_f[a],
                                   gq_a[a], gk_a[a], w_out_a[a])
        else:
            b = layer - N_A_LAYERS
            if b == 0:
                k_sh, v_sh = _shared_kv(h, g_kv, w_kv, gk_b)
                k_band, v_band = _band(k_sh), _band(v_sh)
            h = h + _swa_sink_attention(_rmsnorm(h, g_attn[layer]), w_q_b[b], gq_b[b],
                                        k_band, v_band, sinks[b], rel_bias, w_out_b[b])
        h = h + _sq_relu_mlp(_rmsnorm(h, g_mlp[layer]), w_up[layer], w_down[layer])
    return h
```

```cpp
#include <hip/hip_runtime.h>
#include <math.h>

constexpr int D = 1024, NB = 8, S = 2048, H = 16, HD = 64, FF = 4096, NIN = 3088, KVC = 256;

__device__ __forceinline__ float wave_sum(float v) {
#pragma unroll
    for (int o = 1; o < 64; o <<= 1) v += __shfl_xor(v, o);
    return v;
}

__global__ void __launch_bounds__(256) k_rmsnorm(const float* x, const float* g, float* out) {
    const int row = blockIdx.x * 4 + (threadIdx.x >> 6), lane = threadIdx.x & 63;
    const float4* xr = (const float4*)(x + (size_t)row * D);
    const float4* gr = (const float4*)g;
    float4 v[4]; float s = 0.f;
#pragma unroll
    for (int j = 0; j < 4; ++j) { v[j] = xr[lane + 64 * j]; s += v[j].x * v[j].x + v[j].y * v[j].y + v[j].z * v[j].z + v[j].w * v[j].w; }
    s = wave_sum(s);
    const float r = rsqrtf(s / D + 1e-6f);
    float4* o = (float4*)(out + (size_t)row * D);
#pragma unroll
    for (int j = 0; j < 4; ++j) { float4 gg = gr[lane + 64 * j]; float4 w; w.x = v[j].x * r * gg.x; w.y = v[j].y * r * gg.y; w.z = v[j].z * r * gg.z; w.w = v[j].w * r * gg.w; o[lane + 64 * j] = w; }
}

template <int ACT>
__global__ void __launch_bounds__(256) k_gemm(const float* A, int lda, const float* W, int ldw, float* C, int ldc, int N, int K, const float* resid, int ldr) {
    __shared__ float As[16][68];
    __shared__ float Ws[16][68];
    const int bm = blockIdx.y * 64, bn = blockIdx.x * 64, tid = threadIdx.x, tx = tid & 15, ty = tid >> 4;
    float acc[4][4];
#pragma unroll
    for (int i = 0; i < 4; ++i)
#pragma unroll
        for (int j = 0; j < 4; ++j) acc[i][j] = 0.f;
    const int ar = tid >> 2, akq = (tid & 3) * 4, wk = tid >> 4, wn = (tid & 15) * 4;
    for (int k0 = 0; k0 < K; k0 += 16) {
        const float4 av = *(const float4*)(A + (size_t)(bm + ar) * lda + k0 + akq);
        float4 wv = make_float4(0.f, 0.f, 0.f, 0.f);
        if (bn + wn < N) wv = *(const float4*)(W + (size_t)(k0 + wk) * ldw + bn + wn);
        As[akq + 0][ar] = av.x; As[akq + 1][ar] = av.y; As[akq + 2][ar] = av.z; As[akq + 3][ar] = av.w;
        *(float4*)&Ws[wk][wn] = wv;
        __syncthreads();
#pragma unroll
        for (int kk = 0; kk < 16; ++kk) {
            const float4 a = *(const float4*)&As[kk][ty * 4];
            const float4 w = *(const float4*)&Ws[kk][tx * 4];
            const float aa[4] = {a.x, a.y, a.z, a.w}, ww[4] = {w.x, w.y, w.z, w.w};
#pragma unroll
            for (int i = 0; i < 4; ++i)
#pragma unroll
                for (int j = 0; j < 4; ++j) acc[i][j] = fmaf(aa[i], ww[j], acc[i][j]);
        }
        __syncthreads();
    }
    if (bn + tx * 4 < N) {
#pragma unroll
        for (int i = 0; i < 4; ++i) {
            const int row = bm + ty * 4 + i;
            float4 o = make_float4(acc[i][0], acc[i][1], acc[i][2], acc[i][3]);
            if (ACT == 1) { o.x = o.x > 0.f ? o.x * o.x : 0.f; o.y = o.y > 0.f ? o.y * o.y : 0.f; o.z = o.z > 0.f ? o.z * o.z : 0.f; o.w = o.w > 0.f ? o.w * o.w : 0.f; }
            if (resid) { const float4 r = *(const float4*)(resid + (size_t)row * ldr + bn + tx * 4); o.x += r.x; o.y += r.y; o.z += r.z; o.w += r.w; }
            *(float4*)(C + (size_t)row * ldc + bn + tx * 4) = o;
        }
    }
}

__global__ void __launch_bounds__(256) k_headnorm(float* buf, int ld, int coff, int nheads, const float* g, int rows) {
    const int idx = blockIdx.x * 256 + threadIdx.x;
    if (idx >= rows * nheads) return;
    const int row = idx / nheads, h = idx % nheads;
    float* p = buf + (size_t)row * ld + coff + h * 64;
    float ss = 0.f;
    for (int d = 0; d < 64; ++d) ss += p[d] * p[d];
    const float r = rsqrtf(ss / 64.f + 1e-6f);
    for (int d = 0; d < 64; ++d) p[d] = p[d] * r * g[d];
}

__global__ void k_cum(const float* proj, const float* bf, float* cum) {
    const int h = threadIdx.x;
    if (h >= H) return;
    float c = 0.f; const float b = bf[h];
    for (int t = 0; t < S; ++t) {
        const float z = proj[(size_t)t * NIN + 3072 + h] + b;
        const float lf = fminf(z, 0.f) - log1pf(expf(-fabsf(z)));
        c += lf; cum[h * S + t] = c;
    }
}

__global__ void __launch_bounds__(64) k_fox(const float* proj, const float* cum, float* O) {
    const int h = blockIdx.y, t = blockIdx.x * 64 + threadIdx.x;
    float q[64], o[64];
    const float* qp = proj + (size_t)t * NIN + h * 64;
#pragma unroll
    for (int d = 0; d < 64; ++d) { q[d] = qp[d]; o[d] = 0.f; }
    const float ct = cum[h * S + t];
    float m = -INFINITY, l = 0.f;
    const int smax = blockIdx.x * 64 + 63;
    for (int s = 0; s <= smax; ++s) {
        const float* kp = proj + (size_t)s * NIN + 1024 + h * 64;
        const float* vp = proj + (size_t)s * NIN + 2048 + h * 64;
        float sc = 0.f;
#pragma unroll
        for (int d = 0; d < 64; ++d) sc = fmaf(q[d], kp[d], sc);
        sc = sc * 0.125f + ct - cum[h * S + s];
        if (s <= t) {
            const float mn = fmaxf(m, sc), a = expf(m - mn), p = expf(sc - mn);
            l = l * a + p; m = mn;
#pragma unroll
            for (int d = 0; d < 64; ++d) o[d] = fmaf(p, vp[d], o[d] * a);
        }
    }
    const float il = 1.f / l;
    float* op = O + (size_t)t * D + h * 64;
#pragma unroll
    for (int d = 0; d < 64; ++d) op[d] = o[d] * il;
}

__device__ __forceinline__ int t5_bucket(int n) {
    if (n < 16) return n;
    int b = 16;
    b += (n >= 19); b += (n >= 21); b += (n >= 24); b += (n >= 27); b += (n >= 31); b += (n >= 35); b += (n >= 40); b += (n >= 46);
    b += (n >= 52); b += (n >= 59); b += (n >= 67); b += (n >= 77); b += (n >= 87); b += (n >= 99); b += (n >= 113);
    return b;
}

__global__ void __launch_bounds__(64) k_swa(const float* qb, const float* kv, const float* sinks, const float* relb, float* O) {
    const int h = blockIdx.y, t = blockIdx.x * 64 + threadIdx.x, kvh = h >> 3;
    float q[64], o[64];
    const float* qp = qb + (size_t)t * D + h * 64;
#pragma unroll
    for (int d = 0; d < 64; ++d) { q[d] = qp[d]; o[d] = 0.f; }
    const float sink = sinks[h];
    float m = sink, l = 1.f;
    for (int j = 0; j < 128; ++j) {
        const int pos = t - j;
        if (pos >= 0) {
            const float* kp = kv + (size_t)pos * KVC + kvh * 64;
            const float* vp = kv + (size_t)pos * KVC + 128 + kvh * 64;
            float sc = 0.f;
#pragma unroll
            for (int d = 0; d < 64; ++d) sc = fmaf(q[d], kp[d], sc);
            sc = sc * 0.125f + relb[t5_bucket(j) * H + h];
            const float mn = fmaxf(m, sc), a = expf(m - mn), p = expf(sc - mn);
            l = l * a + p; m = mn;
#pragma unroll
            for (int d = 0; d < 64; ++d) o[d] = fmaf(p, vp[d], o[d] * a);
        }
    }
    const float il = 1.f / l;
    float* op = O + (size_t)t * D + h * 64;
#pragma unroll
    for (int d = 0; d < 64; ++d) op[d] = o[d] * il;
}

extern "C" void kernel_launch(void* const* d_in, const int* in_sizes, int n_in, void* d_out, int out_size, void* d_ws, size_t ws_size, hipStream_t stream) {
    const float* x = (const float*)d_in[0];
    const float* g_attn = (const float*)d_in[1];
    const float* g_mlp = (const float*)d_in[2];
    const float* w_in_a = (const float*)d_in[3];
    const float* b_f = (const float*)d_in[4];
    const float* gq_a = (const float*)d_in[5];
    const float* gk_a = (const float*)d_in[6];
    const float* w_out_a = (const float*)d_in[7];
    const float* g_kv = (const float*)d_in[8];
    const float* w_kv = (const float*)d_in[9];
    const float* gk_b = (const float*)d_in[10];
    const float* w_q_b = (const float*)d_in[11];
    const float* gq_b = (const float*)d_in[12];
    const float* sinks = (const float*)d_in[13];
    const float* rel_bias = (const float*)d_in[14];
    const float* w_out_b = (const float*)d_in[15];
    const float* w_up = (const float*)d_in[16];
    const float* w_down = (const float*)d_in[17];
    float* out = (float*)d_out;
    float* ws = (float*)d_ws;
    float* xn = ws;
    float* proj = xn + (size_t)S * D;
    float* att = proj + (size_t)S * NIN;
    float* hid = att + (size_t)S * D;
    float* cum = hid + (size_t)S * FF;
    float* qb = cum + (size_t)H * S;
    float* kvb = qb + (size_t)S * D;
    for (int b = 0; b < NB; ++b) {
        const float* xb = x + (size_t)b * S * D;
        float* hb = out + (size_t)b * S * D;
        k_rmsnorm<<<S / 4, 256, 0, stream>>>(xb, g_attn, xn);
        k_gemm<0><<<dim3((NIN + 63) / 64, S / 64), 256, 0, stream>>>(xn, D, w_in_a, NIN, proj, NIN, NIN, D, nullptr, 0);
        k_headnorm<<<(S * H + 255) / 256, 256, 0, stream>>>(proj, NIN, 0, H, gq_a, S);
        k_headnorm<<<(S * H + 255) / 256, 256, 0, stream>>>(proj, NIN, 1024, H, gk_a, S);
        k_cum<<<1, 64, 0, stream>>>(proj, b_f, cum);
        k_fox<<<dim3(S / 64, H), 64, 0, stream>>>(proj, cum, att);
        k_gemm<0><<<dim3(D / 64, S / 64), 256, 0, stream>>>(att, D, w_out_a, D, hb, D, D, D, xb, D);
        k_rmsnorm<<<S / 4, 256, 0, stream>>>(hb, g_mlp, xn);
        k_gemm<1><<<dim3(FF / 64, S / 64), 256, 0, stream>>>(xn, D, w_up, FF, hid, FF, FF, D, nullptr, 0);
        k_gemm<0><<<dim3(D / 64, S / 64), 256, 0, stream>>>(hid, FF, w_down, D, hb, D, D, FF, hb, D);
        k_rmsnorm<<<S / 4, 256, 0, stream>>>(hb, g_kv, xn);
        k_gemm<0><<<dim3(KVC / 64, S / 64), 256, 0, stream>>>(xn, D, w_kv, KVC, kvb, KVC, KVC, D, nullptr, 0);
        k_headnorm<<<(S * 2 + 255) / 256, 256, 0, stream>>>(kvb, KVC, 0, 2, gk_b, S);
        k_rmsnorm<<<S / 4, 256, 0, stream>>>(hb, g_attn + D, xn);
        k_gemm<0><<<dim3(D / 64, S / 64), 256, 0, stream>>>(xn, D, w_q_b, D, qb, D, D, D, nullptr, 0);
        k_headnorm<<<(S * H + 255) / 256, 256, 0, stream>>>(qb, D, 0, H, gq_b, S);
        k_swa<<<dim3(S / 64, H), 64, 0, stream>>>(qb, kvb, sinks, rel_bias, att);
        k_gemm<0><<<dim3(D / 64, S / 64), 256, 0, stream>>>(att, D, w_out_b, D, hb, D, D, D, hb, D);
        k_rmsnorm<<<S / 4, 256, 0, stream>>>(hb, g_mlp + D, xn);
        k_gemm<1><<<dim3(FF / 64, S / 64), 256, 0, stream>>>(xn, D, w_up + (size_t)D * FF, FF, hid, FF, FF, D, nullptr, 0);
        k_gemm<0><<<dim3(D / 64, S / 64), 256, 0, stream>>>(hid, FF, w_down + (size_t)FF * D, D, hb, D, D, FF, hb, D);
    }
}
```

```cpp
#include <hip/hip_runtime.h>
#include <hip/hip_bf16.h>
#include <cstdio>
#include <cstdint>
#include <cmath>
namespace pg8 {
#define PG8_LAS __attribute__((address_space(3)))
typedef unsigned short bf16_t;
typedef short bf16x8 __attribute__((ext_vector_type(8)));
typedef float f32x4 __attribute__((ext_vector_type(4)));
typedef unsigned u32x4 __attribute__((ext_vector_type(4)));
constexpr int BM = 256, BK = 64, HALF = 128, HTB = HALF * BK * 2  , STAGE_BYTES = 8 * HTB, NXCD = 8, WGM = 8;

__host__ __device__ __forceinline__ int lds_byte(int r, int c) { const int st = (r >> 4) * 2 + (c >> 5), rr = r & 15, cc = c & 31, ob = rr * 64 + cc * 2; return st * 1024 + (ob ^ (((ob >> 9) & 1) << 5)); }
__host__ __device__ __forceinline__ void stage_rc(int b, int& R, int& C) { const int st = b / 1024, sb = b % 1024, swz = sb ^ (((sb >> 9) & 1) << 5); R = (st >> 1) * 16 + swz / 64; C = (st & 1) * 32 + (swz % 64) / 2; }
__host__ __device__ __forceinline__ int perm32(int rho) { const int n = rho >> 4, i = rho & 15; return 8 * (i >> 2) + 4 * n + (i & 3); }

struct Unit { int pm, pn; };
struct Gemm { const bf16_t* A; const bf16_t* Bt; int M, N, K; };

struct StaticOrder {
    int nM, nN, nwg, G, c;
    __host__ __device__ void init(int M, int N, int G_, int c_) { nM = M / BM; nN = N / BM; nwg = nM * nN; G = G_; c = c_; }
    __host__ __device__ bool next(int i, Unit& u) const {
        const long L = (long)i * G + c; if (L >= nwg) return false;
        int wgid = (int)L; { const int q = nwg / NXCD, r = nwg % NXCD, xcd = wgid % NXCD, off = wgid / NXCD; wgid = (xcd < r ? xcd * (q + 1) : r * (q + 1) + (xcd - r) * q) + off; }
        const int nig = WGM * nN, gid = wgid / nig, fm = gid * WGM, gsz = (nM - fm) < WGM ? (nM - fm) : WGM;
        u.pm = fm + ((wgid % nig) % gsz); u.pn = (wgid % nig) / gsz; return true;
    }
    __device__ __forceinline__ void a_ready(const Unit&) const {}
    __device__ __forceinline__ void done(const Unit&) const {}
};
__device__ __forceinline__ unsigned cvt_pk_bf16(float lo, float hi) { unsigned r; asm volatile("v_cvt_pk_bf16_f32 %0, %1, %2" : "=v"(r) : "v"(lo), "v"(hi)); return r; }
typedef unsigned u32x2 __attribute__((ext_vector_type(2)));
constexpr float QK_C2 = 0.125f * 1.4426950408889634f;
constexpr float RMS_EPS = 1e-6f;

__device__ __forceinline__ float sum_fq(float s) {
    { auto r = __builtin_amdgcn_permlane16_swap(__float_as_uint(s), __float_as_uint(s), false, false); s = __uint_as_float(r[0]) + __uint_as_float(r[1]); }
    { auto r = __builtin_amdgcn_permlane32_swap(__float_as_uint(s), __float_as_uint(s), false, false); s = __uint_as_float(r[0]) + __uint_as_float(r[1]); }
    return s;
}
typedef float f32x2 __attribute__((ext_vector_type(2)));
__device__ __forceinline__ float sumsq16(const f32x4& a, const f32x4& b, const f32x4& c, const f32x4& d) {
    f32x2 s = a.xy * a.xy;
    s = __builtin_elementwise_fma(a.zw, a.zw, s); s = __builtin_elementwise_fma(b.xy, b.xy, s); s = __builtin_elementwise_fma(b.zw, b.zw, s);
    s = __builtin_elementwise_fma(c.xy, c.xy, s); s = __builtin_elementwise_fma(c.zw, c.zw, s); s = __builtin_elementwise_fma(d.xy, d.xy, s); s = __builtin_elementwise_fma(d.zw, d.zw, s);
    return s.x + s.y;
}
struct EpiHead {
    static constexpr bool PERM = true, AFTER_DRAIN = false; static constexpr int NST = 32;
    bf16_t* dq; size_t cls_stride; bf16_t* dkv; const PG8_LAS float* gl; const PG8_LAS float* rrl; int layerB;
    __device__ __forceinline__ void operator()(const f32x4 (&acc)[2][2][4][2], const Unit& u, int wr, int wc, int fr0, int fq0) const {
        int ln = fr0 | (fq0 << 4); asm volatile("" : "+v"(ln)); const int fr = ln & 15, fq = ln >> 4;
        bf16_t* base; int ld, colbase, mode;
        if (!layerB) { const int cls = u.pn >> 2; base = dq + (size_t)cls * cls_stride; ld = 1024; colbase = 256 * (u.pn & 3); mode = cls; }
        else if (u.pn < 4) { base = dq; ld = 1024; colbase = 256 * u.pn; mode = 0; }
        else { base = dkv; ld = 256; colbase = 0; mode = wc < 2 ? 1 : 2; }
        const int row0 = u.pm * BM + wr * 64 + fr;
        bf16_t* p0 = base + (size_t)row0 * ld + colbase + 64 * wc + 8 * fq;
        if (mode == 0) {
            f32x4 gv[2][2];
#pragma unroll
            for (int bj = 0; bj < 2; ++bj)
#pragma unroll
                for (int n = 0; n < 2; ++n) gv[bj][n] = *(const PG8_LAS f32x4*)(gl + 32 * bj + 8 * fq + 4 * n);
#pragma unroll
            for (int ai = 0; ai < 2; ++ai)
#pragma unroll
                for (int m = 0; m < 4; ++m) {
                    const float rr = rrl[wr * 64 + fr + ai * HALF + m * 16];
                    const float s = sum_fq(sumsq16(acc[ai][0][m][0], acc[ai][0][m][1], acc[ai][1][m][0], acc[ai][1][m][1]));
                    const float t = rr * __builtin_amdgcn_rsqf(rr * rr * s * (1.f / 64.f) + RMS_EPS);
                    bf16_t* rowp = p0 + (size_t)(ai * HALF + m * 16) * ld;
#pragma unroll
                    for (int bj = 0; bj < 2; ++bj) { const f32x4 v0 = acc[ai][bj][m][0] * gv[bj][0] * t, v1 = acc[ai][bj][m][1] * gv[bj][1] * t;
                        u32x4 w; w.x = cvt_pk_bf16(v0[0], v0[1]); w.y = cvt_pk_bf16(v0[2], v0[3]); w.z = cvt_pk_bf16(v1[0], v1[1]); w.w = cvt_pk_bf16(v1[2], v1[3]);
                        *(u32x4*)(rowp + 32 * bj) = w; }
                }
        } else {
#pragma unroll
            for (int ai = 0; ai < 2; ++ai)
#pragma unroll
                for (int m = 0; m < 4; ++m) {
                    float t = rrl[wr * 64 + fr + ai * HALF + m * 16];
                    if (mode == 1) { const float s = sum_fq(sumsq16(acc[ai][0][m][0], acc[ai][0][m][1], acc[ai][1][m][0], acc[ai][1][m][1])); t = t * __builtin_amdgcn_rsqf(t * t * s * (1.f / 64.f) + RMS_EPS); }
                    bf16_t* rowp = p0 + (size_t)(ai * HALF + m * 16) * ld;
#pragma unroll
                    for (int bj = 0; bj < 2; ++bj) { const f32x4 v0 = acc[ai][bj][m][0] * t, v1 = acc[ai][bj][m][1] * t;
                        u32x4 w; w.x = cvt_pk_bf16(v0[0], v0[1]); w.y = cvt_pk_bf16(v0[2], v0[3]); w.z = cvt_pk_bf16(v1[0], v1[1]); w.w = cvt_pk_bf16(v1[2], v1[3]);
                        *(u32x4*)(rowp + 32 * bj) = w; }
                }
        }
    }
};

struct EpiAct {
    static constexpr bool PERM = true, AFTER_DRAIN = false; static constexpr int NST = 32;
    bf16_t* O; int ldc;
    __device__ __forceinline__ void operator()(const f32x4 (&acc)[2][2][4][2], const Unit& u, int wr, int wc, int fr, int fq) const {
        const int row0 = u.pm * BM + wr * 64 + fr, col0 = u.pn * BM + wc * 32 + 8 * fq;
#pragma unroll
        for (int ai = 0; ai < 2; ++ai)
#pragma unroll
            for (int m = 0; m < 4; ++m) {
                const int row = row0 + ai * HALF + m * 16;
                bf16_t* rowp = O + (size_t)row * ldc + col0;
#pragma unroll
                for (int bj = 0; bj < 2; ++bj) { f32x4 v0 = acc[ai][bj][m][0], v1 = acc[ai][bj][m][1];
#pragma unroll
                    for (int e = 0; e < 4; ++e) { v0[e] = __int_as_float(max(__float_as_int(v0[e]), 0)); v1[e] = __int_as_float(max(__float_as_int(v1[e]), 0)); }
                    v0 = v0 * v0; v1 = v1 * v1;
                    u32x4 w; w.x = cvt_pk_bf16(v0[0], v0[1]); w.y = cvt_pk_bf16(v0[2], v0[3]); w.z = cvt_pk_bf16(v1[0], v1[1]); w.w = cvt_pk_bf16(v1[2], v1[3]);
                    *(u32x4*)(rowp + bj * HALF) = w; }
            }
    }
};

template <int MODE, bool SCALE = false> struct EpiResid {
    static constexpr bool PERM = true, AFTER_DRAIN = false; static constexpr int NST = 0;
    const float* base32; bf16_t* xn; float* out32; float* ss; const PG8_LAS float* rrl;
    __device__ __forceinline__ void operator()(const f32x4 (&acc)[2][2][4][2], const Unit& u, int wr, int wc, int fr, int fq) const {
        const int row0 = u.pm * BM + wr * 64 + fr, col0 = u.pn * BM + wc * 32 + 8 * fq;
#pragma unroll
        for (int ai = 0; ai < 2; ++ai)
#pragma unroll
            for (int m = 0; m < 4; ++m) {
                const int row = row0 + ai * HALF + m * 16; const size_t off = (size_t)row * 1024 + col0;
                float s = 0.f, sc = 1.f;
                if (SCALE) { const float rr = rrl[wr * 64 + fr + ai * HALF + m * 16]; sc = rr * rr; }
#pragma unroll
                for (int bj = 0; bj < 2; ++bj) {
                    f32x4 r0, r1;
                    if (MODE == 0) { r0 = __builtin_nontemporal_load((const f32x4*)(base32 + off + bj * HALF)); r1 = __builtin_nontemporal_load((const f32x4*)(base32 + off + bj * HALF + 4)); }
                    else { const u32x4 w = MODE == 2 ? __builtin_nontemporal_load((const u32x4*)(xn + off + bj * HALF)) : *(const u32x4*)(xn + off + bj * HALF);
                        r0 = (f32x4){__uint_as_float(w.x << 16), __uint_as_float(w.x & 0xffff0000u), __uint_as_float(w.y << 16), __uint_as_float(w.y & 0xffff0000u)};
                        r1 = (f32x4){__uint_as_float(w.z << 16), __uint_as_float(w.z & 0xffff0000u), __uint_as_float(w.w << 16), __uint_as_float(w.w & 0xffff0000u)}; }
                    const f32x4 o0 = SCALE ? r0 + acc[ai][bj][m][0] * sc : r0 + acc[ai][bj][m][0], o1 = SCALE ? r1 + acc[ai][bj][m][1] * sc : r1 + acc[ai][bj][m][1];
                    if (MODE == 2) { __builtin_nontemporal_store(o0, (f32x4*)(out32 + off + bj * HALF)); __builtin_nontemporal_store(o1, (f32x4*)(out32 + off + bj * HALF + 4)); }
                    else { u32x4 w; w.x = cvt_pk_bf16(o0[0], o0[1]); w.y = cvt_pk_bf16(o0[2], o0[3]); w.z = cvt_pk_bf16(o1[0], o1[1]); w.w = cvt_pk_bf16(o1[2], o1[3]);
                        *(u32x4*)(xn + off + bj * HALF) = w;
                        s += ((o0[0] * o0[0] + o0[1] * o0[1]) + (o0[2] * o0[2] + o0[3] * o0[3])) + ((o1[0] * o1[0] + o1[1] * o1[1]) + (o1[2] * o1[2] + o1[3] * o1[3])); }
                }
                if (MODE != 2) { s = sum_fq(s);
                    if (fq == 0) __hip_atomic_fetch_add(ss + row, s, __ATOMIC_RELAXED, __HIP_MEMORY_SCOPE_AGENT); }
                if (m & 1) asm volatile("" ::: "memory");
            }
    }
};

struct EpiDry {
    static constexpr bool PERM = false, AFTER_DRAIN = false; static constexpr int NST = 0;
    __device__ __forceinline__ void operator()(const f32x4 (&acc)[2][2][4][2], const Unit& u, int wr, int wc, int fr, int fq) const {
#pragma unroll
        for (int ai = 0; ai < 2; ++ai)
#pragma unroll
            for (int bj = 0; bj < 2; ++bj)
#pragma unroll
                for (int m = 0; m < 4; ++m)
#pragma unroll
                    for (int n = 0; n < 2; ++n) asm volatile("" :: "v"(acc[ai][bj][m][n]));
    }
};
template <class Epi, class Sched, bool ALIGN_EPI = false, bool SP2 = false>
__device__ __forceinline__ void gemm_phase(PG8_LAS unsigned char* lds, const Gemm g, const Sched& S, const Epi& E) {
    const int tid = threadIdx.x, wid = __builtin_amdgcn_readfirstlane(tid >> 6), lane = tid & 63, wr = wid >> 2, wc = wid & 3, fr = lane & 15, fq = lane >> 4;
    const int K = g.K, nt = K / BK;
    unsigned voffA[2], voffB[2];
#pragma unroll
    for (int i = 0; i < 2; ++i) { int R, C; stage_rc(tid * 16 + i * 8192, R, C); const int Rb = Epi::PERM ? ((R & ~31) + perm32(R & 31)) : R;
        voffA[i] = (unsigned)(R * K + C) * 2u; voffB[i] = (unsigned)(Rb * K + C) * 2u; }
    const size_t kstep = (size_t)(BK * 2);
    const size_t hstep = (size_t)HALF * K * 2;
    const size_t tstep = 2 * hstep;
    const unsigned ldsw = (unsigned)wid * 1024u;
    const int aoff = lds_byte(wr * 64 + fr, fq * 8), boff = lds_byte(wc * 32 + fr, fq * 8);
#define PG8_SA(b, h) (((b) * 2 + (h)) * HTB)
#define PG8_SB(b, h) ((4 + (b) * 2 + (h)) * HTB)
#define PG8_STAGE(bufoff, gbase, voff) do { _Pragma("unroll") for (int _i = 0; _i < 2; ++_i) \
        __builtin_amdgcn_global_load_lds((const unsigned*)((const char*)(gbase) + (voff)[_i]), (PG8_LAS unsigned*)(lds + (bufoff) + ldsw + _i * 8192), 16, 0, 0); } while (0)
#define PG8_LDA(dst, b, h) do { _Pragma("unroll") for (int m = 0; m < 4; ++m) _Pragma("unroll") for (int k = 0; k < 2; ++k) dst[m][k] = *(const PG8_LAS bf16x8*)(lds + PG8_SA(b, h) + aoff + m * 2048 + k * 1024); } while (0)
#define PG8_LDB(dst, b, h) do { _Pragma("unroll") for (int n = 0; n < 2; ++n) _Pragma("unroll") for (int k = 0; k < 2; ++k) dst[n][k] = *(const PG8_LAS bf16x8*)(lds + PG8_SB(b, h) + boff + n * 2048 + k * 1024); } while (0)
#define PG8_MMA(ai, bj, At, Bt) do { __builtin_amdgcn_s_setprio(1); _Pragma("unroll") for (int m = 0; m < 4; ++m) _Pragma("unroll") for (int n = 0; n < 2; ++n) _Pragma("unroll") for (int k = 0; k < 2; ++k) \
        acc[ai][bj][m][n] = __builtin_amdgcn_mfma_f32_16x16x32_bf16(Bt[n][k], At[m][k], acc[ai][bj][m][n], 0, 0, 0); __builtin_amdgcn_s_setprio(0); } while (0)
#define PG8_WAIT_V(n) asm volatile("s_waitcnt vmcnt(" #n ")" ::: "memory")
#define PG8_WAIT_L(n) asm volatile("s_waitcnt lgkmcnt(" #n ")" ::: "memory")
#define PG8_BAR __builtin_amdgcn_s_barrier()
#define PG8_SCHED __builtin_amdgcn_sched_barrier(0)
    Unit cur, nxt; int ui = 0;
    if (!S.next(0, cur)) return;
    f32x4 acc[2][2][4][2];
#pragma unroll
    for (int a = 0; a < 2; ++a)
#pragma unroll
        for (int b = 0; b < 2; ++b)
#pragma unroll
            for (int m = 0; m < 4; ++m)
#pragma unroll
                for (int n = 0; n < 2; ++n) acc[a][b][m][n] = (f32x4){0.f, 0.f, 0.f, 0.f};
    bf16x8 At[4][2], B0[2][2], B1[2][2];
    const char* cA = (const char*)g.A + (size_t)cur.pm * tstep; const char* cB = (const char*)g.Bt + (size_t)cur.pn * tstep;
    S.a_ready(cur);
    if constexpr (SP2) {
        PG8_STAGE(PG8_SB(0, 0), cB, voffB); PG8_STAGE(PG8_SB(0, 1), cB + hstep, voffB); PG8_STAGE(PG8_SA(0, 0), cA, voffA); PG8_STAGE(PG8_SA(0, 1), cA + hstep, voffA);
        if (wr == 1) PG8_BAR;
        PG8_WAIT_V(2); PG8_BAR;
        PG8_STAGE(PG8_SB(1, 0), cB + kstep, voffB); PG8_STAGE(PG8_SA(1, 0), cA + kstep, voffA); PG8_STAGE(PG8_SB(1, 1), cB + hstep + kstep, voffB);
        PG8_WAIT_V(6); PG8_BAR;
    } else {
        PG8_STAGE(PG8_SB(0, 0), cB, voffB); PG8_STAGE(PG8_SA(0, 0), cA, voffA); PG8_STAGE(PG8_SB(0, 1), cB + hstep, voffB); PG8_STAGE(PG8_SA(0, 1), cA + hstep, voffA);
        if (wr == 1) PG8_BAR;
        PG8_WAIT_V(4); PG8_BAR;
        PG8_STAGE(PG8_SB(1, 0), cB + kstep, voffB); PG8_STAGE(PG8_SA(1, 0), cA + kstep, voffA); PG8_STAGE(PG8_SB(1, 1), cB + hstep + kstep, voffB);
        PG8_WAIT_V(6); PG8_BAR;
    }
    for (;;) {
        const bool has_next = S.next(ui + 1, nxt);
        const char* nA = has_next ? (const char*)g.A + (size_t)nxt.pm * tstep : cA; const char* nB = has_next ? (const char*)g.Bt + (size_t)nxt.pn * tstep : cB;
        for (int t = 0; t < nt; t += 2) {
            const bool last = (t == nt - 2);
            const char* a1 = cA + (size_t)(t + 1) * kstep;
            const char* a2 = last ? nA : cA + (size_t)(t + 2) * kstep; const char* b2 = last ? nB : cB + (size_t)(t + 2) * kstep;
            const char* a3 = a2 + kstep; const char* b3 = b2 + kstep;
            if (last && has_next) S.a_ready(nxt);
            if constexpr (SP2) {
            PG8_LDB(B0, 0, 0); PG8_LDB(B1, 0, 1); PG8_SCHED; PG8_LDA(At, 0, 0); PG8_STAGE(PG8_SA(1, 1), a1 + hstep, voffA);
            PG8_WAIT_V(8); PG8_WAIT_L(0); PG8_BAR; PG8_MMA(0, 0, At, B0); PG8_MMA(0, 1, At, B1); PG8_BAR; PG8_SCHED;
            PG8_LDA(At, 0, 1); PG8_STAGE(PG8_SB(0, 0), b2, voffB); PG8_STAGE(PG8_SB(0, 1), b2 + hstep, voffB); PG8_STAGE(PG8_SA(0, 0), a2, voffA);
            PG8_WAIT_V(8); PG8_WAIT_L(0); PG8_BAR; PG8_MMA(1, 0, At, B0); PG8_MMA(1, 1, At, B1); PG8_BAR; PG8_SCHED;
            PG8_LDB(B0, 1, 0); PG8_LDB(B1, 1, 1); PG8_SCHED; PG8_LDA(At, 1, 0); PG8_STAGE(PG8_SA(0, 1), a2 + hstep, voffA);
            PG8_WAIT_V(8); PG8_WAIT_L(0); PG8_BAR; PG8_MMA(0, 0, At, B0); PG8_MMA(0, 1, At, B1); PG8_BAR; PG8_SCHED;
            PG8_LDA(At, 1, 1); PG8_STAGE(PG8_SB(1, 0), b3, voffB); PG8_STAGE(PG8_SB(1, 1), b3 + hstep, voffB); PG8_STAGE(PG8_SA(1, 0), a3, voffA);
            PG8_WAIT_V(8); PG8_WAIT_L(0); PG8_BAR; PG8_MMA(1, 0, At, B0); PG8_MMA(1, 1, At, B1); PG8_BAR; PG8_SCHED;
            } else {
            PG8_LDB(B0, 0, 0); PG8_SCHED; PG8_LDA(At, 0, 0); PG8_STAGE(PG8_SA(1, 1), a1 + hstep, voffA);
            PG8_WAIT_L(8); PG8_BAR; PG8_WAIT_L(0); PG8_MMA(0, 0, At, B0); PG8_BAR; PG8_SCHED;
            PG8_LDB(B1, 0, 1); PG8_STAGE(PG8_SB(0, 0), b2, voffB);
            PG8_BAR; PG8_WAIT_L(0); PG8_MMA(0, 1, At, B1); PG8_BAR;
            PG8_LDA(At, 0, 1); PG8_STAGE(PG8_SA(0, 0), a2, voffA);
            PG8_BAR; PG8_WAIT_L(0); PG8_MMA(1, 0, At, B0); PG8_BAR; PG8_SCHED;
            PG8_STAGE(PG8_SB(0, 1), b2 + hstep, voffB);
            PG8_WAIT_V(6); PG8_BAR; PG8_MMA(1, 1, At, B1); PG8_BAR;
            PG8_LDB(B0, 1, 0); PG8_SCHED; PG8_LDA(At, 1, 0); PG8_STAGE(PG8_SA(0, 1), a2 + hstep, voffA);
            PG8_WAIT_L(8); PG8_BAR; PG8_WAIT_L(0); PG8_MMA(0, 0, At, B0); PG8_BAR; PG8_SCHED;
            PG8_LDB(B1, 1, 1); PG8_STAGE(PG8_SB(1, 0), b3, voffB);
            PG8_BAR; PG8_WAIT_L(0); PG8_MMA(0, 1, At, B1); PG8_BAR;
            PG8_LDA(At, 1, 1); PG8_STAGE(PG8_SA(1, 0), a3, voffA);
            PG8_BAR; PG8_WAIT_L(0); PG8_MMA(1, 0, At, B0); PG8_BAR; PG8_SCHED;
            PG8_STAGE(PG8_SB(1, 1), b3 + hstep, voffB);
            PG8_WAIT_V(6); PG8_BAR; PG8_MMA(1, 1, At, B1); PG8_BAR;
            }
        }
        if constexpr (ALIGN_EPI) { if (wr == 0) PG8_BAR; }
        if constexpr (!Epi::AFTER_DRAIN) { E(acc, cur, wr, wc, fr, fq); S.done(cur); }
        if (!has_next) break;
#pragma unroll
        for (int a = 0; a < 2; ++a)
#pragma unroll
            for (int b = 0; b < 2; ++b)
#pragma unroll
                for (int m = 0; m < 4; ++m)
#pragma unroll
                    for (int n = 0; n < 2; ++n) acc[a][b][m][n] = (f32x4){0.f, 0.f, 0.f, 0.f};
        cur = nxt; cA = nA; cB = nB; ++ui;
        if constexpr (ALIGN_EPI) { if (wr == 1) PG8_BAR; }
    }
    PG8_WAIT_V(0);
    if constexpr (!ALIGN_EPI) { if (wr == 0) PG8_BAR; }
    PG8_BAR;
    if constexpr (Epi::AFTER_DRAIN) { E.fused(acc, cur, wr, wc, fr, fq, lds, wid, lane); S.done(cur); }
#undef PG8_SA
#undef PG8_SB
#undef PG8_STAGE
#undef PG8_LDA
#undef PG8_LDB
#undef PG8_MMA
#undef PG8_WAIT_V
#undef PG8_WAIT_L
#undef PG8_BAR
#undef PG8_SCHED
}
}
namespace att {
typedef unsigned short bf16_t;
typedef short bf16x8 __attribute__((ext_vector_type(8)));
typedef short s16x4 __attribute__((ext_vector_type(4)));
typedef float f32x16 __attribute__((ext_vector_type(16)));
typedef float f32x4 __attribute__((ext_vector_type(4)));
typedef unsigned u32x4 __attribute__((ext_vector_type(4)));
#define ALDS __attribute__((address_space(3)))
typedef ALDS const char* lds_cptr;
typedef ALDS char* lds_ptr;
typedef short v4i16_t __attribute__((ext_vector_type(4)));
constexpr int SEQ = 2048, DM = 1024, SLOTB = 8192;
constexpr float LOG2E = 1.4426950408889634f;
__device__ __forceinline__ int crow(int r, int hi) { return (r & 3) + 8 * (r >> 2) + 4 * hi; }
#define ATT_SBAR() __builtin_amdgcn_sched_barrier(0)
#define ATT_WAIT_BAR(N) asm volatile("s_waitcnt vmcnt(" #N ") lgkmcnt(0)\n\ts_barrier" ::: "memory")
#define ATT_LGKM_BAR() asm volatile("s_waitcnt lgkmcnt(0)\n\ts_barrier" ::: "memory")
__device__ __forceinline__ void glds16(const void* gsrc, unsigned lds_dst) { unsigned keep;
    asm volatile("s_mov_b32 %0, m0\n\ts_mov_b32 m0, %2\n\ts_nop 0\n\tglobal_load_lds_dwordx4 %1, off\n\ts_mov_b32 m0, %0" : "=&s"(keep) : "v"(gsrc), "s"(lds_dst) : "memory"); }
typedef float f32x2_t __attribute__((ext_vector_type(2))); typedef __bf16 bf16x2_t __attribute__((ext_vector_type(2)));
__device__ __forceinline__ unsigned cvtpk_s(float lo, float hi) { f32x2_t v = {lo, hi}; bf16x2_t b = __builtin_convertvector(v, bf16x2_t); return __builtin_bit_cast(unsigned, b); }

__device__ __forceinline__ void qkt2(f32x16& p0, f32x16& p1, lds_cptr kp, const bf16x8* qr, const f32x16& c0, const f32x16& c1) {
#pragma unroll
    for (int d0 = 0; d0 < 4; ++d0) {
        const bf16x8 b0 = *(const ALDS bf16x8*)(kp + d0 * 2048);
        const bf16x8 b1 = *(const ALDS bf16x8*)(kp + d0 * 2048 + 512);
        if (d0 == 0) { p0 = __builtin_amdgcn_mfma_f32_32x32x16_bf16(b0, qr[0], c0, 0, 0, 0); p1 = __builtin_amdgcn_mfma_f32_32x32x16_bf16(b1, qr[0], c1, 0, 0, 0); }
        else { p0 = __builtin_amdgcn_mfma_f32_32x32x16_bf16(b0, qr[d0], p0, 0, 0, 0); p1 = __builtin_amdgcn_mfma_f32_32x32x16_bf16(b1, qr[d0], p1, 0, 0, 0); }
    }
}
__device__ __forceinline__ void pv(f32x16* o, int vb, bf16x8 pa0, bf16x8 pa1, bf16x8 pa2, bf16x8 pa3) {
#pragma unroll
    for (int d0 = 0; d0 < 2; ++d0) { s16x4 lo[4], hi[4];
#pragma unroll
        for (int ks = 0; ks < 4; ++ks) {
            asm volatile("ds_read_b64_tr_b16 %0,%1 offset:%c2" : "=&v"(lo[ks]) : "v"(vb), "i"(d0 * 4096 + ks * 1024) : "memory");
            asm volatile("ds_read_b64_tr_b16 %0,%1 offset:%c2" : "=&v"(hi[ks]) : "v"(vb), "i"(d0 * 4096 + ks * 1024 + 512) : "memory"); }
        asm volatile("s_waitcnt lgkmcnt(0)" ::: "memory"); ATT_SBAR();
#define ATT_PK(k) (bf16x8){lo[k][0], lo[k][1], lo[k][2], lo[k][3], hi[k][0], hi[k][1], hi[k][2], hi[k][3]}
        o[d0] = __builtin_amdgcn_mfma_f32_32x32x16_bf16(pa0, ATT_PK(0), o[d0], 0, 0, 0);
        o[d0] = __builtin_amdgcn_mfma_f32_32x32x16_bf16(pa1, ATT_PK(1), o[d0], 0, 0, 0);
        o[d0] = __builtin_amdgcn_mfma_f32_32x32x16_bf16(pa2, ATT_PK(2), o[d0], 0, 0, 0);
        o[d0] = __builtin_amdgcn_mfma_f32_32x32x16_bf16(pa3, ATT_PK(3), o[d0], 0, 0, 0);
#undef ATT_PK
    }
}
__device__ __forceinline__ void tile_body(f32x16* o, float& l, lds_cptr kp, int vb, const bf16x8* qr, const f32x16& c0, const f32x16& c1) {
    f32x16 p0, p1; qkt2(p0, p1, kp, qr, c0, c1);
#pragma unroll
    for (int r = 0; r < 16; ++r) { p0[r] = __builtin_amdgcn_exp2f(p0[r]); p1[r] = __builtin_amdgcn_exp2f(p1[r]); }
    float s0 = 0.f, s1 = 0.f;
#pragma unroll
    for (int r = 0; r < 16; ++r) { s0 += p0[r]; s1 += p1[r]; }
    l += s0 + s1;
    u32x4 pw0, pw1, pw2, pw3;
    pw0 = (u32x4){cvtpk_s(p0[0], p0[1]), cvtpk_s(p0[2], p0[3]), cvtpk_s(p0[4], p0[5]), cvtpk_s(p0[6], p0[7])};
    pw1 = (u32x4){cvtpk_s(p0[8], p0[9]), cvtpk_s(p0[10], p0[11]), cvtpk_s(p0[12], p0[13]), cvtpk_s(p0[14], p0[15])};
    pw2 = (u32x4){cvtpk_s(p1[0], p1[1]), cvtpk_s(p1[2], p1[3]), cvtpk_s(p1[4], p1[5]), cvtpk_s(p1[6], p1[7])};
    pw3 = (u32x4){cvtpk_s(p1[8], p1[9]), cvtpk_s(p1[10], p1[11]), cvtpk_s(p1[12], p1[13]), cvtpk_s(p1[14], p1[15])};
    pv(o, vb, __builtin_bit_cast(bf16x8, pw0), __builtin_bit_cast(bf16x8, pw1), __builtin_bit_cast(bf16x8, pw2), __builtin_bit_cast(bf16x8, pw3));
}
__device__ __forceinline__ void store_o(const f32x16* o, float l, ALDS float* wsf, ALDS bf16_t* stg, bf16_t* Ow, int lane, int r32, int hi) {
    { auto rr = __builtin_amdgcn_permlane32_swap(__float_as_uint(l), __float_as_uint(l), false, false); l = __uint_as_float(rr[0]) + __uint_as_float(rr[1]); }
    if (hi == 0) wsf[32 + r32] = l;
    asm volatile("s_waitcnt lgkmcnt(0)" ::: "memory");
    float rli[16];
#pragma unroll
    for (int r = 0; r < 16; ++r) rli[r] = __builtin_amdgcn_rcpf(wsf[32 + crow(r, hi)]);
#pragma unroll
    for (int r = 0; r < 16; ++r) { const int orow = crow(r, hi);
#pragma unroll
        for (int d0 = 0; d0 < 2; ++d0) { const float v = o[d0][r] * rli[r]; stg[orow * 64 + d0 * 32 + r32] = (bf16_t)(cvtpk_s(v, v) & 0xffffu); } }
    asm volatile("s_waitcnt lgkmcnt(0)" ::: "memory");
#pragma unroll
    for (int i = 0; i < 4; ++i) { const int row = i * 8 + (lane >> 3), ch = lane & 7; const u32x4 v = *(const ALDS u32x4*)(stg + row * 64 + ch * 8); *(u32x4*)(Ow + (long)row * DM + ch * 8) = v; }
    asm volatile("s_waitcnt lgkmcnt(0)" ::: "memory");
}

__device__ __forceinline__ void store_o2(const f32x16* o, const f32x16& lsum, ALDS bf16_t* stg, bf16_t* Ow, int lane, int r32, int hi) {
#pragma unroll
    for (int r = 0; r < 16; ++r) { const int orow = crow(r, hi); const float rl = __builtin_amdgcn_rcpf(lsum[r]);
#pragma unroll
        for (int d0 = 0; d0 < 2; ++d0) { const float v = o[d0][r] * rl; stg[orow * 64 + d0 * 32 + r32] = (bf16_t)(cvtpk_s(v, v) & 0xffffu); } }
    asm volatile("s_waitcnt lgkmcnt(0)" ::: "memory");
#pragma unroll
    for (int i = 0; i < 4; ++i) { const int row = i * 8 + (lane >> 3), ch = lane & 7; const u32x4 v = *(const ALDS u32x4*)(stg + row * 64 + ch * 8); *(u32x4*)(Ow + (long)row * DM + ch * 8) = v; }
    asm volatile("s_waitcnt lgkmcnt(0)" ::: "memory");
}

constexpr int FX_K = 0, FX_V = 3 * SLOTB, FX_WS = 6 * SLOTB, FX_OST = FX_WS + 2048, FX_C2 = FX_OST + 8 * 4096, FX_WT = FX_C2 + SEQ * 4, FX_KA = FX_WT + 64, FX_Z = FX_KA + SEQ * 16, FX_END = FX_Z + 64;
__device__ __forceinline__ void kload8(bf16x8* kf, lds_cptr kp) {
    kf[0] = *(const ALDS bf16x8*)(kp);        kf[1] = *(const ALDS bf16x8*)(kp + 512);
    kf[2] = *(const ALDS bf16x8*)(kp + 2048); kf[3] = *(const ALDS bf16x8*)(kp + 2560);
    kf[4] = *(const ALDS bf16x8*)(kp + 4096); kf[5] = *(const ALDS bf16x8*)(kp + 4608);
    kf[6] = *(const ALDS bf16x8*)(kp + 6144); kf[7] = *(const ALDS bf16x8*)(kp + 6656);
}
__device__ __forceinline__ void kload2(bf16x8* kf, lds_cptr kp, int j) { kf[2 * j] = *(const ALDS bf16x8*)(kp + j * 2048); kf[2 * j + 1] = *(const ALDS bf16x8*)(kp + j * 2048 + 512); }
__device__ __forceinline__ s16x4 vtr(lds_cptr p) { return __builtin_bit_cast(s16x4, __builtin_amdgcn_ds_read_tr16_b64_v4i16((ALDS v4i16_t*)p)); }
__device__ __forceinline__ void fox_prepare(int b, int h, const float* logf2, lds_ptr shm) {
    int tid = threadIdx.x; asm volatile("" : "+v"(tid));
    const int lane = tid & 63; const int wid = __builtin_amdgcn_readfirstlane(tid >> 6);
    ALDS float* c2s = (ALDS float*)(shm + FX_C2); ALDS float* wtot = (ALDS float*)(shm + FX_WT);
    const float* lf = logf2 + (size_t)(b * 16 + h) * SEQ;
    const f32x4 v = *(const f32x4*)(lf + 4 * tid);
    const float a0 = v[0], a1 = a0 + v[1], a2 = a1 + v[2], a3 = a2 + v[3];
    float x = a3;
#pragma unroll
    for (int ofs = 1; ofs < 64; ofs <<= 1) { const int src = lane >= ofs ? lane - ofs : lane; const float y = __uint_as_float(__builtin_amdgcn_ds_bpermute(src << 2, __float_as_uint(x))); if (lane >= ofs) x += y; }
    if (lane == 63) wtot[wid] = x;
    ATT_WAIT_BAR(0);
    float off = 0.f;
#pragma unroll
    for (int w = 0; w < 8; ++w) { const float tw = wtot[w]; if (w < wid) off += tw; }
    const float ex = off + x - a3;
    *(ALDS f32x4*)(c2s + 4 * tid) = (f32x4){ex + a0, ex + a1, ex + a2, ex + a3};
    { const float cc[4] = {ex + a0, ex + a1, ex + a2, ex + a3};
#pragma unroll
      for (int j = 0; j < 4; ++j) { const float v0 = -cc[j];
          const unsigned h1 = cvtpk_s(v0, 0.f) & 0xffffu; const float r1 = v0 - __uint_as_float(h1 << 16);
          const unsigned h2 = cvtpk_s(r1, 0.f) & 0xffffu; const float r2 = r1 - __uint_as_float(h2 << 16);
          const unsigned h3 = cvtpk_s(r2, 0.f) & 0xffffu;
          *(ALDS u32x4*)(shm + FX_KA + (4 * tid + j) * 16) = (u32x4){h1 | (h2 << 16), h3 | 0x3F800000u, 0x3F803F80u, 0u}; }
      if (tid < 4) *(ALDS unsigned*)(shm + FX_Z + 4 * tid) = 0u; }
    ATT_WAIT_BAR(0);
}
constexpr long PNL = 1048576, SLT = 262144;
__device__ __forceinline__ void fox_cu(int h, int sel, bf16_t* PB, lds_ptr shm, float nB2) {
#define QBOF(i) (sel == 0 ? ((i) == 0 ? 7 : (i) == 1 ? 4 : (i) == 2 ? 3 : 0) : ((i) == 0 ? 6 : (i) == 1 ? 5 : (i) == 2 ? 2 : 1))
#define SLOT(t) ((((s0) + (t)) % 3) * SLOTB)
#define LOADQ(dst, qb_) do { const bf16_t* Qw_ = PB + (qb_) * PNL + (long)(wid * 32) * DM + h * 64; _Pragma("unroll") for (int d0 = 0; d0 < 4; ++d0) dst[d0] = *(const bf16x8*)(Qw_ + (long)r32 * DM + d0 * 16 + hi * 8); } while (0)
    int s0 = 0;
    bf16x8 qr[4];
    for (int ui = 0; ui < 4; ++ui) {
    int tid = threadIdx.x; asm volatile("" : "+v"(tid));
    const int lane = tid & 63, r32 = lane & 31, hi = lane >> 5; const int wid = __builtin_amdgcn_readfirstlane(tid >> 6);
    const bf16_t* Kh = PB + SLT + h * 64; const bf16_t* Vh = PB + 2 * SLT + h * 64;
    const unsigned lds0 = (unsigned)(uintptr_t)shm;
    ALDS float* wsf = (ALDS float*)(shm + FX_WS) + wid * 64;
    const ALDS float* c2s = (const ALDS float*)(shm + FX_C2);
    const bf16_t* ksrc = Kh + (long)lane * DM + wid * 8;
    const bf16_t* vsrc = Vh + (long)(16 * (wid & 3) + (lane >> 2)) * DM + (wid >> 2) * 32 + (lane & 3) * 8;
    const unsigned kdst = lds0 + FX_K + wid * 1024, vdst = lds0 + FX_V + wid * 1024;
#define TOFF(t) ((long)((t) >> 2) * PNL + (long)((t) & 3) * 64 * DM)
#define DMA_K(t, slot) glds16(ksrc + TOFF(t), (unsigned)__builtin_amdgcn_readfirstlane(kdst + (slot)))
#define DMA_V(t, slot) glds16(vsrc + TOFF(t), (unsigned)__builtin_amdgcn_readfirstlane(vdst + (slot)))
    const int vb0 = (int)(lds0 + FX_V) + ((lane >> 4) & 1) * 32 + (lane & 3) * 8 + (4 * hi + ((lane & 15) >> 2)) * 64;
    const lds_cptr shm3 = (lds_cptr)shm; const lds_cptr kp0 = shm3 + FX_K + hi * 1024 + r32 * 16; const lds_cptr vp0 = shm3 + FX_V + ((lane >> 4) & 1) * 32 + (lane & 3) * 8 + (4 * hi + ((lane & 15) >> 2)) * 64;
    bf16x8 kf[8], kaf[2];
    const lds_cptr kab = hi ? shm3 + FX_Z : shm3 + FX_KA + r32 * 16; const int kats = hi ? 0 : 1024, kah = hi ? 0 : 512;
#define KALD(t) do { kaf[0] = *(const ALDS bf16x8*)(kab + (t) * kats); kaf[1] = *(const ALDS bf16x8*)(kab + (t) * kats + kah); } while (0)
    if (ui == 0) { DMA_K(0, SLOT(0)); DMA_V(0, SLOT(0)); DMA_K(1, SLOT(1)); LOADQ(qr, QBOF(0)); DMA_K(2, SLOT(2)); }
    const int qb = QBOF(ui), q0 = qb * 256;
    const int NT = (q0 + 256) / 64;
    f32x16 lacc, o[2];
    bf16x8 ones; { _Pragma("unroll") for (int j = 0; j < 8; ++j) ones[j] = (short)0x3F80; } asm volatile("" : "+v"(ones));
#pragma unroll
    for (int r = 0; r < 16; ++r) { o[0][r] = 0.f; o[1][r] = 0.f; lacc[r] = 0.f; }
    const int qrel = wid * 32 + r32;
    bf16x8 qaug;
    { const float cq = c2s[q0 + qrel] + nB2;
      const unsigned g1 = cvtpk_s(cq, 0.f) & 0xffffu; const float r1 = cq - __uint_as_float(g1 << 16);
      const unsigned g2 = cvtpk_s(r1, 0.f) & 0xffffu; const float r2 = r1 - __uint_as_float(g2 << 16);
      const unsigned g3 = cvtpk_s(r2, 0.f) & 0xffffu;
      qaug = __builtin_bit_cast(bf16x8, (u32x4){0x3F803F80u, 0x3F80u | (g1 << 16), g2 | (g3 << 16), 0u}); }
    const f32x16 zero16 = (f32x16){0.f, 0.f, 0.f, 0.f, 0.f, 0.f, 0.f, 0.f, 0.f, 0.f, 0.f, 0.f, 0.f, 0.f, 0.f, 0.f};
#define THR(t) ((t) >= NT - 4 ? qrel - 4 * hi - 64 * ((t) - (NT - 4)) : 4096)
#define CMASK4(X, B, G, thr_) do { float tf_ = (float)((thr_) + 1); asm volatile("" : "+v"(tf_));   \
      _Pragma("unroll") for (int e = 0; e < 4; ++e) X[(B) + e] *= __builtin_fminf(__builtin_fmaxf(tf_ - (float)(8 * ((G) & 3) + 32 * ((G) >> 2) + e), 0.f), 1.f); } while (0)
    f32x16 pA0, pA1, pB0, pB1;
    int sl_prev = SLOT(0), sl_cur = SLOT(0), sl_next = SLOT(1);
#define ROT() do { sl_prev = sl_cur; sl_cur = sl_next; sl_next = (sl_next == 2 * SLOTB) ? 0 : sl_next + SLOTB; } while (0)
    ATT_WAIT_BAR(3);
    KALD(0);
    { const f32x16 d0_ = __builtin_amdgcn_mfma_f32_32x32x16_bf16(kaf[0], qaug, zero16, 0, 0, 0), d1_ = __builtin_amdgcn_mfma_f32_32x32x16_bf16(kaf[1], qaug, zero16, 0, 0, 0); qkt2(pA0, pA1, kp0 + SLOT(0), qr, d0_, d1_); }
#pragma unroll
    for (int r = 0; r < 16; ++r) { pA0[r] = __builtin_amdgcn_exp2f(pA0[r]); pA1[r] = __builtin_amdgcn_exp2f(pA1[r]); }
    { const int thr0 = THR(0);
#pragma unroll
      for (int g = 0; g < 4; ++g) { CMASK4(pA0, 4 * g, g, thr0); CMASK4(pA1, 4 * g, 4 + g, thr0); } }
    ATT_WAIT_BAR(0);
    DMA_K(3, SLOT(0)); DMA_V(1, SLOT(1));
    ROT();
    kload8(kf, kp0 + sl_cur); KALD(1);
    ATT_WAIT_BAR(2);
    s16x4 vlo[8], vhi[8]; u32x4 pw0, pw1, pw2, pw3;
#define PKW(P, B) cvtpk_s(P[B], P[B + 1])
#define PAF(k) __builtin_bit_cast(bf16x8, pw##k)
#define VFR(i) (bf16x8){vlo[i][0], vlo[i][1], vlo[i][2], vlo[i][3], vhi[i][0], vhi[i][1], vhi[i][2], vhi[i][3]}
#define PIN(x) asm volatile("" : "+v"(x))
#define MFMA32(a, b, c) __builtin_amdgcn_mfma_f32_32x32x16_bf16(a, b, c, 0, 0, 0)
#define GAPA(MF, A0, A1, A2, A3, W0, W1, PW) do { MF; W0; W1; PIN(PW); ATT_SBAR(); } while (0)
#define EX(v) __builtin_amdgcn_exp2f(v)
#define GAPB(MF, X, B, BAND, G) do { MF; X[B] = EX(X[B]); X[B + 1] = EX(X[B + 1]); X[B + 2] = EX(X[B + 2]); X[B + 3] = EX(X[B + 3]); if (BAND) CMASK4(X, B, G, thr_); PIN(X); ATT_SBAR(); } while (0)
#define VRD(i) do { vlo[i] = vtr(vp_ + (((i) >> 2) * 4096 + ((i) & 3) * 1024)); vhi[i] = vtr(vp_ + (((i) >> 2) * 4096 + ((i) & 3) * 1024 + 512)); } while (0)
#define KRD(G, j) do { if (G) { kload2(kf, kp0 + sl_next, j); ATT_SBAR(); } } while (0)
#define STEP(C0, C1, P0, P1, t, GK, GV, GL, BAND) do { ATT_SBAR(); \
    const lds_cptr vp_ = vp0 + sl_prev; \
    C0 = MFMA32(kaf[0], qaug, zero16); C1 = MFMA32(kaf[1], qaug, zero16); \
    VRD(0); ATT_SBAR(); \
    GAPA(C0 = MFMA32(kf[0], qr[0], C0), P0[2], P0[3], P0[4], P0[5],     pw0[0] = PKW(P0, 0), pw0[1] = PKW(P0, 2), pw0); \
    VRD(4); ATT_SBAR(); GAPA(C1 = MFMA32(kf[1], qr[0], C1), P0[6], P0[7], P0[8], P0[9],     pw0[2] = PKW(P0, 4), pw0[3] = PKW(P0, 6), pw0); \
    VRD(1); ATT_SBAR(); GAPA(C0 = MFMA32(kf[2], qr[1], C0),  P0[10], P0[11], P0[12], P0[13], pw1[0] = PKW(P0, 8), pw1[1] = PKW(P0, 10), pw1); \
    VRD(5); ATT_SBAR(); GAPA(C1 = MFMA32(kf[3], qr[1], C1),  P0[14], P0[15], P1[0], P1[1],   pw1[2] = PKW(P0, 12), pw1[3] = PKW(P0, 14), pw1); \
    VRD(2); ATT_SBAR(); GAPA(C0 = MFMA32(kf[4], qr[2], C0),  P1[2], P1[3], P1[4], P1[5],     pw2[0] = PKW(P1, 0), pw2[1] = PKW(P1, 2), pw2); \
    VRD(6); ATT_SBAR(); GAPA(C1 = MFMA32(kf[5], qr[2], C1),  P1[6], P1[7], P1[8], P1[9],     pw2[2] = PKW(P1, 4), pw2[3] = PKW(P1, 6), pw2); \
    VRD(3); ATT_SBAR(); GAPA(C0 = MFMA32(kf[6], qr[3], C0),  P1[10], P1[11], P1[12], P1[13], pw3[0] = PKW(P1, 8), pw3[1] = PKW(P1, 10), pw3); \
    VRD(7); ATT_SBAR(); GAPA(C1 = MFMA32(kf[7], qr[3], C1),  P1[14], P1[15], 0.f, 0.f,       pw3[2] = PKW(P1, 12), pw3[3] = PKW(P1, 14), pw3); \
    if (GK) { DMA_K((t) + 3, sl_cur); } if (GV) { DMA_V((t) + 1, sl_next); } \
    const int thr_ = (BAND) ? THR(t) : 0; \
    ATT_SBAR(); \
    GAPB(o[0] = MFMA32(PAF(0), VFR(0), o[0]), C0, 0, BAND, 0); \
    GAPB(o[1] = MFMA32(PAF(0), VFR(4), o[1]); lacc = MFMA32(PAF(0), ones, lacc), C0, 4, BAND, 1); \
    KRD(GL, 0); GAPB(o[0] = MFMA32(PAF(1), VFR(1), o[0]), C0, 8, BAND, 2); \
    KRD(GL, 1); GAPB(o[1] = MFMA32(PAF(1), VFR(5), o[1]); lacc = MFMA32(PAF(1), ones, lacc), C0, 12, BAND, 3); \
    KRD(GL, 2); GAPB(o[0] = MFMA32(PAF(2), VFR(2), o[0]), C1, 0, BAND, 4); \
    KRD(GL, 3); GAPB(o[1] = MFMA32(PAF(2), VFR(6), o[1]); lacc = MFMA32(PAF(2), ones, lacc), C1, 4, BAND, 5); \
    if (GL) { KALD((t) + 1); ATT_SBAR(); } GAPB(o[0] = MFMA32(PAF(3), VFR(3), o[0]), C1, 8, BAND, 6); \
    GAPB(o[1] = MFMA32(PAF(3), VFR(7), o[1]); lacc = MFMA32(PAF(3), ones, lacc), C1, 12, BAND, 7); \
    } while (0)
    int t = 1;
    for (; t + 5 < NT; t += 2) {
        STEP(pB0, pB1, pA0, pA1, t, true, true, true, false);     ATT_WAIT_BAR(2); ROT();
        STEP(pA0, pA1, pB0, pB1, t + 1, true, true, true, false); ATT_WAIT_BAR(2); ROT();
    }
#define ENDW(tt) do { if ((tt) + 3 < NT) { ATT_WAIT_BAR(2); } else if ((tt) + 2 < NT) { ATT_WAIT_BAR(1); } else { ATT_WAIT_BAR(0); } } while (0)
    for (; t + 1 < NT; t += 2) {
        STEP(pB0, pB1, pA0, pA1, t, (t + 3 < NT), (t + 1 < NT), (t + 1 < NT), true);         ENDW(t);     ROT();
        STEP(pA0, pA1, pB0, pB1, t + 1, (t + 4 < NT), (t + 2 < NT), (t + 2 < NT), true);     ENDW(t + 1); ROT();
    }
    STEP(pB0, pB1, pA0, pA1, NT - 1, false, false, false, true);
    bf16x8 qn[4];
    const int s0n = (s0 + NT) % 3;
    if (ui < 3) { const int s0k = s0; s0 = s0n; DMA_K(0, SLOT(0)); DMA_V(0, SLOT(0)); DMA_K(1, SLOT(1)); LOADQ(qn, QBOF(ui + 1)); DMA_K(2, SLOT(2)); s0 = s0k; }
    {
      pw0 = (u32x4){PKW(pB0, 0), PKW(pB0, 2), PKW(pB0, 4), PKW(pB0, 6)}; pw1 = (u32x4){PKW(pB0, 8), PKW(pB0, 10), PKW(pB0, 12), PKW(pB0, 14)};
      pw2 = (u32x4){PKW(pB1, 0), PKW(pB1, 2), PKW(pB1, 4), PKW(pB1, 6)}; pw3 = (u32x4){PKW(pB1, 8), PKW(pB1, 10), PKW(pB1, 12), PKW(pB1, 14)};
      ATT_SBAR(); pv(o, vb0 + sl_cur, PAF(0), PAF(1), PAF(2), PAF(3));
      lacc = MFMA32(PAF(0), ones, lacc); lacc = MFMA32(PAF(1), ones, lacc); lacc = MFMA32(PAF(2), ones, lacc); lacc = MFMA32(PAF(3), ones, lacc); }
    store_o2(o, lacc, (ALDS bf16_t*)(shm + FX_OST) + wid * 2048, PB + qb * PNL + 3 * SLT + (long)(wid * 32) * DM + h * 64, lane, r32, hi);
    ATT_LGKM_BAR();
    if (ui < 3) {
#pragma unroll
        for (int d0 = 0; d0 < 4; ++d0) qr[d0] = qn[d0];
    }
    s0 = s0n;
    }
#undef QBOF
#undef SLOT
#undef LOADQ
#undef DMA_K
#undef DMA_V
#undef TOFF
#undef KALD
#undef THR
#undef CMASK4

#undef ROT
#undef PKW
#undef PAF
#undef VFR
#undef PIN
#undef MFMA32
#undef GAPA
#undef EX
#undef GAPB
#undef VRD
#undef KRD
#undef STEP
#undef ENDW
}

__device__ __forceinline__ int t5_bucket(int n) {
    if (n < 16) return n;
    int b = 16;
    b += (n >= 19); b += (n >= 21); b += (n >= 24); b += (n >= 27); b += (n >= 31); b += (n >= 35); b += (n >= 40); b += (n >= 46);
    b += (n >= 52); b += (n >= 59); b += (n >= 67); b += (n >= 77); b += (n >= 87); b += (n >= 99); b += (n >= 113);
    return b;
}
constexpr int SW_K = 0, SW_V = 4 * SLOTB, SW_WS = 8 * SLOTB, SW_OST = SW_WS + 2048, SW_TBL = SW_OST + 8 * 4096, SW_MB = SW_TBL + 8 * 384 * 4, SW_END = SW_MB + 64;
__device__ __forceinline__ void swa_unit(int b, int kvh, int qblk, const bf16_t* Q, const bf16_t* KV, bf16_t* O, const float* sinks, const float* relb, lds_ptr shm, float qkb) {
    int tid = threadIdx.x; asm volatile("" : "+v"(tid));
    const int lane = tid & 63, r32 = lane & 31, hi = lane >> 5; const int wid = __builtin_amdgcn_readfirstlane(tid >> 6);
    const long rowbase = (long)b * SEQ; const int q0 = qblk * 128; const int jt0 = qblk == 0 ? 2 : 0;
    const unsigned lds0 = (unsigned)(uintptr_t)shm;
    const long band0 = rowbase + q0 - 128;
    {
        const long krow = band0 + lane, vrow = band0 + 16 * (wid & 3) + (lane >> 2);
        for (int jt = jt0; jt < 4; ++jt) {
            glds16(KV + (krow + 64 * jt) * 256 + kvh * 64 + wid * 8, (unsigned)__builtin_amdgcn_readfirstlane(lds0 + SW_K + jt * SLOTB + wid * 1024));
            glds16(KV + (vrow + 64 * jt) * 256 + 128 + kvh * 64 + (wid >> 2) * 32 + (lane & 3) * 8, (unsigned)__builtin_amdgcn_readfirstlane(lds0 + SW_V + jt * SLOTB + wid * 1024));
        }
    }
#define SW_LOADQ(dst, round_) do { const bf16_t* Qw_ = Q + (rowbase + q0 + 32 * (wid & 3)) * DM + (kvh * 8 + 2 * (round_) + (wid >> 2)) * 64; \
      _Pragma("unroll") for (int d0 = 0; d0 < 4; ++d0) dst[d0] = *(const bf16x8*)(Qw_ + (long)r32 * DM + d0 * 16 + hi * 8); } while (0)
    bf16x8 qc[4], qn[4];
    SW_LOADQ(qc, 0);
    ALDS float* tbl = (ALDS float*)(shm + SW_TBL); ALDS float* mb = (ALDS float*)(shm + SW_MB);
    if (tid < 8) { const int hh = kvh * 8 + tid; float m = relb[hh];
        for (int bk = 1; bk < 32; ++bk) m = fmaxf(m, relb[bk * 16 + hh]);
        mb[tid] = m * LOG2E; }
    ATT_LGKM_BAR();
    for (int idx = tid; idx < 8 * 384; idx += 512) { const int g = idx / 384, di = idx - g * 384, dist = di - 127;
        float v = -INFINITY; if (dist >= 0 && dist < 128) v = relb[t5_bucket(dist) * 16 + kvh * 8 + g] * LOG2E - (qkb + mb[g]);
        tbl[idx] = v; }
    ATT_WAIT_BAR(0);
    const int wq = wid & 3;
    ALDS float* wsf = (ALDS float*)(shm + SW_WS) + wid * 64;
    const lds_cptr kp0 = (lds_cptr)shm + SW_K + hi * 1024 + r32 * 16;
    const lds_cptr vp0 = (lds_cptr)shm + SW_V + ((lane >> 4) & 1) * 32 + (lane & 3) * 8 + (4 * hi + ((lane & 15) >> 2)) * 64;
    const int jbase = wq >> 1;
#define SW_SCORES(p0, p1, jt_) do { f32x16 c0_, c1_; const ALDS float* tj_ = tb - 64 * (jt_); \
        _Pragma("unroll") for (int r = 0; r < 16; ++r) { c0_[r] = tj_[-((r & 3) + 8 * (r >> 2))]; c1_[r] = tj_[-((r & 3) + 8 * (r >> 2)) - 32]; } \
        qkt2(p0, p1, kp0 + (jt_) * SLOTB, qc, c0_, c1_); } while (0)
#define SW_SOFT(p0, p1) do { \
        _Pragma("unroll") for (int r = 0; r < 16; ++r) { p0[r] = __builtin_amdgcn_exp2f(p0[r]); p1[r] = __builtin_amdgcn_exp2f(p1[r]); } \
        pw[0] = (u32x4){cvtpk_s(p0[0], p0[1]), cvtpk_s(p0[2], p0[3]), cvtpk_s(p0[4], p0[5]), cvtpk_s(p0[6], p0[7])}; \
        pw[1] = (u32x4){cvtpk_s(p0[8], p0[9]), cvtpk_s(p0[10], p0[11]), cvtpk_s(p0[12], p0[13]), cvtpk_s(p0[14], p0[15])}; \
        pw[2] = (u32x4){cvtpk_s(p1[0], p1[1]), cvtpk_s(p1[2], p1[3]), cvtpk_s(p1[4], p1[5]), cvtpk_s(p1[6], p1[7])}; \
        pw[3] = (u32x4){cvtpk_s(p1[8], p1[9]), cvtpk_s(p1[10], p1[11]), cvtpk_s(p1[12], p1[13]), cvtpk_s(p1[14], p1[15])}; } while (0)
#define SW_PV(jt_) do { const lds_cptr vp_ = vp0 + (jt_) * SLOTB; \
        _Pragma("unroll") for (int d0 = 0; d0 < 2; ++d0) { s16x4 vl[4], vh[4]; \
            _Pragma("unroll") for (int ks = 0; ks < 4; ++ks) { vl[ks] = vtr(vp_ + d0 * 4096 + ks * 1024); vh[ks] = vtr(vp_ + d0 * 4096 + ks * 1024 + 512); } \
            _Pragma("unroll") for (int ks = 0; ks < 4; ++ks) o[d0] = __builtin_amdgcn_mfma_f32_32x32x16_bf16(__builtin_bit_cast(bf16x8, pw[ks]), \
                (bf16x8){vl[ks][0], vl[ks][1], vl[ks][2], vl[ks][3], vh[ks][0], vh[ks][1], vh[ks][2], vh[ks][3]}, o[d0], 0, 0, 0); } \
        _Pragma("unroll") for (int ks = 0; ks < 4; ++ks) lacc = __builtin_amdgcn_mfma_f32_32x32x16_bf16(__builtin_bit_cast(bf16x8, pw[ks]), ones, lacc, 0, 0, 0);     \
        } while (0)
    bf16x8 ones; { _Pragma("unroll") for (int j = 0; j < 8; ++j) ones[j] = (short)0x3F80; } asm volatile("" : "+v"(ones));
#pragma unroll
    for (int round = 0; round < 4; ++round) {
        const int g = 2 * round + (wid >> 2), hh = kvh * 8 + g;
        if (round < 3) SW_LOADQ(qn, round + 1);
        const float B2 = qkb + mb[g];
        const float lsink = __builtin_amdgcn_exp2f(sinks[hh] * LOG2E - B2);
        f32x16 o[2], lacc;
#pragma unroll
        for (int r = 0; r < 16; ++r) { o[0][r] = 0.f; o[1][r] = 0.f; lacc[r] = lsink; }
        const ALDS float* tb = tbl + g * 384 + (255 + 32 * wq + r32 - 4 * hi);
        u32x4 pw[4];
        if (jt0 == 0) {
            f32x16 a0, a1, b0, b1;
            SW_SCORES(a0, a1, jbase); SW_SCORES(b0, b1, jbase + 1);
            SW_SOFT(a0, a1); SW_PV(jbase);
            SW_SCORES(a0, a1, jbase + 2);
            SW_SOFT(b0, b1); SW_PV(jbase + 1);
            SW_SOFT(a0, a1); SW_PV(jbase + 2);
        } else {
#pragma unroll
            for (int k = 0; k < 3; ++k) { const int jt = jbase + k;
                if (jt >= jt0) { f32x16 a0, a1; SW_SCORES(a0, a1, jt); SW_SOFT(a0, a1); SW_PV(jt); } }
        }
        store_o2(o, lacc, (ALDS bf16_t*)(shm + SW_OST) + wid * 2048, O + (rowbase + q0 + 32 * wq) * DM + hh * 64, lane, r32, hi);
        if (round < 3) {
#pragma unroll
            for (int d0 = 0; d0 < 4; ++d0) qc[d0] = qn[d0];
        }
    }
#undef SW_SCORES
#undef SW_SOFT
#undef SW_PV
#undef SW_LOADQ
    ATT_LGKM_BAR();
}
#undef ALDS
}
#define GAS __attribute__((address_space(1)))
#define LAS __attribute__((address_space(3)))
typedef unsigned short bf16;
typedef unsigned v4u __attribute__((ext_vector_type(4)));
typedef float f32x4 __attribute__((ext_vector_type(4)));
typedef short bf16x8 __attribute__((ext_vector_type(8)));
typedef GAS unsigned gu32;
typedef GAS unsigned long long gu64;
#define RLX_AGENT __ATOMIC_RELAXED, __HIP_MEMORY_SCOPE_AGENT
#define LDS_WAIT() asm volatile("s_waitcnt lgkmcnt(0)" ::: "memory")
#define VM_WAIT() asm volatile("s_waitcnt vmcnt(0)" ::: "memory")
__device__ __forceinline__ unsigned long long rt() { return __builtin_amdgcn_s_memrealtime(); }
__device__ __forceinline__ unsigned f2bf(float f) { unsigned u = __builtin_bit_cast(unsigned, f); return (u + 0x7fffu + ((u >> 16) & 1u)) >> 16; }
__device__ __forceinline__ unsigned pk2(float lo, float hi) { return f2bf(lo) | (f2bf(hi) << 16); }

#define XB_TMO      128
#define XB_XCNT(j)  (256  + 64 * (j))
#define XB_XSUB(j)  (1280 + 64 * (j))
#define XB_XGEN(j)  (2304 + 64 * (j))
#define XB_TOP      3328
#define XB_TOPGEN   3392
#define XCD_BAR_WORDS 3456
#define XB_SPIN_CAP (1u << 18)

__device__ __forceinline__ unsigned xb_ld(unsigned* p)              { return __hip_atomic_load(p, __ATOMIC_RELAXED, __HIP_MEMORY_SCOPE_AGENT); }
__device__ __forceinline__ unsigned xb_add(unsigned* p, unsigned v) { return __hip_atomic_fetch_add(p, v, __ATOMIC_RELAXED, __HIP_MEMORY_SCOPE_AGENT); }
__device__ __forceinline__ unsigned xb_xcc_id() { return (unsigned)__builtin_amdgcn_s_getreg((3 << 11) | 20) & 0xFu; }
#define XB_SPIN(cond, bar) do { unsigned _sp = 0; while (cond) { __builtin_amdgcn_s_sleep(1); \
    if ((++_sp & 255u) == 0u) { if (xb_ld(&(bar)[XB_TMO])) break; if (_sp > XB_SPIN_CAP) { atomicAdd(&(bar)[XB_TMO], 1u); break; } } } } while (0)

struct XcdBarrier {
    unsigned* bar; unsigned x; unsigned G; bool nowb;
    volatile LAS unsigned* st;
};

__device__ __forceinline__ XcdBarrier xcd_barrier_post(unsigned* bar, volatile LAS unsigned* st, unsigned G) {
    XcdBarrier b; b.bar = bar; b.x = xb_xcc_id(); b.st = st; b.G = G; b.nowb = false;
    if (threadIdx.x == 0) (void)xb_add(&bar[XB_XCNT(b.x)], 1u);
    return b;
}
__device__ __forceinline__ void xcd_barrier_complete(unsigned* bar, unsigned x, unsigned G, unsigned& nloc, unsigned& nx) {
    unsigned sum, cnt, mine, sp = 0u;
    for (;;) {
        sum = 0u; cnt = 0u; mine = 0u;
#pragma unroll
        for (unsigned j = 0; j < 16; ++j) { const unsigned c = xb_ld(&bar[XB_XCNT(j)]); sum += c; cnt += (c > 0u) ? 1u : 0u; mine = (j == x) ? c : mine; }
        if (sum == G) break;
        __builtin_amdgcn_s_sleep(1);
        if ((++sp & 255u) == 0u) { if (xb_ld(&bar[XB_TMO])) break; if (sp > XB_SPIN_CAP) { atomicAdd(&bar[XB_TMO], 1u); break; } }
    }
    nloc = mine > 0u ? mine : 1u; nx = cnt > 0u ? cnt : 1u;
}

__device__ __forceinline__ void xcd_barrier(const XcdBarrier& b) {
    asm volatile("s_waitcnt vmcnt(0)" ::: "memory");
    __syncthreads();
    if (threadIdx.x == 0) {
        unsigned* bar = b.bar;
        __builtin_amdgcn_s_waitcnt(0);
        unsigned nloc = b.st[0], nx = b.st[1];
        if (nloc == 0u) { xcd_barrier_complete(bar, b.x, b.G, nloc, nx); b.st[0] = nloc; b.st[1] = nx; }
        const unsigned old = xb_add(&bar[XB_XSUB(b.x)], 1u);
        const unsigned gen = old / nloc;
        if (nx == 1u && b.G <= 32u) {
            const unsigned target = (gen + 1u) * nloc;
            XB_SPIN(xb_ld(&bar[XB_XSUB(b.x)]) < target, bar);
            __builtin_amdgcn_fence(__ATOMIC_ACQUIRE, "agent");
            asm volatile("s_waitcnt vmcnt(0)" ::: "memory");
        } else
        if (old + 1u == (gen + 1u) * nloc) {
            if ((nx > 1u || b.G > 32u) && !b.nowb) {
            __builtin_amdgcn_fence(__ATOMIC_RELEASE, "agent");
            asm volatile("s_waitcnt vmcnt(0)" ::: "memory");
            }
            const unsigned og = xb_add(&bar[XB_TOP], 1u);
            const unsigned tg = og / nx;
            if (og + 1u == (tg + 1u) * nx) xb_add(&bar[XB_TOPGEN], 1u);
            else XB_SPIN(xb_ld(&bar[XB_TOPGEN]) == tg, bar);
            __builtin_amdgcn_fence(__ATOMIC_ACQUIRE, "agent");
            xb_add(&bar[XB_XGEN(b.x)], 1u);
            asm volatile("s_waitcnt vmcnt(0)" ::: "memory");
        } else {
            XB_SPIN(xb_ld(&bar[XB_XGEN(b.x)]) == gen, bar);
            __builtin_amdgcn_fence(__ATOMIC_ACQUIRE, "agent");
            asm volatile("s_waitcnt vmcnt(0)" ::: "memory");
        }
    }
    __syncthreads();
}

constexpr int NWAVES = 8;
#ifndef MK_SPLIT
#define MK_SPLIT 0
#endif
constexpr int NPHASE = 11;
#ifndef MK_REP
#define MK_REP 0
#endif
#define REPN(k) (1 + ((MK_REP >> (k)) & 1))
#define DRYGEMM(k, g, S) do { if ((MK_REP >> (k)) & 1) { pg8::EpiDry Ed; pg8::gemm_phase<pg8::EpiDry, pg8::StaticOrder, PG8_ALIGN, PG8_SP2>(ring, g, S, Ed); } } while (0)
#ifndef PG8_SP2
#define PG8_SP2 true
#endif
#ifndef PG8_ALIGN
#define PG8_ALIGN true
#endif

constexpr int NBATCH = 8, SEQ = 2048, D = 1024, H = 16, HD = 64, FF = 4096, NIN = 3088, KVC = 256;
constexpr int M = NBATCH * SEQ;
constexpr int NQKV_A = 3 * D, NQKV_B = D + KVC;

constexpr size_t MiB = 1u << 20;
constexpr size_t WS_CTL = 0, CTL_ZERO_BYTES = 2 * MiB;
constexpr size_t WS_SS = 1536 * 1024;
constexpr size_t WS_WQKV_A = 2 * MiB, WS_WG = 8 * MiB, WS_WO_A = 9 * MiB, WS_WUP0 = 11 * MiB, WS_WDN0 = 19 * MiB, WS_WQKV_B = 27 * MiB, WS_WO_B = 30 * MiB, WS_WUP1 = 32 * MiB, WS_WDN1 = 40 * MiB;
constexpr size_t WS_KVB = 52 * MiB;
constexpr size_t WS_LOGF = 48 * MiB;
constexpr size_t WS_ACT = 64 * MiB;
constexpr size_t WS_H = 64 * MiB;
constexpr size_t WS_XN = 192 * MiB, WS_END = 224 * MiB;
static_assert(WS_SS + 4 * (size_t)M * 4 <= CTL_ZERO_BYTES && WS_WDN1 + (size_t)D * FF * 2 <= WS_LOGF && WS_LOGF + (size_t)NBATCH * H * SEQ * 4 <= WS_KVB && WS_KVB + (size_t)M * KVC * 2 <= WS_ACT && WS_H == WS_ACT && WS_H + (size_t)M * FF * 2 <= WS_XN && WS_XN + (size_t)M * D * 2 <= WS_END, "d_ws map");
constexpr int CW_CONV = 2048, CW_CONV_B = 2112, CW_CONV_0 = 2176, CW_KVD = 2304;
constexpr int CW_BAR = 4096;
static_assert((size_t)(CW_BAR + 73 * 3456) * 4 <= WS_SS, "barrier regions below the ss accumulators");

constexpr int RING_OFF = 0, RING_BYTES = 131072;
constexpr int LDSCTL_OFF = RING_BYTES, MISC_OFF = LDSCTL_OFF + 320;
constexpr int EPI_RR_OFF = LDSCTL_OFF + 1024, EPI_G_OFF = LDSCTL_OFF + 2048;
constexpr int LDS_BYTES = 147456;
static_assert(att::FX_END <= RING_BYTES && att::SW_END <= RING_BYTES, "attention LDS maps fit the ring region");

struct Frame {
    LAS unsigned char* lds;
    volatile LAS unsigned* MISC;
    gu32* ctl;
    int tid, lane, wave;
    int vcu, G;
};
struct Args { const float* in[18]; float* out; unsigned char* ws; int ph_lo, ph_hi; };
#define A_x        (A.in[0])
#define A_g_attn   (A.in[1])
#define A_g_mlp    (A.in[2])
#define A_w_in_a   (A.in[3])
#define A_b_f      (A.in[4])
#define A_gq_a     (A.in[5])
#define A_gk_a     (A.in[6])
#define A_w_out_a  (A.in[7])
#define A_g_kv     (A.in[8])
#define A_w_kv     (A.in[9])
#define A_gk_b     (A.in[10])
#define A_w_q_b    (A.in[11])
#define A_gq_b     (A.in[12])
#define A_sinks    (A.in[13])
#define A_rel_bias (A.in[14])
#define A_w_out_b  (A.in[15])
#define A_w_up     (A.in[16])
#define A_w_down   (A.in[17])
#define WSB(off)   ((bf16*)(A.ws + (off)))
#define WSF(off)   ((float*)(A.ws + (off)))

__device__ __forceinline__ float wave_sum(float v) {
    v += __builtin_bit_cast(float, __builtin_amdgcn_update_dpp(0, __builtin_bit_cast(int, v), 0xB1, 0xF, 0xF, true));
    v += __builtin_bit_cast(float, __builtin_amdgcn_update_dpp(0, __builtin_bit_cast(int, v), 0x4E, 0xF, 0xF, true));
    v += __builtin_bit_cast(float, __builtin_amdgcn_update_dpp(0, __builtin_bit_cast(int, v), 0x141, 0xF, 0xF, true));
    v += __builtin_bit_cast(float, __builtin_amdgcn_update_dpp(0, __builtin_bit_cast(int, v), 0x140, 0xF, 0xF, true));
    { auto r = __builtin_amdgcn_permlane16_swap(__float_as_uint(v), __float_as_uint(v), false, false); v = __uint_as_float(r[0]) + __uint_as_float(r[1]); }
    { auto r = __builtin_amdgcn_permlane32_swap(__float_as_uint(v), __float_as_uint(v), false, false); v = __uint_as_float(r[0]) + __uint_as_float(r[1]); }
    return v;
}
__device__ __forceinline__ float wave_max(float v) {
#pragma unroll
    for (int o = 1; o < 64; o <<= 1) v = fmaxf(v, __shfl_xor(v, o));
    return v;
}
__device__ __forceinline__ int headperm(int n) { return (n & ~255) + 128 * ((n >> 5) & 1) + 32 * ((n >> 6) & 3) + (n & 31); }
template <bool WT_SC1 = false>
__device__ __forceinline__ void p0_transpose_item(const float* W, int ldw, int coff, int K, int N, bf16* WT, int perm, int row_off, const float* g, LAS float* scr, int item, int lane) {
    const int nblk = N / 32, kb = item / nblk, nb = item % nblk, k0 = 64 * kb, n0 = 32 * nb;
    float wv[32];
#pragma unroll
    for (int i = 0; i < 32; ++i) wv[i] = __builtin_nontemporal_load(W + (size_t)(k0 + 2 * i + (lane >> 5)) * ldw + coff + n0 + (lane & 31));
    if (g) {
#pragma unroll
        for (int i = 0; i < 32; ++i) wv[i] *= g[k0 + 2 * i + (lane >> 5)];
    }
#pragma unroll
    for (int i = 0; i < 32; ++i) scr[(2 * i + (lane >> 5)) * 33 + (lane & 31)] = wv[i];
    LDS_WAIT(); asm volatile("" ::: "memory");
    const int c = lane & 7;
#pragma unroll
    for (int j = 0; j < 4; ++j) { const int n = (lane >> 3) + 8 * j; const LAS float* s = scr + (8 * c) * 33 + n;
        v4u o; o.x = pk2(s[0 * 33], s[1 * 33]); o.y = pk2(s[2 * 33], s[3 * 33]); o.z = pk2(s[4 * 33], s[5 * 33]); o.w = pk2(s[6 * 33], s[7 * 33]);
        const int orow = row_off + (perm ? headperm(n0 + n) : (n0 + n));
        if constexpr (WT_SC1) { const __amdgpu_buffer_rsrc_t rs = __builtin_amdgcn_make_buffer_rsrc((void*)WT, 0, 0x7fffffff, 0x00020000);
            __builtin_amdgcn_raw_buffer_store_b128(o, rs, (int)(((size_t)orow * K + k0 + 8 * c) * 2), 0, 16); }
        else *(GAS v4u*)(WT + (size_t)orow * K + k0 + 8 * c) = o; }
    LDS_WAIT(); asm volatile("" ::: "memory");
}
template <int NR> __device__ __forceinline__ void rows_to_bf16(Frame& F, const float* x, bf16* xn, float* ss0, int m0, int stride) {
    f32x4 v[NR][4];
#pragma unroll
    for (int r = 0; r < NR; ++r) { const GAS f32x4* xr = (const GAS f32x4*)(x + (size_t)(m0 + r * stride) * D) + F.lane;
#pragma unroll
        for (int j = 0; j < 4; ++j) v[r][j] = __builtin_nontemporal_load(xr + 64 * j); }
#pragma unroll
    for (int r = 0; r < NR; ++r) { float s = 0.f;
#pragma unroll
        for (int j = 0; j < 4; ++j) s += (v[r][j].x * v[r][j].x + v[r][j].y * v[r][j].y) + (v[r][j].z * v[r][j].z + v[r][j].w * v[r][j].w);
        s = wave_sum(s);
        if (F.lane == 0) ss0[m0 + r * stride] = s;
        GAS unsigned long long* o8 = (GAS unsigned long long*)(xn + (size_t)(m0 + r * stride) * D) + F.lane;
#pragma unroll
        for (int j = 0; j < 4; ++j) o8[64 * j] = (unsigned long long)pk2(v[r][j].x, v[r][j].y) | ((unsigned long long)pk2(v[r][j].z, v[r][j].w) << 32); }
}
constexpr int P0_I1 = (D / 64) * (D / 32), P0_I2 = (D / 64) * (FF / 32), P0_I3 = (FF / 64) * (D / 32), P0_I5 = (D / 64) * (KVC / 32);
constexpr int P0_NLATE = 3 * P0_I1 + 2 * P0_I2 + 2 * P0_I3 + P0_I5, P0_NLATE_A = P0_I1 + P0_I2 + P0_I3;
#ifndef MK_EARLY
#define MK_EARLY 0
#endif
constexpr int P0_EARLY = MK_EARLY;
static_assert(P0_EARLY == 0, "early items: not with the two-part late list");
__device__ __forceinline__ void p0_late_item(Frame& F, const Args& A, LAS float* scr, int r) {
    const float* W; const float* g = nullptr; int ldw, K, N, perm = 0, row_off = 0; size_t wt;
    if (r < P0_I1) { W = A_w_out_a; ldw = D; K = D; N = D; wt = WS_WO_A; }
    else if ((r -= P0_I1) < P0_I2) { W = A_w_up; ldw = FF; K = D; N = FF; wt = WS_WUP0; g = A_g_mlp; }
    else if ((r -= P0_I2) < P0_I3) { W = A_w_down; ldw = D; K = FF; N = D; wt = WS_WDN0; }
    else if ((r -= P0_I3) < P0_I1) { W = A_w_q_b; ldw = D; K = D; N = D; wt = WS_WQKV_B; perm = 1; g = A_g_attn + D; }
    else if ((r -= P0_I1) < P0_I5) { W = A_w_kv; ldw = KVC; K = D; N = KVC; wt = WS_WQKV_B; perm = 1; row_off = D; g = A_g_kv; }
    else if ((r -= P0_I5) < P0_I1) { W = A_w_out_b; ldw = D; K = D; N = D; wt = WS_WO_B; }
    else if ((r -= P0_I1) < P0_I2) { W = A_w_up + (size_t)D * FF; ldw = FF; K = D; N = FF; wt = WS_WUP1; g = A_g_mlp + D; }
    else { r -= P0_I2; W = A_w_down + (size_t)FF * D; ldw = D; K = FF; N = D; wt = WS_WDN1; }
    p0_transpose_item<true>(W, ldw, 0, K, N, WSB(wt), perm, row_off, g, scr, r, F.lane);
}
__device__ __forceinline__ void p0_prologue(Frame& F, const Args& A, bool late) {
    LAS float* scr = (LAS float*)(F.lds + RING_OFF + F.wave * 16384);
    const int gw = F.vcu * NWAVES + F.wave, NGW = F.G * NWAVES;
    constexpr int I0 = (D / 64) * (NQKV_A / 32);
    for (int it = gw; it < I0; it += NGW) p0_transpose_item<true>(A_w_in_a, NIN, 0, D, NQKV_A, WSB(WS_WQKV_A), 1, 0, A_g_attn, scr, it, F.lane);
    for (int it = gw; it < (late ? P0_NLATE : P0_EARLY); it += NGW) p0_late_item(F, A, scr, it);
    for (int e = (F.vcu * NWAVES + F.wave) * 64 + F.lane; e < 16 * D; e += F.G * NWAVES * 64) { const int n = e >> 10, k = e & 1023; __hip_atomic_store(WSB(WS_WG) + e, (bf16)f2bf(A_w_in_a[(size_t)k * NIN + 3 * D + n] * A_g_attn[k]), __ATOMIC_RELAXED, __HIP_MEMORY_SCOPE_AGENT); }
    if (late) for (int m = gw; m < M; m += NGW) rows_to_bf16<1>(F, A_x, WSB(WS_XN), WSF(WS_SS) + 3 * M, m, NGW);
}
__device__ __forceinline__ void p0_rows(Frame& F, const Args& A, int blk) {
    const int m0 = 64 * blk + F.wave;
    rows_to_bf16<4>(F, A_x, WSB(WS_XN), WSF(WS_SS) + 3 * M, m0, 8);
    rows_to_bf16<4>(F, A_x, WSB(WS_XN), WSF(WS_SS) + 3 * M, m0 + 32, 8);
}
#ifndef MK_SLOTS
#define MK_SLOTS 1
#endif
__device__ __forceinline__ int slot_of(int part, int b) {
#if MK_SLOTS == 0
    return part == 0 ? (b >= 4 ? 0 : 1) : 2 + b % 3;
#else
    return b < 4 ? 1 : 2;
#endif
}
__device__ __forceinline__ void copy_slot(Frame& F, const Args& A, int slot, int bb) {
    constexpr int NA = P0_NLATE_A, NB = P0_NLATE - P0_NLATE_A; static_assert(NA % 8 == 0 && NB % 8 == 0, "even eighths");
#pragma unroll 1
    for (int part = 0; part < 2; ++part) {
        if (slot_of(part, bb) != slot) continue;
        const int lo = part == 0 ? (NA / 8) * bb : NA + (NB / 8) * bb, hi = lo + (part == 0 ? NA / 8 : NB / 8);
        __syncthreads();
        LAS float* scr = (LAS float*)(F.lds + RING_OFF + F.wave * 16384);
        for (int it = lo + (F.vcu & 31) * NWAVES + F.wave; it < hi; it += 32 * NWAVES) p0_late_item(F, A, scr, it);
        asm volatile("s_waitcnt vmcnt(0)" ::: "memory"); __syncthreads();
        if (F.tid == 0) __hip_atomic_fetch_add((unsigned*)(F.ctl + (part == 0 ? CW_CONV : CW_CONV_B)), 1u, __ATOMIC_RELAXED, __HIP_MEMORY_SCOPE_AGENT);
    }
}
__device__ __forceinline__ void gate_job(Frame& F, const Args& A, int blk0) {
    const int lane = F.lane, fr = lane & 15, fq = lane >> 4, rg = F.wave & 3, kh = F.wave >> 2;
    for (int blk = blk0; blk < M / 64; blk += F.G) {
        const int row0 = 64 * blk + 16 * rg;
        const bf16* arow = WSB(WS_XN) + (size_t)(row0 + fr) * D + kh * 512 + 8 * fq;
        const bf16* brow = WSB(WS_WG) + (size_t)fr * D + kh * 512 + 8 * fq;
        f32x4 acc = (f32x4){0.f, 0.f, 0.f, 0.f};
#pragma unroll 8
        for (int kk = 0; kk < 16; ++kk) { const bf16x8 a = *(const bf16x8*)(arow + 32 * kk), b = *(const bf16x8*)(brow + 32 * kk); acc = __builtin_amdgcn_mfma_f32_16x16x32_bf16(a, b, acc, 0, 0, 0); }
        LAS f32x4* scr = (LAS f32x4*)(F.lds + RING_OFF) + rg * 64 + lane;
        if (kh == 1) *scr = acc;
        __syncthreads();
        if (kh == 0) { const f32x4 o = *scr; acc += o;
            const float bias = A_b_f[fr];
#pragma unroll
            for (int i = 0; i < 4; ++i) { const float rr = rsqrtf(WSF(WS_SS)[3 * M + row0 + 4 * fq + i] * (1.f / D) + 1e-6f); const float z = acc[i] * rr + bias; const float lf = fminf(z, 0.f) - log1pf(expf(-fabsf(z)));
                const int tok = row0 + 4 * fq + i, bb = tok >> 11, t = tok & (SEQ - 1);
                WSF(WS_LOGF)[(size_t)(bb * H + fr) * SEQ + t] = lf * 1.4426950408889634f; } }
        __syncthreads();
    }
}

__global__ void __launch_bounds__(NWAVES * 64, 2) yoco_fwd(Args A) {
    extern __shared__ __attribute__((aligned(16))) unsigned char lds[];
    Frame F;
    F.lds = (LAS unsigned char*)lds;
    F.MISC = (volatile LAS unsigned*)(F.lds + MISC_OFF);
    F.tid = threadIdx.x; F.lane = F.tid & 63; F.wave = __builtin_amdgcn_readfirstlane(F.tid >> 6);
    F.G = gridDim.x; { const int bx = blockIdx.x; F.vcu = (F.G % 8 == 0) ? (bx % 8) * (F.G / 8) + bx / 8 : bx; }
    F.ctl = (gu32*)(A.ws + WS_CTL);
    for (int u = F.tid; u < (LDS_BYTES - LDSCTL_OFF) / 4; u += NWAVES * 64) ((LAS unsigned*)(F.lds + LDSCTL_OFF))[u] = 0u;
    __syncthreads();
    const int lo = A.ph_lo, hi = A.ph_hi;
    const bool use_bar = (hi - lo) > 1;
    XcdBarrier bar; bar.bar = (unsigned*)(F.ctl + CW_BAR); bar.x = 0; bar.st = nullptr;
    if (use_bar) { bar = xcd_barrier_post((unsigned*)(F.ctl + CW_BAR), F.MISC + 8, (unsigned)F.G); bar.nowb = (F.G == 256); }
    const int bb = (int)(blockIdx.x & 7); const bool batch_sets = (F.G == 256);
    XcdBarrier sbar = bar;
    if (use_bar && batch_sets) sbar = xcd_barrier_post((unsigned*)(F.ctl + CW_BAR) + (1 + bb) * XCD_BAR_WORDS, F.MISC + 10, 32u);
    const int gj = (int)((blockIdx.x >> 3) & 7), gm = (int)(blockIdx.x >> 6);
    XcdBarrier gbar = sbar;
    if (use_bar && batch_sets) gbar = xcd_barrier_post((unsigned*)(F.ctl + CW_BAR) + (9 + bb * 8 + gj) * XCD_BAR_WORDS, F.MISC + 12, 4u);
    unsigned char* const pnl = A.ws + WS_ACT + (size_t)bb * (16 * MiB) + (size_t)gj * (2 * MiB);
    const size_t rp0 = (size_t)(8 * bb + gj) * 256 * 2048;
    bf16* const ACT_Q = (bf16*)(pnl - rp0); bf16* const ACT_OA = (bf16*)(pnl + 3 * 512 * 1024 - rp0);
    bf16* const ACT_QB = ACT_Q; bf16* const ACT_OB = ACT_Q;
    bf16* const ACT_KVB = WSB(WS_KVB);
    bf16* const ACT_PB = (bf16*)(A.ws + WS_ACT + (size_t)bb * (16 * MiB));
#define IN(k) (lo <= (k) && (k) < hi)
#define SEAM1(k) do { if ((k) == 0) xcd_barrier(bar); else if ((k) == 1 || (k) == 2 || (k) == 6) xcd_barrier(sbar); else xcd_barrier(gbar); } while (0)
#define SEAM(k) do { if (IN(k) && IN((k) + 1)) { SEAM1(k); if ((MK_REP >> 11) & 1) SEAM1(k); } } while (0)
    float* ss1 = WSF(WS_SS); float* ss2 = WSF(WS_SS) + M; float* ss3 = WSF(WS_SS) + 2 * M; float* ss0 = WSF(WS_SS) + 3 * M;
    LAS unsigned char* ring = F.lds + RING_OFF;
    LAS float* const epi_rr = (LAS float*)(F.lds + EPI_RR_OFF); LAS float* const epi_g = (LAS float*)(F.lds + EPI_G_OFF);
    const int my_pm = 8 * bb + gj;
#define STAGE_RR(ssp) do { if (F.tid < 256) epi_rr[F.tid] = rsqrtf((ssp)[my_pm * 256 + F.tid] * (1.f / 1024.f) + 1e-6f); } while (0)
#define STAGE_G(gq_, gk_) do { if (F.tid < 64) epi_g[F.tid] = (gq_)[F.tid] * (gk_)[F.tid] * pg8::QK_C2; } while (0)

    if (IN(0)) { for (int rep = 0; rep < REPN(0); ++rep) p0_prologue(F, A, !(use_bar && batch_sets)); }
    if (use_bar && batch_sets) {
        asm volatile("s_waitcnt vmcnt(0)" ::: "memory"); __syncthreads();
        if (F.tid == 0) __hip_atomic_fetch_add((unsigned*)(F.ctl + CW_CONV_0), 1u, __ATOMIC_RELAXED, __HIP_MEMORY_SCOPE_AGENT);
        p0_rows(F, A, 4 * (8 * bb + gj) + gm);
        copy_slot(F, A, 0, bb);
        asm volatile("s_waitcnt vmcnt(0)" ::: "memory"); __syncthreads();
        if (F.tid == 0) { unsigned sp = 0; while (__hip_atomic_load((unsigned*)(F.ctl + CW_CONV_0), __ATOMIC_RELAXED, __HIP_MEMORY_SCOPE_AGENT) < 256u) { __builtin_amdgcn_s_sleep(2); if (++sp > (1u << 22)) break; } }
        xcd_barrier(gbar);
    } else SEAM(0);
    if (IN(1)) {
        STAGE_RR(ss0); STAGE_G(A_gq_a, A_gk_a);
        gate_job(F, A, (use_bar && batch_sets) ? 4 * (8 * bb + gj) + gm : F.vcu);
        pg8::Gemm g{WSB(WS_XN), WSB(WS_WQKV_A), M, NQKV_A, D}; pg8::StaticOrder S; S.init(M, NQKV_A, F.G, (int)blockIdx.x);
        pg8::EpiHead E{ACT_Q, (size_t)(512 * 1024) / 2, nullptr, epi_g, epi_rr, 0};
        DRYGEMM(1, g, S);
        if ((MK_REP >> 13) & 1) { gate_job(F, A, (use_bar && batch_sets) ? 4 * (8 * bb + gj) + gm : F.vcu); pg8::gemm_phase<pg8::EpiHead, pg8::StaticOrder, PG8_ALIGN, PG8_SP2>(ring, g, S, E); }
        pg8::gemm_phase<pg8::EpiHead, pg8::StaticOrder, PG8_ALIGN, PG8_SP2>(ring, g, S, E);
        if (use_bar && batch_sets) copy_slot(F, A, 1, bb);
    } SEAM(1);
    if (IN(2)) {
        int ln = F.lane; asm volatile("" : "+v"(ln));
        const float gqm = wave_max(fabsf(A_gq_a[ln])), gkm = wave_max(fabsf(A_gk_a[ln]));
        const float nB2 = -(8.f * gqm * gkm * 1.01f * att::LOG2E);
        for (int rep = 0; rep < REPN(2); ++rep)
        for (int c = F.vcu; c < 256; c += F.G) {
            const int bh = c >> 1, s = c & 1;
            att::fox_prepare(bh >> 4, bh & 15, WSF(WS_LOGF), (att::lds_ptr)ring);
            att::fox_cu(bh & 15, s, ACT_PB, (att::lds_ptr)ring, nB2);
        }
    }
    if (IN(2) && use_bar && batch_sets) copy_slot(F, A, 2, bb);
    if (IN(2) && IN(3) && use_bar && batch_sets) {
        if (F.tid == 0) { unsigned sp = 0; while (__hip_atomic_load((unsigned*)(F.ctl + CW_CONV), __ATOMIC_RELAXED, __HIP_MEMORY_SCOPE_AGENT) < 256u) { __builtin_amdgcn_s_sleep(2); if (++sp > (1u << 22)) break; } }
    }
    SEAM(2);
    if (IN(3)) {
        pg8::Gemm g{ACT_OA, WSB(WS_WO_A), M, D, D}; pg8::StaticOrder S; S.init(M, D, F.G, (int)blockIdx.x);
        pg8::EpiResid<1> E{nullptr, WSB(WS_XN), nullptr, ss1, nullptr};
        DRYGEMM(3, g, S);
        pg8::gemm_phase<pg8::EpiResid<1>, pg8::StaticOrder, PG8_ALIGN, PG8_SP2>(ring, g, S, E);
        if (use_bar && batch_sets) copy_slot(F, A, 3, bb);
    } SEAM(3);
    if (IN(4)) {
        pg8::Gemm g{WSB(WS_XN), WSB(WS_WUP0), M, FF, D}; pg8::StaticOrder S; S.init(M, FF, F.G, (int)blockIdx.x);
        STAGE_RR(ss1); __syncthreads();
        pg8::EpiAct E{WSB(WS_H), FF};
        DRYGEMM(4, g, S);
        if ((MK_REP >> 12) & 1) pg8::gemm_phase<pg8::EpiAct, pg8::StaticOrder, PG8_ALIGN, PG8_SP2>(ring, g, S, E);
        pg8::gemm_phase<pg8::EpiAct, pg8::StaticOrder, PG8_ALIGN, PG8_SP2>(ring, g, S, E);
        if (use_bar && batch_sets) copy_slot(F, A, 4, bb);
    } SEAM(4);
    if (IN(5)) {
        pg8::Gemm g{WSB(WS_H), WSB(WS_WDN0), M, D, FF}; pg8::StaticOrder S; S.init(M, D, F.G, (int)blockIdx.x);
        if (!use_bar) { STAGE_RR(ss1); __syncthreads(); }
        pg8::EpiResid<1, true> E{nullptr, WSB(WS_XN), nullptr, ss2, epi_rr};
        DRYGEMM(5, g, S);
        pg8::gemm_phase<pg8::EpiResid<1, true>, pg8::StaticOrder, PG8_ALIGN, PG8_SP2>(ring, g, S, E);
    }
    if (IN(5) && IN(6) && use_bar && batch_sets) {
        if (F.tid == 0) { unsigned sp = 0; while (__hip_atomic_load((unsigned*)(F.ctl + CW_CONV_B), __ATOMIC_RELAXED, __HIP_MEMORY_SCOPE_AGENT) < 256u) { __builtin_amdgcn_s_sleep(2); if (++sp > (1u << 22)) break; } }
    }
    SEAM(5);
    if (IN(6)) {
        pg8::Gemm g{WSB(WS_XN), WSB(WS_WQKV_B), M, NQKV_B, D}; pg8::StaticOrder S; S.init(M, NQKV_B, F.G, (int)blockIdx.x);
        STAGE_RR(ss2); STAGE_G(A_gq_b, A_gk_b); __syncthreads();
        pg8::EpiHead E{ACT_QB, 0, ACT_KVB, epi_g, epi_rr, 1};
        DRYGEMM(6, g, S);
        if ((MK_REP >> 14) & 1) pg8::gemm_phase<pg8::EpiHead, pg8::StaticOrder, PG8_ALIGN, PG8_SP2>(ring, g, S, E);
        pg8::gemm_phase<pg8::EpiHead, pg8::StaticOrder, PG8_ALIGN, PG8_SP2>(ring, g, S, E);
    }
    if (IN(6) && IN(7) && use_bar && batch_sets) {
        xcd_barrier(gbar);
        if (F.tid == 0) {
            if (gm == 0) { if (sbar.st[1] > 1u) { __builtin_amdgcn_fence(__ATOMIC_RELEASE, "agent"); asm volatile("s_waitcnt vmcnt(0)" ::: "memory"); }
                __hip_atomic_fetch_add((unsigned*)(F.ctl + CW_KVD + 16 * my_pm), 1u, __ATOMIC_RELAXED, __HIP_MEMORY_SCOPE_AGENT); }
            if ((gm & 1) == 0 && gj > 0) { unsigned sp = 0; while (__hip_atomic_load((unsigned*)(F.ctl + CW_KVD + 16 * (my_pm - 1)), __ATOMIC_RELAXED, __HIP_MEMORY_SCOPE_AGENT) < 1u) { __builtin_amdgcn_s_sleep(1); if (++sp > (1u << 22)) break; }
                __builtin_amdgcn_fence(__ATOMIC_ACQUIRE, "agent"); asm volatile("s_waitcnt vmcnt(0)" ::: "memory"); }
        }
        __syncthreads();
    } else SEAM(6);
    if (IN(7)) {
        int ln = F.lane; asm volatile("" : "+v"(ln));
        const float gqm = wave_max(fabsf(A_gq_b[ln])), gkm = wave_max(fabsf(A_gk_b[ln]));
        const float qkb = 8.f * gqm * gkm * 1.01f * att::LOG2E;
        for (int rep = 0; rep < REPN(7); ++rep)
            att::swa_unit(bb, gm >> 1, 2 * gj + (gm & 1), ACT_QB, ACT_KVB, ACT_OB, A_sinks, A_rel_bias, (att::lds_ptr)ring, qkb);
    } SEAM(7);
    if (IN(8)) {
        pg8::Gemm g{ACT_OB, WSB(WS_WO_B), M, D, D}; pg8::StaticOrder S; S.init(M, D, F.G, (int)blockIdx.x);
        pg8::EpiResid<1> E{nullptr, WSB(WS_XN), nullptr, ss3, nullptr};
        DRYGEMM(8, g, S);
        pg8::gemm_phase<pg8::EpiResid<1>, pg8::StaticOrder, PG8_ALIGN, PG8_SP2>(ring, g, S, E);
    } SEAM(8);
    if (IN(9)) {
        pg8::Gemm g{WSB(WS_XN), WSB(WS_WUP1), M, FF, D}; pg8::StaticOrder S; S.init(M, FF, F.G, (int)blockIdx.x);
        STAGE_RR(ss3); __syncthreads();
        pg8::EpiAct E{WSB(WS_H), FF};
        DRYGEMM(9, g, S);
        pg8::gemm_phase<pg8::EpiAct, pg8::StaticOrder, PG8_ALIGN, PG8_SP2>(ring, g, S, E);
    } SEAM(9);
    if (IN(10)) {
        pg8::Gemm g{WSB(WS_H), WSB(WS_WDN1), M, D, FF}; pg8::StaticOrder S; S.init(M, D, F.G, (int)blockIdx.x);
        if (!use_bar) { STAGE_RR(ss3); __syncthreads(); }
        pg8::EpiResid<2, true> E{nullptr, WSB(WS_XN), A.out, nullptr, epi_rr};
        DRYGEMM(10, g, S);
        pg8::gemm_phase<pg8::EpiResid<2, true>, pg8::StaticOrder, PG8_ALIGN, PG8_SP2>(ring, g, S, E);
    }
#undef IN
#undef SEAM
}

extern "C" void kernel_launch(void* const* d_in, const int* in_sizes, int n_in, void* d_out, int out_size, void* d_ws, size_t ws_size, hipStream_t stream) {
    static int grid = 0;
    if (grid == 0) {
        if (n_in != 18 || in_sizes[0] != M * D || out_size != M * D || ws_size < WS_END) { fprintf(stderr, "kernel_launch: unexpected shapes (n_in %d, in0 %d, out %d, ws %zu); nothing launched\n", n_in, n_in > 0 ? in_sizes[0] : -1, out_size, ws_size); grid = -1; return; }
        int dev = 0, cus = 0, per_cu = 0;
        if (hipGetDevice(&dev) != hipSuccess || hipDeviceGetAttribute(&cus, hipDeviceAttributeMultiprocessorCount, dev) != hipSuccess) { grid = -1; return; }
        if (hipFuncSetAttribute((const void*)yoco_fwd, hipFuncAttributeMaxDynamicSharedMemorySize, LDS_BYTES) != hipSuccess) { fprintf(stderr, "kernel_launch: hipFuncSetAttribute failed\n"); grid = -1; return; }
        if (hipOccupancyMaxActiveBlocksPerMultiprocessor(&per_cu, (const void*)yoco_fwd, NWAVES * 64, LDS_BYTES) != hipSuccess || per_cu < 1)
            fprintf(stderr, "kernel_launch: note: occupancy query reports %d workgroups per CU\n", per_cu);
        (void)hipGetLastError();
        grid = cus;
        if (grid != 256) { fprintf(stderr, "kernel_launch: built for a 256-CU device (batch-set unit orders); found %d CUs; nothing launched\n", cus); grid = -1; return; }
    }
    if (grid < 0) return;
    if (hipMemsetAsync((char*)d_ws + WS_CTL, 0, CTL_ZERO_BYTES, stream) != hipSuccess) { fprintf(stderr, "kernel_launch: hipMemsetAsync failed\n"); return; }
    Args a{};
    for (int i = 0; i < 18; ++i) a.in[i] = (const float*)d_in[i];
    a.out = (float*)d_out; a.ws = (unsigned char*)d_ws;
#if MK_SPLIT
    for (int p = 0; p < NPHASE; ++p) { a.ph_lo = p; a.ph_hi = p + 1; hipLaunchKernelGGL(yoco_fwd, dim3(grid), dim3(NWAVES * 64), LDS_BYTES, stream, a); }
#else
    a.ph_lo = 0; a.ph_hi = NPHASE;
    hipLaunchKernelGGL(yoco_fwd, dim3(grid), dim3(NWAVES * 64), LDS_BYTES, stream, a);
#endif
    const hipError_t le = hipPeekAtLastError();
    if (le != hipSuccess) fprintf(stderr, "kernel_launch: launch failed: %s\n", hipGetErrorName(le));
}
```

```cpp
#include <hip/hip_runtime.h>
#include <hip/hip_bf16.h>
#include <cstdio>
#include <cstdint>
#include <cmath>
namespace pg8 {
#define PG8_LAS __attribute__((address_space(3)))
typedef unsigned short bf16_t;
typedef short bf16x8 __attribute__((ext_vector_type(8)));
typedef float f32x4 __attribute__((ext_vector_type(4)));
typedef unsigned u32x4 __attribute__((ext_vector_type(4)));
constexpr int BM = 256, BK = 64, HALF = 128, HTB = HALF * BK * 2  , STAGE_BYTES = 8 * HTB, NXCD = 8, WGM = 8;

__host__ __device__ __forceinline__ int lds_byte(int r, int c) { const int st = (r >> 4) * 2 + (c >> 5), rr = r & 15, cc = c & 31, ob = rr * 64 + cc * 2; return st * 1024 + (ob ^ (((ob >> 9) & 1) << 5)); }
__host__ __device__ __forceinline__ void stage_rc(int b, int& R, int& C) { const int st = b / 1024, sb = b % 1024, swz = sb ^ (((sb >> 9) & 1) << 5); R = (st >> 1) * 16 + swz / 64; C = (st & 1) * 32 + (swz % 64) / 2; }
__host__ __device__ __forceinline__ int perm32(int rho) { const int n = rho >> 4, i = rho & 15; return 8 * (i >> 2) + 4 * n + (i & 3); }

struct Unit { int pm, pn; };
struct Gemm { const bf16_t* A; const bf16_t* Bt; int M, N, K; };

struct StaticOrder {
    int nM, nN, nwg, G, c;
    __host__ __device__ void init(int M, int N, int G_, int c_) { nM = M / BM; nN = N / BM; nwg = nM * nN; G = G_; c = c_; }
    __host__ __device__ bool next(int i, Unit& u) const {
        const long L = (long)i * G + c; if (L >= nwg) return false;
        int wgid = (int)L; { const int q = nwg / NXCD, r = nwg % NXCD, xcd = wgid % NXCD, off = wgid / NXCD; wgid = (xcd < r ? xcd * (q + 1) : r * (q + 1) + (xcd - r) * q) + off; }
        const int nig = WGM * nN, gid = wgid / nig, fm = gid * WGM, gsz = (nM - fm) < WGM ? (nM - fm) : WGM;
        u.pm = fm + ((wgid % nig) % gsz); u.pn = (wgid % nig) / gsz; return true;
    }
    __device__ __forceinline__ void a_ready(const Unit&) const {}
    __device__ __forceinline__ void done(const Unit&) const {}
};
__device__ __forceinline__ unsigned cvt_pk_bf16(float lo, float hi) { unsigned r; asm volatile("v_cvt_pk_bf16_f32 %0, %1, %2" : "=v"(r) : "v"(lo), "v"(hi)); return r; }
typedef unsigned u32x2 __attribute__((ext_vector_type(2)));
constexpr float QK_C2 = 0.125f * 1.4426950408889634f;
constexpr float RMS_EPS = 1e-6f;

__device__ __forceinline__ float sum_fq(float s) {
    { auto r = __builtin_amdgcn_permlane16_swap(__float_as_uint(s), __float_as_uint(s), false, false); s = __uint_as_float(r[0]) + __uint_as_float(r[1]); }
    { auto r = __builtin_amdgcn_permlane32_swap(__float_as_uint(s), __float_as_uint(s), false, false); s = __uint_as_float(r[0]) + __uint_as_float(r[1]); }
    return s;
}
typedef float f32x2 __attribute__((ext_vector_type(2)));
__device__ __forceinline__ float sumsq16(const f32x4& a, const f32x4& b, const f32x4& c, const f32x4& d) {
    f32x2 s = a.xy * a.xy;
    s = __builtin_elementwise_fma(a.zw, a.zw, s); s = __builtin_elementwise_fma(b.xy, b.xy, s); s = __builtin_elementwise_fma(b.zw, b.zw, s);
    s = __builtin_elementwise_fma(c.xy, c.xy, s); s = __builtin_elementwise_fma(c.zw, c.zw, s); s = __builtin_elementwise_fma(d.xy, d.xy, s); s = __builtin_elementwise_fma(d.zw, d.zw, s);
    return s.x + s.y;
}
struct EpiHead {
    static constexpr bool PERM = true, AFTER_DRAIN = false; static constexpr int NST = 32;
    bf16_t* dq; size_t cls_stride; bf16_t* dkv; const PG8_LAS float* gl; const PG8_LAS float* rrl; int layerB;
    __device__ __forceinline__ void operator()(const f32x4 (&acc)[2][2][4][2], const Unit& u, int wr, int wc, int fr0, int fq0) const {
        int ln = fr0 | (fq0 << 4); asm volatile("" : "+v"(ln)); const int fr = ln & 15, fq = ln >> 4;
        bf16_t* base; int ld, colbase, mode;
        if (!layerB) { const int cls = u.pn >> 2; base = dq + (size_t)cls * cls_stride; ld = 1024; colbase = 256 * (u.pn & 3); mode = cls; }
        else if (u.pn < 4) { base = dq; ld = 1024; colbase = 256 * u.pn; mode = 0; }
        else { base = dkv; ld = 256; colbase = 0; mode = wc < 2 ? 1 : 2; }
        const int row0 = u.pm * BM + wr * 64 + fr;
        bf16_t* p0 = base + (size_t)row0 * ld + colbase + 64 * wc + 8 * fq;
        if (mode == 0) {
            f32x4 gv[2][2];
#pragma unroll
            for (int bj = 0; bj < 2; ++bj)
#pragma unroll
                for (int n = 0; n < 2; ++n) gv[bj][n] = *(const PG8_LAS f32x4*)(gl + 32 * bj + 8 * fq + 4 * n);
#pragma unroll
            for (int ai = 0; ai < 2; ++ai)
#pragma unroll
                for (int m = 0; m < 4; ++m) {
                    const float rr = rrl[wr * 64 + fr + ai * HALF + m * 16];
                    const float s = sum_fq(sumsq16(acc[ai][0][m][0], acc[ai][0][m][1], acc[ai][1][m][0], acc[ai][1][m][1]));
                    const float t = rr * __builtin_amdgcn_rsqf(rr * rr * s * (1.f / 64.f) + RMS_EPS);
                    bf16_t* rowp = p0 + (size_t)(ai * HALF + m * 16) * ld;
#pragma unroll
                    for (int bj = 0; bj < 2; ++bj) { const f32x4 v0 = acc[ai][bj][m][0] * gv[bj][0] * t, v1 = acc[ai][bj][m][1] * gv[bj][1] * t;
                        u32x4 w; w.x = cvt_pk_bf16(v0[0], v0[1]); w.y = cvt_pk_bf16(v0[2], v0[3]); w.z = cvt_pk_bf16(v1[0], v1[1]); w.w = cvt_pk_bf16(v1[2], v1[3]);
                        *(u32x4*)(rowp + 32 * bj) = w; }
                }
        } else {
#pragma unroll
            for (int ai = 0; ai < 2; ++ai)
#pragma unroll
                for (int m = 0; m < 4; ++m) {
                    float t = rrl[wr * 64 + fr + ai * HALF + m * 16];
                    if (mode == 1) { const float s = sum_fq(sumsq16(acc[ai][0][m][0], acc[ai][0][m][1], acc[ai][1][m][0], acc[ai][1][m][1])); t = t * __builtin_amdgcn_rsqf(t * t * s * (1.f / 64.f) + RMS_EPS); }
                    bf16_t* rowp = p0 + (size_t)(ai * HALF + m * 16) * ld;
#pragma unroll
                    for (int bj = 0; bj < 2; ++bj) { const f32x4 v0 = acc[ai][bj][m][0] * t, v1 = acc[ai][bj][m][1] * t;
                        u32x4 w; w.x = cvt_pk_bf16(v0[0], v0[1]); w.y = cvt_pk_bf16(v0[2], v0[3]); w.z = cvt_pk_bf16(v1[0], v1[1]); w.w = cvt_pk_bf16(v1[2], v1[3]);
                        *(u32x4*)(rowp + 32 * bj) = w; }
                }
        }
    }
};

struct EpiAct {
    static constexpr bool PERM = true, AFTER_DRAIN = false; static constexpr int NST = 32;
    bf16_t* O; int ldc;
    __device__ __forceinline__ void operator()(const f32x4 (&acc)[2][2][4][2], const Unit& u, int wr, int wc, int fr, int fq) const {
        const int row0 = u.pm * BM + wr * 64 + fr, col0 = u.pn * BM + wc * 32 + 8 * fq;
#pragma unroll
        for (int ai = 0; ai < 2; ++ai)
#pragma unroll
            for (int m = 0; m < 4; ++m) {
                const int row = row0 + ai * HALF + m * 16;
                bf16_t* rowp = O + (size_t)row * ldc + col0;
#pragma unroll
                for (int bj = 0; bj < 2; ++bj) { f32x4 v0 = acc[ai][bj][m][0], v1 = acc[ai][bj][m][1];
#pragma unroll
                    for (int e = 0; e < 4; ++e) { v0[e] = __int_as_float(max(__float_as_int(v0[e]), 0)); v1[e] = __int_as_float(max(__float_as_int(v1[e]), 0)); }
                    v0 = v0 * v0; v1 = v1 * v1;
                    u32x4 w; w.x = cvt_pk_bf16(v0[0], v0[1]); w.y = cvt_pk_bf16(v0[2], v0[3]); w.z = cvt_pk_bf16(v1[0], v1[1]); w.w = cvt_pk_bf16(v1[2], v1[3]);
                    *(u32x4*)(rowp + bj * HALF) = w; }
            }
    }
};

template <int MODE, bool SCALE = false> struct EpiResid {
    static constexpr bool PERM = true, AFTER_DRAIN = false; static constexpr int NST = 0;
    const float* base32; bf16_t* xn; float* out32; float* ss; const PG8_LAS float* rrl;
    __device__ __forceinline__ void operator()(const f32x4 (&acc)[2][2][4][2], const Unit& u, int wr, int wc, int fr, int fq) const {
        const int row0 = u.pm * BM + wr * 64 + fr, col0 = u.pn * BM + wc * 32 + 8 * fq;
#pragma unroll
        for (int ai = 0; ai < 2; ++ai)
#pragma unroll
            for (int m = 0; m < 4; ++m) {
                const int row = row0 + ai * HALF + m * 16; const size_t off = (size_t)row * 1024 + col0;
                float s = 0.f, sc = 1.f;
                if (SCALE) { const float rr = rrl[wr * 64 + fr + ai * HALF + m * 16]; sc = rr * rr; }
#pragma unroll
                for (int bj = 0; bj < 2; ++bj) {
                    f32x4 r0, r1;
                    if (MODE == 0) { r0 = __builtin_nontemporal_load((const f32x4*)(base32 + off + bj * HALF)); r1 = __builtin_nontemporal_load((const f32x4*)(base32 + off + bj * HALF + 4)); }
                    else { const u32x4 w = MODE == 2 ? __builtin_nontemporal_load((const u32x4*)(xn + off + bj * HALF)) : *(const u32x4*)(xn + off + bj * HALF);
                        r0 = (f32x4){__uint_as_float(w.x << 16), __uint_as_float(w.x & 0xffff0000u), __uint_as_float(w.y << 16), __uint_as_float(w.y & 0xffff0000u)};
                        r1 = (f32x4){__uint_as_float(w.z << 16), __uint_as_float(w.z & 0xffff0000u), __uint_as_float(w.w << 16), __uint_as_float(w.w & 0xffff0000u)}; }
                    const f32x4 o0 = SCALE ? r0 + acc[ai][bj][m][0] * sc : r0 + acc[ai][bj][m][0], o1 = SCALE ? r1 + acc[ai][bj][m][1] * sc : r1 + acc[ai][bj][m][1];
                    if (MODE == 2) { __builtin_nontemporal_store(o0, (f32x4*)(out32 + off + bj * HALF)); __builtin_nontemporal_store(o1, (f32x4*)(out32 + off + bj * HALF + 4)); }
                    else { u32x4 w; w.x = cvt_pk_bf16(o0[0], o0[1]); w.y = cvt_pk_bf16(o0[2], o0[3]); w.z = cvt_pk_bf16(o1[0], o1[1]); w.w = cvt_pk_bf16(o1[2], o1[3]);
                        *(u32x4*)(xn + off + bj * HALF) = w;
                        s += ((o0[0] * o0[0] + o0[1] * o0[1]) + (o0[2] * o0[2] + o0[3] * o0[3])) + ((o1[0] * o1[0] + o1[1] * o1[1]) + (o1[2] * o1[2] + o1[3] * o1[3])); }
                }
                if (MODE != 2) { s = sum_fq(s);
                    if (fq == 0) __hip_atomic_fetch_add(ss + row, s, __ATOMIC_RELAXED, __HIP_MEMORY_SCOPE_AGENT); }
                if (m & 1) asm volatile("" ::: "memory");
            }
    }
};

struct EpiDry {
    static constexpr bool PERM = false, AFTER_DRAIN = false; static constexpr int NST = 0;
    __device__ __forceinline__ void operator()(const f32x4 (&acc)[2][2][4][2], const Unit& u, int wr, int wc, int fr, int fq) const {
#pragma unroll
        for (int ai = 0; ai < 2; ++ai)
#pragma unroll
            for (int bj = 0; bj < 2; ++bj)
#pragma unroll
                for (int m = 0; m < 4; ++m)
#pragma unroll
                    for (int n = 0; n < 2; ++n) asm volatile("" :: "v"(acc[ai][bj][m][n]));
    }
};
template <class Epi, class Sched, bool ALIGN_EPI = false, bool SP2 = false>
__device__ __forceinline__ void gemm_phase(PG8_LAS unsigned char* lds, const Gemm g, const Sched& S, const Epi& E) {
    const int tid = threadIdx.x, wid = __builtin_amdgcn_readfirstlane(tid >> 6), lane = tid & 63, wr = wid >> 2, wc = wid & 3, fr = lane & 15, fq = lane >> 4;
    const int K = g.K, nt = K / BK;
    unsigned voffA[2], voffB[2];
#pragma unroll
    for (int i = 0; i < 2; ++i) { int R, C; stage_rc(tid * 16 + i * 8192, R, C); const int Rb = Epi::PERM ? ((R & ~31) + perm32(R & 31)) : R;
        voffA[i] = (unsigned)(R * K + C) * 2u; voffB[i] = (unsigned)(Rb * K + C) * 2u; }
    const size_t kstep = (size_t)(BK * 2);
    const size_t hstep = (size_t)HALF * K * 2;
    const size_t tstep = 2 * hstep;
    const unsigned ldsw = (unsigned)wid * 1024u;
    const int aoff = lds_byte(wr * 64 + fr, fq * 8), boff = lds_byte(wc * 32 + fr, fq * 8);
#define PG8_SA(b, h) (((b) * 2 + (h)) * HTB)
#define PG8_SB(b, h) ((4 + (b) * 2 + (h)) * HTB)
#define PG8_STAGE(bufoff, gbase, voff) do { _Pragma("unroll") for (int _i = 0; _i < 2; ++_i) \
        __builtin_amdgcn_global_load_lds((const unsigned*)((const char*)(gbase) + (voff)[_i]), (PG8_LAS unsigned*)(lds + (bufoff) + ldsw + _i * 8192), 16, 0, 0); } while (0)
#define PG8_LDA(dst, b, h) do { _Pragma("unroll") for (int m = 0; m < 4; ++m) _Pragma("unroll") for (int k = 0; k < 2; ++k) dst[m][k] = *(const PG8_LAS bf16x8*)(lds + PG8_SA(b, h) + aoff + m * 2048 + k * 1024); } while (0)
#define PG8_LDB(dst, b, h) do { _Pragma("unroll") for (int n = 0; n < 2; ++n) _Pragma("unroll") for (int k = 0; k < 2; ++k) dst[n][k] = *(const PG8_LAS bf16x8*)(lds + PG8_SB(b, h) + boff + n * 2048 + k * 1024); } while (0)
#define PG8_MMA(ai, bj, At, Bt) do { __builtin_amdgcn_s_setprio(1); _Pragma("unroll") for (int m = 0; m < 4; ++m) _Pragma("unroll") for (int n = 0; n < 2; ++n) _Pragma("unroll") for (int k = 0; k < 2; ++k) \
        acc[ai][bj][m][n] = __builtin_amdgcn_mfma_f32_16x16x32_bf16(Bt[n][k], At[m][k], acc[ai][bj][m][n], 0, 0, 0); __builtin_amdgcn_s_setprio(0); } while (0)
#define PG8_WAIT_V(n) asm volatile("s_waitcnt vmcnt(" #n ")" ::: "memory")
#define PG8_WAIT_L(n) asm volatile("s_waitcnt lgkmcnt(" #n ")" ::: "memory")
#define PG8_BAR __builtin_amdgcn_s_barrier()
#define PG8_SCHED __builtin_amdgcn_sched_barrier(0)
    Unit cur, nxt; int ui = 0;
    if (!S.next(0, cur)) return;
    f32x4 acc[2][2][4][2];
#pragma unroll
    for (int a = 0; a < 2; ++a)
#pragma unroll
        for (int b = 0; b < 2; ++b)
#pragma unroll
            for (int m = 0; m < 4; ++m)
#pragma unroll
                for (int n = 0; n < 2; ++n) acc[a][b][m][n] = (f32x4){0.f, 0.f, 0.f, 0.f};
    bf16x8 At[4][2], B0[2][2], B1[2][2];
    const char* cA = (const char*)g.A + (size_t)cur.pm * tstep; const char* cB = (const char*)g.Bt + (size_t)cur.pn * tstep;
    S.a_ready(cur);
    if constexpr (SP2) {
        PG8_STAGE(PG8_SB(0, 0), cB, voffB); PG8_STAGE(PG8_SB(0, 1), cB + hstep, voffB); PG8_STAGE(PG8_SA(0, 0), cA, voffA); PG8_STAGE(PG8_SA(0, 1), cA + hstep, voffA);
        if (wr == 1) PG8_BAR;
        PG8_WAIT_V(2); PG8_BAR;
        PG8_STAGE(PG8_SB(1, 0), cB + kstep, voffB); PG8_STAGE(PG8_SA(1, 0), cA + kstep, voffA); PG8_STAGE(PG8_SB(1, 1), cB + hstep + kstep, voffB);
        PG8_WAIT_V(6); PG8_BAR;
    } else {
        PG8_STAGE(PG8_SB(0, 0), cB, voffB); PG8_STAGE(PG8_SA(0, 0), cA, voffA); PG8_STAGE(PG8_SB(0, 1), cB + hstep, voffB); PG8_STAGE(PG8_SA(0, 1), cA + hstep, voffA);
        if (wr == 1) PG8_BAR;
        PG8_WAIT_V(4); PG8_BAR;
        PG8_STAGE(PG8_SB(1, 0), cB + kstep, voffB); PG8_STAGE(PG8_SA(1, 0), cA + kstep, voffA); PG8_STAGE(PG8_SB(1, 1), cB + hstep + kstep, voffB);
        PG8_WAIT_V(6); PG8_BAR;
    }
    for (;;) {
        const bool has_next = S.next(ui + 1, nxt);
        const char* nA = has_next ? (const char*)g.A + (size_t)nxt.pm * tstep : cA; const char* nB = has_next ? (const char*)g.Bt + (size_t)nxt.pn * tstep : cB;
        for (int t = 0; t < nt; t += 2) {
            const bool last = (t == nt - 2);
            const char* a1 = cA + (size_t)(t + 1) * kstep;
            const char* a2 = last ? nA : cA + (size_t)(t + 2) * kstep; const char* b2 = last ? nB : cB + (size_t)(t + 2) * kstep;
            const char* a3 = a2 + kstep; const char* b3 = b2 + kstep;
            if (last && has_next) S.a_ready(nxt);
            if constexpr (SP2) {
            PG8_LDB(B0, 0, 0); PG8_LDB(B1, 0, 1); PG8_SCHED; PG8_LDA(At, 0, 0); PG8_STAGE(PG8_SA(1, 1), a1 + hstep, voffA);
            PG8_WAIT_V(8); PG8_WAIT_L(0); PG8_BAR; PG8_MMA(0, 0, At, B0); PG8_MMA(0, 1, At, B1); PG8_BAR; PG8_SCHED;
            PG8_LDA(At, 0, 1); PG8_STAGE(PG8_SB(0, 0), b2, voffB); PG8_STAGE(PG8_SB(0, 1), b2 + hstep, voffB); PG8_STAGE(PG8_SA(0, 0), a2, voffA);
            PG8_WAIT_V(8); PG8_WAIT_L(0); PG8_BAR; PG8_MMA(1, 0, At, B0); PG8_MMA(1, 1, At, B1); PG8_BAR; PG8_SCHED;
            PG8_LDB(B0, 1, 0); PG8_LDB(B1, 1, 1); PG8_SCHED; PG8_LDA(At, 1, 0); PG8_STAGE(PG8_SA(0, 1), a2 + hstep, voffA);
            PG8_WAIT_V(8); PG8_WAIT_L(0); PG8_BAR; PG8_MMA(0, 0, At, B0); PG8_MMA(0, 1, At, B1); PG8_BAR; PG8_SCHED;
            PG8_LDA(At, 1, 1); PG8_STAGE(PG8_SB(1, 0), b3, voffB); PG8_STAGE(PG8_SB(1, 1), b3 + hstep, voffB); PG8_STAGE(PG8_SA(1, 0), a3, voffA);
            PG8_WAIT_V(8); PG8_WAIT_L(0); PG8_BAR; PG8_MMA(1, 0, At, B0); PG8_MMA(1, 1, At, B1); PG8_BAR; PG8_SCHED;
            } else {
            PG8_LDB(B0, 0, 0); PG8_SCHED; PG8_LDA(At, 0, 0); PG8_STAGE(PG8_SA(1, 1), a1 + hstep, voffA);
            PG8_WAIT_L(8); PG8_BAR; PG8_WAIT_L(0); PG8_MMA(0, 0, At, B0); PG8_BAR; PG8_SCHED;
            PG8_LDB(B1, 0, 1); PG8_STAGE(PG8_SB(0, 0), b2, voffB);
            PG8_BAR; PG8_WAIT_L(0); PG8_MMA(0, 1, At, B1); PG8_BAR;
            PG8_LDA(At, 0, 1); PG8_STAGE(PG8_SA(0, 0), a2, voffA);
            PG8_BAR; PG8_WAIT_L(0); PG8_MMA(1, 0, At, B0); PG8_BAR; PG8_SCHED;
            PG8_STAGE(PG8_SB(0, 1), b2 + hstep, voffB);
            PG8_WAIT_V(6); PG8_BAR; PG8_MMA(1, 1, At, B1); PG8_BAR;
            PG8_LDB(B0, 1, 0); PG8_SCHED; PG8_LDA(At, 1, 0); PG8_STAGE(PG8_SA(0, 1), a2 + hstep, voffA);
            PG8_WAIT_L(8); PG8_BAR; PG8_WAIT_L(0); PG8_MMA(0, 0, At, B0); PG8_BAR; PG8_SCHED;
            PG8_LDB(B1, 1, 1); PG8_STAGE(PG8_SB(1, 0), b3, voffB);
            PG8_BAR; PG8_WAIT_L(0); PG8_MMA(0, 1, At, B1); PG8_BAR;
            PG8_LDA(At, 1, 1); PG8_STAGE(PG8_SA(1, 0), a3, voffA);
            PG8_BAR; PG8_WAIT_L(0); PG8_MMA(1, 0, At, B0); PG8_BAR; PG8_SCHED;
            PG8_STAGE(PG8_SB(1, 1), b3 + hstep, voffB);
            PG8_WAIT_V(6); PG8_BAR; PG8_MMA(1, 1, At, B1); PG8_BAR;
            }
        }
        if constexpr (ALIGN_EPI) { if (wr == 0) PG8_BAR; }
        if constexpr (!Epi::AFTER_DRAIN) { E(acc, cur, wr, wc, fr, fq); S.done(cur); }
        if (!has_next) break;
#pragma unroll
        for (int a = 0; a < 2; ++a)
#pragma unroll
            for (int b = 0; b < 2; ++b)
#pragma unroll
                for (int m = 0; m < 4; ++m)
#pragma unroll
                    for (int n = 0; n < 2; ++n) acc[a][b][m][n] = (f32x4){0.f, 0.f, 0.f, 0.f};
        cur = nxt; cA = nA; cB = nB; ++ui;
        if constexpr (ALIGN_EPI) { if (wr == 1) PG8_BAR; }
    }
    PG8_WAIT_V(0);
    if constexpr (!ALIGN_EPI) { if (wr == 0) PG8_BAR; }
    PG8_BAR;
    if constexpr (Epi::AFTER_DRAIN) { E.fused(acc, cur, wr, wc, fr, fq, lds, wid, lane); S.done(cur); }
#undef PG8_SA
#undef PG8_SB
#undef PG8_STAGE
#undef PG8_LDA
#undef PG8_LDB
#undef PG8_MMA
#undef PG8_WAIT_V
#undef PG8_WAIT_L
#undef PG8_BAR
#undef PG8_SCHED
}
}
namespace att {
typedef unsigned short bf16_t;
typedef short bf16x8 __attribute__((ext_vector_type(8)));
typedef short s16x4 __attribute__((ext_vector_type(4)));
typedef float f32x16 __attribute__((ext_vector_type(16)));
typedef float f32x4 __attribute__((ext_vector_type(4)));
typedef unsigned u32x4 __attribute__((ext_vector_type(4)));
#define ALDS __attribute__((address_space(3)))
typedef ALDS const char* lds_cptr;
typedef ALDS char* lds_ptr;
typedef short v4i16_t __attribute__((ext_vector_type(4)));
constexpr int SEQ = 2048, DM = 1024, SLOTB = 8192;
constexpr float LOG2E = 1.4426950408889634f;
__device__ __forceinline__ int crow(int r, int hi) { return (r & 3) + 8 * (r >> 2) + 4 * hi; }
#define ATT_SBAR() __builtin_amdgcn_sched_barrier(0)
#define ATT_WAIT_BAR(N) asm volatile("s_waitcnt vmcnt(" #N ") lgkmcnt(0)\n\ts_barrier" ::: "memory")
#define ATT_LGKM_BAR() asm volatile("s_waitcnt lgkmcnt(0)\n\ts_barrier" ::: "memory")
__device__ __forceinline__ void glds16(const void* gsrc, unsigned lds_dst) { unsigned keep;
    asm volatile("s_mov_b32 %0, m0\n\ts_mov_b32 m0, %2\n\ts_nop 0\n\tglobal_load_lds_dwordx4 %1, off\n\ts_mov_b32 m0, %0" : "=&s"(keep) : "v"(gsrc), "s"(lds_dst) : "memory"); }
typedef float f32x2_t __attribute__((ext_vector_type(2))); typedef __bf16 bf16x2_t __attribute__((ext_vector_type(2)));
__device__ __forceinline__ unsigned cvtpk_s(float lo, float hi) { f32x2_t v = {lo, hi}; bf16x2_t b = __builtin_convertvector(v, bf16x2_t); return __builtin_bit_cast(unsigned, b); }

__device__ __forceinline__ void qkt2(f32x16& p0, f32x16& p1, lds_cptr kp, const bf16x8* qr, const f32x16& c0, const f32x16& c1) {
#pragma unroll
    for (int d0 = 0; d0 < 4; ++d0) {
        const bf16x8 b0 = *(const ALDS bf16x8*)(kp + d0 * 2048);
        const bf16x8 b1 = *(const ALDS bf16x8*)(kp + d0 * 2048 + 512);
        if (d0 == 0) { p0 = __builtin_amdgcn_mfma_f32_32x32x16_bf16(b0, qr[0], c0, 0, 0, 0); p1 = __builtin_amdgcn_mfma_f32_32x32x16_bf16(b1, qr[0], c1, 0, 0, 0); }
        else { p0 = __builtin_amdgcn_mfma_f32_32x32x16_bf16(b0, qr[d0], p0, 0, 0, 0); p1 = __builtin_amdgcn_mfma_f32_32x32x16_bf16(b1, qr[d0], p1, 0, 0, 0); }
    }
}
__device__ __forceinline__ void pv(f32x16* o, int vb, bf16x8 pa0, bf16x8 pa1, bf16x8 pa2, bf16x8 pa3) {
#pragma unroll
    for (int d0 = 0; d0 < 2; ++d0) { s16x4 lo[4], hi[4];
#pragma unroll
        for (int ks = 0; ks < 4; ++ks) {
            asm volatile("ds_read_b64_tr_b16 %0,%1 offset:%c2" : "=&v"(lo[ks]) : "v"(vb), "i"(d0 * 4096 + ks * 1024) : "memory");
            asm volatile("ds_read_b64_tr_b16 %0,%1 offset:%c2" : "=&v"(hi[ks]) : "v"(vb), "i"(d0 * 4096 + ks * 1024 + 512) : "memory"); }
        asm volatile("s_waitcnt lgkmcnt(0)" ::: "memory"); ATT_SBAR();
#define ATT_PK(k) (bf16x8){lo[k][0], lo[k][1], lo[k][2], lo[k][3], hi[k][0], hi[k][1], hi[k][2], hi[k][3]}
        o[d0] = __builtin_amdgcn_mfma_f32_32x32x16_bf16(pa0, ATT_PK(0), o[d0], 0, 0, 0);
        o[d0] = __builtin_amdgcn_mfma_f32_32x32x16_bf16(pa1, ATT_PK(1), o[d0], 0, 0, 0);
        o[d0] = __builtin_amdgcn_mfma_f32_32x32x16_bf16(pa2, ATT_PK(2), o[d0], 0, 0, 0);
        o[d0] = __builtin_amdgcn_mfma_f32_32x32x16_bf16(pa3, ATT_PK(3), o[d0], 0, 0, 0);
#undef ATT_PK
    }
}
__device__ __forceinline__ void tile_body(f32x16* o, float& l, lds_cptr kp, int vb, const bf16x8* qr, const f32x16& c0, const f32x16& c1) {
    f32x16 p0, p1; qkt2(p0, p1, kp, qr, c0, c1);
#pragma unroll
    for (int r = 0; r < 16; ++r) { p0[r] = __builtin_amdgcn_exp2f(p0[r]); p1[r] = __builtin_amdgcn_exp2f(p1[r]); }
    float s0 = 0.f, s1 = 0.f;
#pragma unroll
    for (int r = 0; r < 16; ++r) { s0 += p0[r]; s1 += p1[r]; }
    l += s0 + s1;
    u32x4 pw0, pw1, pw2, pw3;
    pw0 = (u32x4){cvtpk_s(p0[0], p0[1]), cvtpk_s(p0[2], p0[3]), cvtpk_s(p0[4], p0[5]), cvtpk_s(p0[6], p0[7])};
    pw1 = (u32x4){cvtpk_s(p0[8], p0[9]), cvtpk_s(p0[10], p0[11]), cvtpk_s(p0[12], p0[13]), cvtpk_s(p0[14], p0[15])};
    pw2 = (u32x4){cvtpk_s(p1[0], p1[1]), cvtpk_s(p1[2], p1[3]), cvtpk_s(p1[4], p1[5]), cvtpk_s(p1[6], p1[7])};
    pw3 = (u32x4){cvtpk_s(p1[8], p1[9]), cvtpk_s(p1[10], p1[11]), cvtpk_s(p1[12], p1[13]), cvtpk_s(p1[14], p1[15])};
    pv(o, vb, __builtin_bit_cast(bf16x8, pw0), __builtin_bit_cast(bf16x8, pw1), __builtin_bit_cast(bf16x8, pw2), __builtin_bit_cast(bf16x8, pw3));
}
__device__ __forceinline__ void store_o(const f32x16* o, float l, ALDS float* wsf, ALDS bf16_t* stg, bf16_t* Ow, int lane, int r32, int hi) {
    { auto rr = __builtin_amdgcn_permlane32_swap(__float_as_uint(l), __float_as_uint(l), false, false); l = __uint_as_float(rr[0]) + __uint_as_float(rr[1]); }
    if (hi == 0) wsf[32 + r32] = l;
    asm volatile("s_waitcnt lgkmcnt(0)" ::: "memory");
    float rli[16];
#pragma unroll
    for (int r = 0; r < 16; ++r) rli[r] = __builtin_amdgcn_rcpf(wsf[32 + crow(r, hi)]);
#pragma unroll
    for (int r = 0; r < 16; ++r) { const int orow = crow(r, hi);
#pragma unroll
        for (int d0 = 0; d0 < 2; ++d0) { const float v = o[d0][r] * rli[r]; stg[orow * 64 + d0 * 32 + r32] = (bf16_t)(cvtpk_s(v, v) & 0xffffu); } }
    asm volatile("s_waitcnt lgkmcnt(0)" ::: "memory");
#pragma unroll
    for (int i = 0; i < 4; ++i) { const int row = i * 8 + (lane >> 3), ch = lane & 7; const u32x4 v = *(const ALDS u32x4*)(stg + row * 64 + ch * 8); *(u32x4*)(Ow + (long)row * DM + ch * 8) = v; }
    asm volatile("s_waitcnt lgkmcnt(0)" ::: "memory");
}

__device__ __forceinline__ void store_o2(const f32x16* o, const f32x16& lsum, ALDS bf16_t* stg, bf16_t* Ow, int lane, int r32, int hi) {
#pragma unroll
    for (int r = 0; r < 16; ++r) { const int orow = crow(r, hi); const float rl = __builtin_amdgcn_rcpf(lsum[r]);
#pragma unroll
        for (int d0 = 0; d0 < 2; ++d0) { const float v = o[d0][r] * rl; stg[orow * 64 + d0 * 32 + r32] = (bf16_t)(cvtpk_s(v, v) & 0xffffu); } }
    asm volatile("s_waitcnt lgkmcnt(0)" ::: "memory");
#pragma unroll
    for (int i = 0; i < 4; ++i) { const int row = i * 8 + (lane >> 3), ch = lane & 7; const u32x4 v = *(const ALDS u32x4*)(stg + row * 64 + ch * 8); *(u32x4*)(Ow + (long)row * DM + ch * 8) = v; }
    asm volatile("s_waitcnt lgkmcnt(0)" ::: "memory");
}

constexpr int FX_K = 0, FX_V = 3 * SLOTB, FX_WS = 6 * SLOTB, FX_OST = FX_WS + 2048, FX_C2 = FX_OST + 8 * 4096, FX_WT = FX_C2 + SEQ * 4, FX_KA = FX_WT + 64, FX_Z = FX_KA + SEQ * 16, FX_END = FX_Z + 64;
__device__ __forceinline__ void kload8(bf16x8* kf, lds_cptr kp) {
    kf[0] = *(const ALDS bf16x8*)(kp);        kf[1] = *(const ALDS bf16x8*)(kp + 512);
    kf[2] = *(const ALDS bf16x8*)(kp + 2048); kf[3] = *(const ALDS bf16x8*)(kp + 2560);
    kf[4] = *(const ALDS bf16x8*)(kp + 4096); kf[5] = *(const ALDS bf16x8*)(kp + 4608);
    kf[6] = *(const ALDS bf16x8*)(kp + 6144); kf[7] = *(const ALDS bf16x8*)(kp + 6656);
}
__device__ __forceinline__ void kload2(bf16x8* kf, lds_cptr kp, int j) { kf[2 * j] = *(const ALDS bf16x8*)(kp + j * 2048); kf[2 * j + 1] = *(const ALDS bf16x8*)(kp + j * 2048 + 512); }
__device__ __forceinline__ s16x4 vtr(lds_cptr p) { return __builtin_bit_cast(s16x4, __builtin_amdgcn_ds_read_tr16_b64_v4i16((ALDS v4i16_t*)p)); }
__device__ __forceinline__ void fox_prepare(int b, int h, const float* logf2, lds_ptr shm) {
    int tid = threadIdx.x; asm volatile("" : "+v"(tid));
    const int lane = tid & 63; const int wid = __builtin_amdgcn_readfirstlane(tid >> 6);
    ALDS float* c2s = (ALDS float*)(shm + FX_C2); ALDS float* wtot = (ALDS float*)(shm + FX_WT);
    const float* lf = logf2 + (size_t)(b * 16 + h) * SEQ;
    const f32x4 v = *(const f32x4*)(lf + 4 * tid);
    const float a0 = v[0], a1 = a0 + v[1], a2 = a1 + v[2], a3 = a2 + v[3];
    float x = a3;
#pragma unroll
    for (int ofs = 1; ofs < 64; ofs <<= 1) { const int src = lane >= ofs ? lane - ofs : lane; const float y = __uint_as_float(__builtin_amdgcn_ds_bpermute(src << 2, __float_as_uint(x))); if (lane >= ofs) x += y; }
    if (lane == 63) wtot[wid] = x;
    ATT_WAIT_BAR(0);
    float off = 0.f;
#pragma unroll
    for (int w = 0; w < 8; ++w) { const float tw = wtot[w]; if (w < wid) off += tw; }
    const float ex = off + x - a3;
    *(ALDS f32x4*)(c2s + 4 * tid) = (f32x4){ex + a0, ex + a1, ex + a2, ex + a3};
    { const float cc[4] = {ex + a0, ex + a1, ex + a2, ex + a3};
#pragma unroll
      for (int j = 0; j < 4; ++j) { const float v0 = -cc[j];
          const unsigned h1 = cvtpk_s(v0, 0.f) & 0xffffu; const float r1 = v0 - __uint_as_float(h1 << 16);
          const unsigned h2 = cvtpk_s(r1, 0.f) & 0xffffu; const float r2 = r1 - __uint_as_float(h2 << 16);
          const unsigned h3 = cvtpk_s(r2, 0.f) & 0xffffu;
          *(ALDS u32x4*)(shm + FX_KA + (4 * tid + j) * 16) = (u32x4){h1 | (h2 << 16), h3 | 0x3F800000u, 0x3F803F80u, 0u}; }
      if (tid < 4) *(ALDS unsigned*)(shm + FX_Z + 4 * tid) = 0u; }
    ATT_WAIT_BAR(0);
}
constexpr long PNL = 1048576, SLT = 262144;
__device__ __forceinline__ void fox_cu(int h, int sel, bf16_t* PB, lds_ptr shm, float nB2) {
#define QBOF(i) (sel == 0 ? ((i) == 0 ? 7 : (i) == 1 ? 4 : (i) == 2 ? 3 : 0) : ((i) == 0 ? 6 : (i) == 1 ? 5 : (i) == 2 ? 2 : 1))
#define SLOT(t) ((((s0) + (t)) % 3) * SLOTB)
#define LOADQ(dst, qb_) do { const bf16_t* Qw_ = PB + (qb_) * PNL + (long)(wid * 32) * DM + h * 64; _Pragma("unroll") for (int d0 = 0; d0 < 4; ++d0) dst[d0] = *(const bf16x8*)(Qw_ + (long)r32 * DM + d0 * 16 + hi * 8); } while (0)
    int s0 = 0;
    bf16x8 qr[4];
    for (int ui = 0; ui < 4; ++ui) {
    int tid = threadIdx.x; asm volatile("" : "+v"(tid));
    const int lane = tid & 63, r32 = lane & 31, hi = lane >> 5; const int wid = __builtin_amdgcn_readfirstlane(tid >> 6);
    const bf16_t* Kh = PB + SLT + h * 64; const bf16_t* Vh = PB + 2 * SLT + h * 64;
    const unsigned lds0 = (unsigned)(uintptr_t)shm;
    ALDS float* wsf = (ALDS float*)(shm + FX_WS) + wid * 64;
    const ALDS float* c2s = (const ALDS float*)(shm + FX_C2);
    const bf16_t* ksrc = Kh + (long)lane * DM + wid * 8;
    const bf16_t* vsrc = Vh + (long)(16 * (wid & 3) + (lane >> 2)) * DM + (wid >> 2) * 32 + (lane & 3) * 8;
    const unsigned kdst = lds0 + FX_K + wid * 1024, vdst = lds0 + FX_V + wid * 1024;
#define TOFF(t) ((long)((t) >> 2) * PNL + (long)((t) & 3) * 64 * DM)
#define DMA_K(t, slot) glds16(ksrc + TOFF(t), (unsigned)__builtin_amdgcn_readfirstlane(kdst + (slot)))
#define DMA_V(t, slot) glds16(vsrc + TOFF(t), (unsigned)__builtin_amdgcn_readfirstlane(vdst + (slot)))
    const int vb0 = (int)(lds0 + FX_V) + ((lane >> 4) & 1) * 32 + (lane & 3) * 8 + (4 * hi + ((lane & 15) >> 2)) * 64;
    const lds_cptr shm3 = (lds_cptr)shm; const lds_cptr kp0 = shm3 + FX_K + hi * 1024 + r32 * 16; const lds_cptr vp0 = shm3 + FX_V + ((lane >> 4) & 1) * 32 + (lane & 3) * 8 + (4 * hi + ((lane & 15) >> 2)) * 64;
    bf16x8 kf[8], kaf[2];
    const lds_cptr kab = hi ? shm3 + FX_Z : shm3 + FX_KA + r32 * 16; const int kats = hi ? 0 : 1024, kah = hi ? 0 : 512;
#define KALD(t) do { kaf[0] = *(const ALDS bf16x8*)(kab + (t) * kats); kaf[1] = *(const ALDS bf16x8*)(kab + (t) * kats + kah); } while (0)
    if (ui == 0) { DMA_K(0, SLOT(0)); DMA_V(0, SLOT(0)); DMA_K(1, SLOT(1)); LOADQ(qr, QBOF(0)); DMA_K(2, SLOT(2)); }
    const int qb = QBOF(ui), q0 = qb * 256;
    const int NT = (q0 + 256) / 64;
    f32x16 lacc, o[2];
    bf16x8 ones; { _Pragma("unroll") for (int j = 0; j < 8; ++j) ones[j] = (short)0x3F80; } asm volatile("" : "+v"(ones));
#pragma unroll
    for (int r = 0; r < 16; ++r) { o[0][r] = 0.f; o[1][r] = 0.f; lacc[r] = 0.f; }
    const int qrel = wid * 32 + r32;
    bf16x8 qaug;
    { const float cq = c2s[q0 + qrel] + nB2;
      const unsigned g1 = cvtpk_s(cq, 0.f) & 0xffffu; const float r1 = cq - __uint_as_float(g1 << 16);
      const unsigned g2 = cvtpk_s(r1, 0.f) & 0xffffu; const float r2 = r1 - __uint_as_float(g2 << 16);
      const unsigned g3 = cvtpk_s(r2, 0.f) & 0xffffu;
      qaug = __builtin_bit_cast(bf16x8, (u32x4){0x3F803F80u, 0x3F80u | (g1 << 16), g2 | (g3 << 16), 0u}); }
    const f32x16 zero16 = (f32x16){0.f, 0.f, 0.f, 0.f, 0.f, 0.f, 0.f, 0.f, 0.f, 0.f, 0.f, 0.f, 0.f, 0.f, 0.f, 0.f};
#define THR(t) ((t) >= NT - 4 ? qrel - 4 * hi - 64 * ((t) - (NT - 4)) : 4096)
#define CMASK4(X, B, G, thr_) do { float tf_ = (float)((thr_) + 1); asm volatile("" : "+v"(tf_));   \
      _Pragma("unroll") for (int e = 0; e < 4; ++e) X[(B) + e] *= __builtin_fminf(__builtin_fmaxf(tf_ - (float)(8 * ((G) & 3) + 32 * ((G) >> 2) + e), 0.f), 1.f); } while (0)
    f32x16 pA0, pA1, pB0, pB1;
    int sl_prev = SLOT(0), sl_cur = SLOT(0), sl_next = SLOT(1);
#define ROT() do { sl_prev = sl_cur; sl_cur = sl_next; sl_next = (sl_next == 2 * SLOTB) ? 0 : sl_next + SLOTB; } while (0)
    ATT_WAIT_BAR(3);
    KALD(0);
    { const f32x16 d0_ = __builtin_amdgcn_mfma_f32_32x32x16_bf16(kaf[0], qaug, zero16, 0, 0, 0), d1_ = __builtin_amdgcn_mfma_f32_32x32x16_bf16(kaf[1], qaug, zero16, 0, 0, 0); qkt2(pA0, pA1, kp0 + SLOT(0), qr, d0_, d1_); }
#pragma unroll
    for (int r = 0; r < 16; ++r) { pA0[r] = __builtin_amdgcn_exp2f(pA0[r]); pA1[r] = __builtin_amdgcn_exp2f(pA1[r]); }
    { const int thr0 = THR(0);
#pragma unroll
      for (int g = 0; g < 4; ++g) { CMASK4(pA0, 4 * g, g, thr0); CMASK4(pA1, 4 * g, 4 + g, thr0); } }
    ATT_WAIT_BAR(0);
    DMA_K(3, SLOT(0)); DMA_V(1, SLOT(1));
    ROT();
    kload8(kf, kp0 + sl_cur); KALD(1);
    ATT_WAIT_BAR(2);
    s16x4 vlo[8], vhi[8]; u32x4 pw0, pw1, pw2, pw3;
#define PKW(P, B) cvtpk_s(P[B], P[B + 1])
#define PAF(k) __builtin_bit_cast(bf16x8, pw##k)
#define VFR(i) (bf16x8){vlo[i][0], vlo[i][1], vlo[i][2], vlo[i][3], vhi[i][0], vhi[i][1], vhi[i][2], vhi[i][3]}
#define PIN(x) asm volatile("" : "+v"(x))
#define MFMA32(a, b, c) __builtin_amdgcn_mfma_f32_32x32x16_bf16(a, b, c, 0, 0, 0)
#define GAPA(MF, A0, A1, A2, A3, W0, W1, PW) do { MF; W0; W1; PIN(PW); ATT_SBAR(); } while (0)
#define EX(v) __builtin_amdgcn_exp2f(v)
#define GAPB(MF, X, B, BAND, G) do { MF; X[B] = EX(X[B]); X[B + 1] = EX(X[B + 1]); X[B + 2] = EX(X[B + 2]); X[B + 3] = EX(X[B + 3]); if (BAND) CMASK4(X, B, G, thr_); PIN(X); ATT_SBAR(); } while (0)
#define VRD(i) do { vlo[i] = vtr(vp_ + (((i) >> 2) * 4096 + ((i) & 3) * 1024)); vhi[i] = vtr(vp_ + (((i) >> 2) * 4096 + ((i) & 3) * 1024 + 512)); } while (0)
#define KRD(G, j) do { if (G) { kload2(kf, kp0 + sl_next, j); ATT_SBAR(); } } while (0)
#define STEP(C0, C1, P0, P1, t, GK, GV, GL, BAND) do { ATT_SBAR(); \
    const lds_cptr vp_ = vp0 + sl_prev; \
    C0 = MFMA32(kaf[0], qaug, zero16); C1 = MFMA32(kaf[1], qaug, zero16); \
    VRD(0); ATT_SBAR(); \
    GAPA(C0 = MFMA32(kf[0], qr[0], C0), P0[2], P0[3], P0[4], P0[5],     pw0[0] = PKW(P0, 0), pw0[1] = PKW(P0, 2), pw0); \
    VRD(4); ATT_SBAR(); GAPA(C1 = MFMA32(kf[1], qr[0], C1), P0[6], P0[7], P0[8], P0[9],     pw0[2] = PKW(P0, 4), pw0[3] = PKW(P0, 6), pw0); \
    VRD(1); ATT_SBAR(); GAPA(C0 = MFMA32(kf[2], qr[1], C0),  P0[10], P0[11], P0[12], P0[13], pw1[0] = PKW(P0, 8), pw1[1] = PKW(P0, 10), pw1); \
    VRD(5); ATT_SBAR(); GAPA(C1 = MFMA32(kf[3], qr[1], C1),  P0[14], P0[15], P1[0], P1[1],   pw1[2] = PKW(P0, 12), pw1[3] = PKW(P0, 14), pw1); \
    VRD(2); ATT_SBAR(); GAPA(C0 = MFMA32(kf[4], qr[2], C0),  P1[2], P1[3], P1[4], P1[5],     pw2[0] = PKW(P1, 0), pw2[1] = PKW(P1, 2), pw2); \
    VRD(6); ATT_SBAR(); GAPA(C1 = MFMA32(kf[5], qr[2], C1),  P1[6], P1[7], P1[8], P1[9],     pw2[2] = PKW(P1, 4), pw2[3] = PKW(P1, 6), pw2); \
    VRD(3); ATT_SBAR(); GAPA(C0 = MFMA32(kf[6], qr[3], C0),  P1[10], P1[11], P1[12], P1[13], pw3[0] = PKW(P1, 8), pw3[1] = PKW(P1, 10), pw3); \
    VRD(7); ATT_SBAR(); GAPA(C1 = MFMA32(kf[7], qr[3], C1),  P1[14], P1[15], 0.f, 0.f,       pw3[2] = PKW(P1, 12), pw3[3] = PKW(P1, 14), pw3); \
    if (GK) { DMA_K((t) + 3, sl_cur); } if (GV) { DMA_V((t) + 1, sl_next); } \
    const int thr_ = (BAND) ? THR(t) : 0; \
    ATT_SBAR(); \
    GAPB(o[0] = MFMA32(PAF(0), VFR(0), o[0]), C0, 0, BAND, 0); \
    GAPB(o[1] = MFMA32(PAF(0), VFR(4), o[1]); lacc = MFMA32(PAF(0), ones, lacc), C0, 4, BAND, 1); \
    KRD(GL, 0); GAPB(o[0] = MFMA32(PAF(1), VFR(1), o[0]), C0, 8, BAND, 2); \
    KRD(GL, 1); GAPB(o[1] = MFMA32(PAF(1), VFR(5), o[1]); lacc = MFMA32(PAF(1), ones, lacc), C0, 12, BAND, 3); \
    KRD(GL, 2); GAPB(o[0] = MFMA32(PAF(2), VFR(2), o[0]), C1, 0, BAND, 4); \
    KRD(GL, 3); GAPB(o[1] = MFMA32(PAF(2), VFR(6), o[1]); lacc = MFMA32(PAF(2), ones, lacc), C1, 4, BAND, 5); \
    if (GL) { KALD((t) + 1); ATT_SBAR(); } GAPB(o[0] = MFMA32(PAF(3), VFR(3), o[0]), C1, 8, BAND, 6); \
    GAPB(o[1] = MFMA32(PAF(3), VFR(7), o[1]); lacc = MFMA32(PAF(3), ones, lacc), C1, 12, BAND, 7); \
    } while (0)
    int t = 1;
    for (; t + 5 < NT; t += 2) {
        STEP(pB0, pB1, pA0, pA1, t, true, true, true, false);     ATT_WAIT_BAR(2); ROT();
        STEP(pA0, pA1, pB0, pB1, t + 1, true, true, true, false); ATT_WAIT_BAR(2); ROT();
    }
#define ENDW(tt) do { if ((tt) + 3 < NT) { ATT_WAIT_BAR(2); } else if ((tt) + 2 < NT) { ATT_WAIT_BAR(1); } else { ATT_WAIT_BAR(0); } } while (0)
    for (; t + 1 < NT; t += 2) {
        STEP(pB0, pB1, pA0, pA1, t, (t + 3 < NT), (t + 1 < NT), (t + 1 < NT), true);         ENDW(t);     ROT();
        STEP(pA0, pA1, pB0, pB1, t + 1, (t + 4 < NT), (t + 2 < NT), (t + 2 < NT), true);     ENDW(t + 1); ROT();
    }
    STEP(pB0, pB1, pA0, pA1, NT - 1, false, false, false, true);
    bf16x8 qn[4];
    const int s0n = (s0 + NT) % 3;
    if (ui < 3) { const int s0k = s0; s0 = s0n; DMA_K(0, SLOT(0)); DMA_V(0, SLOT(0)); DMA_K(1, SLOT(1)); LOADQ(qn, QBOF(ui + 1)); DMA_K(2, SLOT(2)); s0 = s0k; }
    {
      pw0 = (u32x4){PKW(pB0, 0), PKW(pB0, 2), PKW(pB0, 4), PKW(pB0, 6)}; pw1 = (u32x4){PKW(pB0, 8), PKW(pB0, 10), PKW(pB0, 12), PKW(pB0, 14)};
      pw2 = (u32x4){PKW(pB1, 0), PKW(pB1, 2), PKW(pB1, 4), PKW(pB1, 6)}; pw3 = (u32x4){PKW(pB1, 8), PKW(pB1, 10), PKW(pB1, 12), PKW(pB1, 14)};
      ATT_SBAR(); pv(o, vb0 + sl_cur, PAF(0), PAF(1), PAF(2), PAF(3));
      lacc = MFMA32(PAF(0), ones, lacc); lacc = MFMA32(PAF(1), ones, lacc); lacc = MFMA32(PAF(2), ones, lacc); lacc = MFMA32(PAF(3), ones, lacc); }
    store_o2(o, lacc, (ALDS bf16_t*)(shm + FX_OST) + wid * 2048, PB + qb * PNL + 3 * SLT + (long)(wid * 32) * DM + h * 64, lane, r32, hi);
    ATT_LGKM_BAR();
    if (ui < 3) {
#pragma unroll
        for (int d0 = 0; d0 < 4; ++d0) qr[d0] = qn[d0];
    }
    s0 = s0n;
    }
#undef QBOF
#undef SLOT
#undef LOADQ
#undef DMA_K
#undef DMA_V
#undef TOFF
#undef KALD
#undef THR
#undef CMASK4

#undef ROT
#undef PKW
#undef PAF
#undef VFR
#undef PIN
#undef MFMA32
#undef GAPA
#undef EX
#undef GAPB
#undef VRD
#undef KRD
#undef STEP
#undef ENDW
}

__device__ __forceinline__ int t5_bucket(int n) {
    if (n < 16) return n;
    int b = 16;
    b += (n >= 19); b += (n >= 21); b += (n >= 24); b += (n >= 27); b += (n >= 31); b += (n >= 35); b += (n >= 40); b += (n >= 46);
    b += (n >= 52); b += (n >= 59); b += (n >= 67); b += (n >= 77); b += (n >= 87); b += (n >= 99); b += (n >= 113);
    return b;
}
constexpr int SW_K = 0, SW_V = 4 * SLOTB, SW_WS = 8 * SLOTB, SW_OST = SW_WS + 2048, SW_TBL = SW_OST + 8 * 4096, SW_MB = SW_TBL + 8 * 384 * 4, SW_END = SW_MB + 64;
__device__ __forceinline__ void swa_unit(int b, int kvh, int qblk, const bf16_t* Q, const bf16_t* KV, bf16_t* O, const float* sinks, const float* relb, lds_ptr shm, float qkb) {
    int tid = threadIdx.x; asm volatile("" : "+v"(tid));
    const int lane = tid & 63, r32 = lane & 31, hi = lane >> 5; const int wid = __builtin_amdgcn_readfirstlane(tid >> 6);
    const long rowbase = (long)b * SEQ; const int q0 = qblk * 128; const int jt0 = qblk == 0 ? 2 : 0;
    const unsigned lds0 = (unsigned)(uintptr_t)shm;
    const long band0 = rowbase + q0 - 128;
    {
        const long krow = band0 + lane, vrow = band0 + 16 * (wid & 3) + (lane >> 2);
        for (int jt = jt0; jt < 4; ++jt) {
            glds16(KV + (krow + 64 * jt) * 256 + kvh * 64 + wid * 8, (unsigned)__builtin_amdgcn_readfirstlane(lds0 + SW_K + jt * SLOTB + wid * 1024));
            glds16(KV + (vrow + 64 * jt) * 256 + 128 + kvh * 64 + (wid >> 2) * 32 + (lane & 3) * 8, (unsigned)__builtin_amdgcn_readfirstlane(lds0 + SW_V + jt * SLOTB + wid * 1024));
        }
    }
#define SW_LOADQ(dst, round_) do { const bf16_t* Qw_ = Q + (rowbase + q0 + 32 * (wid & 3)) * DM + (kvh * 8 + 2 * (round_) + (wid >> 2)) * 64; \
      _Pragma("unroll") for (int d0 = 0; d0 < 4; ++d0) dst[d0] = *(const bf16x8*)(Qw_ + (long)r32 * DM + d0 * 16 + hi * 8); } while (0)
    bf16x8 qc[4], qn[4];
    SW_LOADQ(qc, 0);
    ALDS float* tbl = (ALDS float*)(shm + SW_TBL); ALDS float* mb = (ALDS float*)(shm + SW_MB);
    if (tid < 8) { const int hh = kvh * 8 + tid; float m = relb[hh];
        for (int bk = 1; bk < 32; ++bk) m = fmaxf(m, relb[bk * 16 + hh]);
        mb[tid] = m * LOG2E; }
    ATT_LGKM_BAR();
    for (int idx = tid; idx < 8 * 384; idx += 512) { const int g = idx / 384, di = idx - g * 384, dist = di - 127;
        float v = -INFINITY; if (dist >= 0 && dist < 128) v = relb[t5_bucket(dist) * 16 + kvh * 8 + g] * LOG2E - (qkb + mb[g]);
        tbl[idx] = v; }
    ATT_WAIT_BAR(0);
    const int wq = wid & 3;
    ALDS float* wsf = (ALDS float*)(shm + SW_WS) + wid * 64;
    const lds_cptr kp0 = (lds_cptr)shm + SW_K + hi * 1024 + r32 * 16;
    const lds_cptr vp0 = (lds_cptr)shm + SW_V + ((lane >> 4) & 1) * 32 + (lane & 3) * 8 + (4 * hi + ((lane & 15) >> 2)) * 64;
    const int jbase = wq >> 1;
#define SW_SCORES(p0, p1, jt_) do { f32x16 c0_, c1_; const ALDS float* tj_ = tb - 64 * (jt_); \
        _Pragma("unroll") for (int r = 0; r < 16; ++r) { c0_[r] = tj_[-((r & 3) + 8 * (r >> 2))]; c1_[r] = tj_[-((r & 3) + 8 * (r >> 2)) - 32]; } \
        qkt2(p0, p1, kp0 + (jt_) * SLOTB, qc, c0_, c1_); } while (0)
#define SW_SOFT(p0, p1) do { \
        _Pragma("unroll") for (int r = 0; r < 16; ++r) { p0[r] = __builtin_amdgcn_exp2f(p0[r]); p1[r] = __builtin_amdgcn_exp2f(p1[r]); } \
        pw[0] = (u32x4){cvtpk_s(p0[0], p0[1]), cvtpk_s(p0[2], p0[3]), cvtpk_s(p0[4], p0[5]), cvtpk_s(p0[6], p0[7])}; \
        pw[1] = (u32x4){cvtpk_s(p0[8], p0[9]), cvtpk_s(p0[10], p0[11]), cvtpk_s(p0[12], p0[13]), cvtpk_s(p0[14], p0[15])}; \
        pw[2] = (u32x4){cvtpk_s(p1[0], p1[1]), cvtpk_s(p1[2], p1[3]), cvtpk_s(p1[4], p1[5]), cvtpk_s(p1[6], p1[7])}; \
        pw[3] = (u32x4){cvtpk_s(p1[8], p1[9]), cvtpk_s(p1[10], p1[11]), cvtpk_s(p1[12], p1[13]), cvtpk_s(p1[14], p1[15])}; } while (0)
#define SW_PV(jt_) do { const lds_cptr vp_ = vp0 + (jt_) * SLOTB; \
        _Pragma("unroll") for (int d0 = 0; d0 < 2; ++d0) { s16x4 vl[4], vh[4]; \
            _Pragma("unroll") for (int ks = 0; ks < 4; ++ks) { vl[ks] = vtr(vp_ + d0 * 4096 + ks * 1024); vh[ks] = vtr(vp_ + d0 * 4096 + ks * 1024 + 512); } \
            _Pragma("unroll") for (int ks = 0; ks < 4; ++ks) o[d0] = __builtin_amdgcn_mfma_f32_32x32x16_bf16(__builtin_bit_cast(bf16x8, pw[ks]), \
                (bf16x8){vl[ks][0], vl[ks][1], vl[ks][2], vl[ks][3], vh[ks][0], vh[ks][1], vh[ks][2], vh[ks][3]}, o[d0], 0, 0, 0); } \
        _Pragma("unroll") for (int ks = 0; ks < 4; ++ks) lacc = __builtin_amdgcn_mfma_f32_32x32x16_bf16(__builtin_bit_cast(bf16x8, pw[ks]), ones, lacc, 0, 0, 0);     \
        } while (0)
    bf16x8 ones; { _Pragma("unroll") for (int j = 0; j < 8; ++j) ones[j] = (short)0x3F80; } asm volatile("" : "+v"(ones));
#pragma unroll
    for (int round = 0; round < 4; ++round) {
        const int g = 2 * round + (wid >> 2), hh = kvh * 8 + g;
        if (round < 3) SW_LOADQ(qn, round + 1);
        const float B2 = qkb + mb[g];
        const float lsink = __builtin_amdgcn_exp2f(sinks[hh] * LOG2E - B2);
        f32x16 o[2], lacc;
#pragma unroll
        for (int r = 0; r < 16; ++r) { o[0][r] = 0.f; o[1][r] = 0.f; lacc[r] = lsink; }
        const ALDS float* tb = tbl + g * 384 + (255 + 32 * wq + r32 - 4 * hi);
        u32x4 pw[4];
        if (jt0 == 0) {
            f32x16 a0, a1, b0, b1;
            SW_SCORES(a0, a1, jbase); SW_SCORES(b0, b1, jbase + 1);
            SW_SOFT(a0, a1); SW_PV(jbase);
            SW_SCORES(a0, a1, jbase + 2);
            SW_SOFT(b0, b1); SW_PV(jbase + 1);
            SW_SOFT(a0, a1); SW_PV(jbase + 2);
        } else {
#pragma unroll
            for (int k = 0; k < 3; ++k) { const int jt = jbase + k;
                if (jt >= jt0) { f32x16 a0, a1; SW_SCORES(a0, a1, jt); SW_SOFT(a0, a1); SW_PV(jt); } }
        }
        store_o2(o, lacc, (ALDS bf16_t*)(shm + SW_OST) + wid * 2048, O + (rowbase + q0 + 32 * wq) * DM + hh * 64, lane, r32, hi);
        if (round < 3) {
#pragma unroll
            for (int d0 = 0; d0 < 4; ++d0) qc[d0] = qn[d0];
        }
    }
#undef SW_SCORES
#undef SW_SOFT
#undef SW_PV
#undef SW_LOADQ
    ATT_LGKM_BAR();
}
#undef ALDS
}
#define GAS __attribute__((address_space(1)))
#define LAS __attribute__((address_space(3)))
typedef unsigned short bf16;
typedef unsigned v4u __attribute__((ext_vector_type(4)));
typedef float f32x4 __attribute__((ext_vector_type(4)));
typedef short bf16x8 __attribute__((ext_vector_type(8)));
typedef GAS unsigned gu32;
typedef GAS unsigned long long gu64;
#define RLX_AGENT __ATOMIC_RELAXED, __HIP_MEMORY_SCOPE_AGENT
#define LDS_WAIT() asm volatile("s_waitcnt lgkmcnt(0)" ::: "memory")
#define VM_WAIT() asm volatile("s_waitcnt vmcnt(0)" ::: "memory")
__device__ __forceinline__ unsigned long long rt() { return __builtin_amdgcn_s_memrealtime(); }
__device__ __forceinline__ unsigned f2bf(float f) { unsigned u = __builtin_bit_cast(unsigned, f); return (u + 0x7fffu + ((u >> 16) & 1u)) >> 16; }
__device__ __forceinline__ unsigned pk2(float lo, float hi) { return f2bf(lo) | (f2bf(hi) << 16); }

#define XB_TMO      128
#define XB_XCNT(j)  (256  + 64 * (j))
#define XB_XSUB(j)  (1280 + 64 * (j))
#define XB_XGEN(j)  (2304 + 64 * (j))
#define XB_TOP      3328
#define XB_TOPGEN   3392
#define XCD_BAR_WORDS 3456
#define XB_SPIN_CAP (1u << 18)

__device__ __forceinline__ unsigned xb_ld(unsigned* p)              { return __hip_atomic_load(p, __ATOMIC_RELAXED, __HIP_MEMORY_SCOPE_AGENT); }
__device__ __forceinline__ unsigned xb_add(unsigned* p, unsigned v) { return __hip_atomic_fetch_add(p, v, __ATOMIC_RELAXED, __HIP_MEMORY_SCOPE_AGENT); }
__device__ __forceinline__ unsigned xb_xcc_id() { return (unsigned)__builtin_amdgcn_s_getreg((3 << 11) | 20) & 0xFu; }
#define XB_SPIN(cond, bar) do { unsigned _sp = 0; while (cond) { __builtin_amdgcn_s_sleep(1); \
    if ((++_sp & 255u) == 0u) { if (xb_ld(&(bar)[XB_TMO])) break; if (_sp > XB_SPIN_CAP) { atomicAdd(&(bar)[XB_TMO], 1u); break; } } } } while (0)

struct XcdBarrier {
    unsigned* bar; unsigned x; unsigned G; bool nowb;
    volatile LAS unsigned* st;
};

__device__ __forceinline__ XcdBarrier xcd_barrier_post(unsigned* bar, volatile LAS unsigned* st, unsigned G) {
    XcdBarrier b; b.bar = bar; b.x = xb_xcc_id(); b.st = st; b.G = G; b.nowb = false;
    if (threadIdx.x == 0) (void)xb_add(&bar[XB_XCNT(b.x)], 1u);
    return b;
}
__device__ __forceinline__ void xcd_barrier_complete(unsigned* bar, unsigned x, unsigned G, unsigned& nloc, unsigned& nx) {
    unsigned sum, cnt, mine, sp = 0u;
    for (;;) {
        sum = 0u; cnt = 0u; mine = 0u;
#pragma unroll
        for (unsigned j = 0; j < 16; ++j) { const unsigned c = xb_ld(&bar[XB_XCNT(j)]); sum += c; cnt += (c > 0u) ? 1u : 0u; mine = (j == x) ? c : mine; }
        if (sum == G) break;
        __builtin_amdgcn_s_sleep(1);
        if ((++sp & 255u) == 0u) { if (xb_ld(&bar[XB_TMO])) break; if (sp > XB_SPIN_CAP) { atomicAdd(&bar[XB_TMO], 1u); break; } }
    }
    nloc = mine > 0u ? mine : 1u; nx = cnt > 0u ? cnt : 1u;
}

__device__ __forceinline__ void xcd_barrier(const XcdBarrier& b) {
    asm volatile("s_waitcnt vmcnt(0)" ::: "memory");
    __syncthreads();
    if (threadIdx.x == 0) {
        unsigned* bar = b.bar;
        __builtin_amdgcn_s_waitcnt(0);
        unsigned nloc = b.st[0], nx = b.st[1];
        if (nloc == 0u) { xcd_barrier_complete(bar, b.x, b.G, nloc, nx); b.st[0] = nloc; b.st[1] = nx; }
        const unsigned old = xb_add(&bar[XB_XSUB(b.x)], 1u);
        const unsigned gen = old / nloc;
        if (nx == 1u && b.G <= 32u) {
            const unsigned target = (gen + 1u) * nloc;
            XB_SPIN(xb_ld(&bar[XB_XSUB(b.x)]) < target, bar);
            __builtin_amdgcn_fence(__ATOMIC_ACQUIRE, "agent");
            asm volatile("s_waitcnt vmcnt(0)" ::: "memory");
        } else
        if (old + 1u == (gen + 1u) * nloc) {
            if ((nx > 1u || b.G > 32u) && !b.nowb) {
            __builtin_amdgcn_fence(__ATOMIC_RELEASE, "agent");
            asm volatile("s_waitcnt vmcnt(0)" ::: "memory");
            }
            const unsigned og = xb_add(&bar[XB_TOP], 1u);
            const unsigned tg = og / nx;
            if (og + 1u == (tg + 1u) * nx) xb_add(&bar[XB_TOPGEN], 1u);
            else XB_SPIN(xb_ld(&bar[XB_TOPGEN]) == tg, bar);
            __builtin_amdgcn_fence(__ATOMIC_ACQUIRE, "agent");
            xb_add(&bar[XB_XGEN(b.x)], 1u);
            asm volatile("s_waitcnt vmcnt(0)" ::: "memory");
        } else {
            XB_SPIN(xb_ld(&bar[XB_XGEN(b.x)]) == gen, bar);
            __builtin_amdgcn_fence(__ATOMIC_ACQUIRE, "agent");
            asm volatile("s_waitcnt vmcnt(0)" ::: "memory");
        }
    }
    __syncthreads();
}

constexpr int NWAVES = 8;
#ifndef MK_SPLIT
#define MK_SPLIT 0
#endif
constexpr int NPHASE = 11;
#ifndef MK_REP
#define MK_REP 0
#endif
#define REPN(k) (1 + ((MK_REP >> (k)) & 1))
#define DRYGEMM(k, g, S) do { if ((MK_REP >> (k)) & 1) { pg8::EpiDry Ed; pg8::gemm_phase<pg8::EpiDry, pg8::StaticOrder, PG8_ALIGN, PG8_SP2>(ring, g, S, Ed); } } while (0)
#ifndef PG8_SP2
#define PG8_SP2 true
#endif
#ifndef PG8_ALIGN
#define PG8_ALIGN true
#endif

constexpr int NBATCH = 8, SEQ = 2048, D = 1024, H = 16, HD = 64, FF = 4096, NIN = 3088, KVC = 256;
constexpr int M = NBATCH * SEQ;
constexpr int NQKV_A = 3 * D, NQKV_B = D + KVC;

constexpr size_t MiB = 1u << 20;
constexpr size_t WS_CTL = 0, CTL_ZERO_BYTES = 2 * MiB;
constexpr size_t WS_SS = 1536 * 1024;
constexpr size_t WS_WQKV_A = 2 * MiB, WS_WG = 8 * MiB, WS_WO_A = 9 * MiB, WS_WUP0 = 11 * MiB, WS_WDN0 = 19 * MiB, WS_WQKV_B = 27 * MiB, WS_WO_B = 30 * MiB, WS_WUP1 = 32 * MiB, WS_WDN1 = 40 * MiB;
constexpr size_t WS_KVB = 52 * MiB;
constexpr size_t WS_LOGF = 48 * MiB;
constexpr size_t WS_ACT = 64 * MiB;
constexpr size_t WS_H = 64 * MiB;
constexpr size_t WS_XN = 192 * MiB, WS_END = 224 * MiB;
static_assert(WS_SS + 4 * (size_t)M * 4 <= CTL_ZERO_BYTES && WS_WDN1 + (size_t)D * FF * 2 <= WS_LOGF && WS_LOGF + (size_t)NBATCH * H * SEQ * 4 <= WS_KVB && WS_KVB + (size_t)M * KVC * 2 <= WS_ACT && WS_H == WS_ACT && WS_H + (size_t)M * FF * 2 <= WS_XN && WS_XN + (size_t)M * D * 2 <= WS_END, "d_ws map");
constexpr int CW_CONV = 2048, CW_CONV_B = 2112, CW_CONV_0 = 2176;
constexpr int CW_BAR = 4096;
static_assert((size_t)(CW_BAR + 73 * 3456) * 4 <= WS_SS, "barrier regions below the ss accumulators");

constexpr int RING_OFF = 0, RING_BYTES = 131072;
constexpr int LDSCTL_OFF = RING_BYTES, MISC_OFF = LDSCTL_OFF + 320;
constexpr int EPI_RR_OFF = LDSCTL_OFF + 1024, EPI_G_OFF = LDSCTL_OFF + 2048;
constexpr int LDS_BYTES = 147456;
static_assert(att::FX_END <= RING_BYTES && att::SW_END <= RING_BYTES, "attention LDS maps fit the ring region");

struct Frame {
    LAS unsigned char* lds;
    volatile LAS unsigned* MISC;
    gu32* ctl;
    int tid, lane, wave;
    int vcu, G;
};
struct Args { const float* in[18]; float* out; unsigned char* ws; int ph_lo, ph_hi; };
#define A_x        (A.in[0])
#define A_g_attn   (A.in[1])
#define A_g_mlp    (A.in[2])
#define A_w_in_a   (A.in[3])
#define A_b_f      (A.in[4])
#define A_gq_a     (A.in[5])
#define A_gk_a     (A.in[6])
#define A_w_out_a  (A.in[7])
#define A_g_kv     (A.in[8])
#define A_w_kv     (A.in[9])
#define A_gk_b     (A.in[10])
#define A_w_q_b    (A.in[11])
#define A_gq_b     (A.in[12])
#define A_sinks    (A.in[13])
#define A_rel_bias (A.in[14])
#define A_w_out_b  (A.in[15])
#define A_w_up     (A.in[16])
#define A_w_down   (A.in[17])
#define WSB(off)   ((bf16*)(A.ws + (off)))
#define WSF(off)   ((float*)(A.ws + (off)))

__device__ __forceinline__ float wave_sum(float v) {
    v += __builtin_bit_cast(float, __builtin_amdgcn_update_dpp(0, __builtin_bit_cast(int, v), 0xB1, 0xF, 0xF, true));
    v += __builtin_bit_cast(float, __builtin_amdgcn_update_dpp(0, __builtin_bit_cast(int, v), 0x4E, 0xF, 0xF, true));
    v += __builtin_bit_cast(float, __builtin_amdgcn_update_dpp(0, __builtin_bit_cast(int, v), 0x141, 0xF, 0xF, true));
    v += __builtin_bit_cast(float, __builtin_amdgcn_update_dpp(0, __builtin_bit_cast(int, v), 0x140, 0xF, 0xF, true));
    { auto r = __builtin_amdgcn_permlane16_swap(__float_as_uint(v), __float_as_uint(v), false, false); v = __uint_as_float(r[0]) + __uint_as_float(r[1]); }
    { auto r = __builtin_amdgcn_permlane32_swap(__float_as_uint(v), __float_as_uint(v), false, false); v = __uint_as_float(r[0]) + __uint_as_float(r[1]); }
    return v;
}
__device__ __forceinline__ float wave_max(float v) {
#pragma unroll
    for (int o = 1; o < 64; o <<= 1) v = fmaxf(v, __shfl_xor(v, o));
    return v;
}
__device__ __forceinline__ int headperm(int n) { return (n & ~255) + 128 * ((n >> 5) & 1) + 32 * ((n >> 6) & 3) + (n & 31); }
template <bool WT_SC1 = false>
__device__ __forceinline__ void p0_transpose_item(const float* W, int ldw, int coff, int K, int N, bf16* WT, int perm, int row_off, const float* g, LAS float* scr, int item, int lane) {
    const int nblk = N / 32, kb = item / nblk, nb = item % nblk, k0 = 64 * kb, n0 = 32 * nb;
    float wv[32];
#pragma unroll
    for (int i = 0; i < 32; ++i) wv[i] = __builtin_nontemporal_load(W + (size_t)(k0 + 2 * i + (lane >> 5)) * ldw + coff + n0 + (lane & 31));
    if (g) {
#pragma unroll
        for (int i = 0; i < 32; ++i) wv[i] *= g[k0 + 2 * i + (lane >> 5)];
    }
#pragma unroll
    for (int i = 0; i < 32; ++i) scr[(2 * i + (lane >> 5)) * 33 + (lane & 31)] = wv[i];
    LDS_WAIT(); asm volatile("" ::: "memory");
    const int c = lane & 7;
#pragma unroll
    for (int j = 0; j < 4; ++j) { const int n = (lane >> 3) + 8 * j; const LAS float* s = scr + (8 * c) * 33 + n;
        v4u o; o.x = pk2(s[0 * 33], s[1 * 33]); o.y = pk2(s[2 * 33], s[3 * 33]); o.z = pk2(s[4 * 33], s[5 * 33]); o.w = pk2(s[6 * 33], s[7 * 33]);
        const int orow = row_off + (perm ? headperm(n0 + n) : (n0 + n));
        if constexpr (WT_SC1) { const __amdgpu_buffer_rsrc_t rs = __builtin_amdgcn_make_buffer_rsrc((void*)WT, 0, 0x7fffffff, 0x00020000);
            __builtin_amdgcn_raw_buffer_store_b128(o, rs, (int)(((size_t)orow * K + k0 + 8 * c) * 2), 0, 16); }
        else *(GAS v4u*)(WT + (size_t)orow * K + k0 + 8 * c) = o; }
    LDS_WAIT(); asm volatile("" ::: "memory");
}
template <int NR> __device__ __forceinline__ void rows_to_bf16(Frame& F, const float* x, bf16* xn, float* ss0, int m0, int stride) {
    f32x4 v[NR][4];
#pragma unroll
    for (int r = 0; r < NR; ++r) { const GAS f32x4* xr = (const GAS f32x4*)(x + (size_t)(m0 + r * stride) * D) + F.lane;
#pragma unroll
        for (int j = 0; j < 4; ++j) v[r][j] = __builtin_nontemporal_load(xr + 64 * j); }
#pragma unroll
    for (int r = 0; r < NR; ++r) { float s = 0.f;
#pragma unroll
        for (int j = 0; j < 4; ++j) s += (v[r][j].x * v[r][j].x + v[r][j].y * v[r][j].y) + (v[r][j].z * v[r][j].z + v[r][j].w * v[r][j].w);
        s = wave_sum(s);
        if (F.lane == 0) ss0[m0 + r * stride] = s;
        GAS unsigned long long* o8 = (GAS unsigned long long*)(xn + (size_t)(m0 + r * stride) * D) + F.lane;
#pragma unroll
        for (int j = 0; j < 4; ++j) o8[64 * j] = (unsigned long long)pk2(v[r][j].x, v[r][j].y) | ((unsigned long long)pk2(v[r][j].z, v[r][j].w) << 32); }
}
constexpr int P0_I1 = (D / 64) * (D / 32), P0_I2 = (D / 64) * (FF / 32), P0_I3 = (FF / 64) * (D / 32), P0_I5 = (D / 64) * (KVC / 32);
constexpr int P0_NLATE = 3 * P0_I1 + 2 * P0_I2 + 2 * P0_I3 + P0_I5, P0_NLATE_A = P0_I1 + P0_I2 + P0_I3;
#ifndef MK_EARLY
#define MK_EARLY 0
#endif
constexpr int P0_EARLY = MK_EARLY;
static_assert(P0_EARLY == 0, "early items: not with the two-part late list");
__device__ __forceinline__ void p0_late_item(Frame& F, const Args& A, LAS float* scr, int r) {
    const float* W; const float* g = nullptr; int ldw, K, N, perm = 0, row_off = 0; size_t wt;
    if (r < P0_I1) { W = A_w_out_a; ldw = D; K = D; N = D; wt = WS_WO_A; }
    else if ((r -= P0_I1) < P0_I2) { W = A_w_up; ldw = FF; K = D; N = FF; wt = WS_WUP0; g = A_g_mlp; }
    else if ((r -= P0_I2) < P0_I3) { W = A_w_down; ldw = D; K = FF; N = D; wt = WS_WDN0; }
    else if ((r -= P0_I3) < P0_I1) { W = A_w_q_b; ldw = D; K = D; N = D; wt = WS_WQKV_B; perm = 1; g = A_g_attn + D; }
    else if ((r -= P0_I1) < P0_I5) { W = A_w_kv; ldw = KVC; K = D; N = KVC; wt = WS_WQKV_B; perm = 1; row_off = D; g = A_g_kv; }
    else if ((r -= P0_I5) < P0_I1) { W = A_w_out_b; ldw = D; K = D; N = D; wt = WS_WO_B; }
    else if ((r -= P0_I1) < P0_I2) { W = A_w_up + (size_t)D * FF; ldw = FF; K = D; N = FF; wt = WS_WUP1; g = A_g_mlp + D; }
    else { r -= P0_I2; W = A_w_down + (size_t)FF * D; ldw = D; K = FF; N = D; wt = WS_WDN1; }
    p0_transpose_item<true>(W, ldw, 0, K, N, WSB(wt), perm, row_off, g, scr, r, F.lane);
}
__device__ __forceinline__ void p0_prologue(Frame& F, const Args& A, bool late) {
    LAS float* scr = (LAS float*)(F.lds + RING_OFF + F.wave * 16384);
    const int gw = F.vcu * NWAVES + F.wave, NGW = F.G * NWAVES;
    constexpr int I0 = (D / 64) * (NQKV_A / 32);
    for (int it = gw; it < I0; it += NGW) p0_transpose_item<true>(A_w_in_a, NIN, 0, D, NQKV_A, WSB(WS_WQKV_A), 1, 0, A_g_attn, scr, it, F.lane);
    for (int it = gw; it < (late ? P0_NLATE : P0_EARLY); it += NGW) p0_late_item(F, A, scr, it);
    for (int e = (F.vcu * NWAVES + F.wave) * 64 + F.lane; e < 16 * D; e += F.G * NWAVES * 64) { const int n = e >> 10, k = e & 1023; __hip_atomic_store(WSB(WS_WG) + e, (bf16)f2bf(A_w_in_a[(size_t)k * NIN + 3 * D + n] * A_g_attn[k]), __ATOMIC_RELAXED, __HIP_MEMORY_SCOPE_AGENT); }
    if (late) for (int m = gw; m < M; m += NGW) rows_to_bf16<1>(F, A_x, WSB(WS_XN), WSF(WS_SS) + 3 * M, m, NGW);
}
__device__ __forceinline__ void p0_rows(Frame& F, const Args& A, int blk) {
    const int m0 = 64 * blk + F.wave;
    rows_to_bf16<4>(F, A_x, WSB(WS_XN), WSF(WS_SS) + 3 * M, m0, 8);
    rows_to_bf16<4>(F, A_x, WSB(WS_XN), WSF(WS_SS) + 3 * M, m0 + 32, 8);
}
#ifndef MK_SLOTS
#define MK_SLOTS 1
#endif
__device__ __forceinline__ int slot_of(int part, int b) {
#if MK_SLOTS == 0
    return part == 0 ? (b >= 4 ? 0 : 1) : 2 + b % 3;
#else
    return b < 4 ? 1 : 2;
#endif
}
__device__ __forceinline__ void copy_slot(Frame& F, const Args& A, int slot, int bb) {
    constexpr int NA = P0_NLATE_A, NB = P0_NLATE - P0_NLATE_A; static_assert(NA % 8 == 0 && NB % 8 == 0, "even eighths");
#pragma unroll 1
    for (int part = 0; part < 2; ++part) {
        if (slot_of(part, bb) != slot) continue;
        const int lo = part == 0 ? (NA / 8) * bb : NA + (NB / 8) * bb, hi = lo + (part == 0 ? NA / 8 : NB / 8);
        __syncthreads();
        LAS float* scr = (LAS float*)(F.lds + RING_OFF + F.wave * 16384);
        for (int it = lo + (F.vcu & 31) * NWAVES + F.wave; it < hi; it += 32 * NWAVES) p0_late_item(F, A, scr, it);
        asm volatile("s_waitcnt vmcnt(0)" ::: "memory"); __syncthreads();
        if (F.tid == 0) __hip_atomic_fetch_add((unsigned*)(F.ctl + (part == 0 ? CW_CONV : CW_CONV_B)), 1u, __ATOMIC_RELAXED, __HIP_MEMORY_SCOPE_AGENT);
    }
}
__device__ __forceinline__ void gate_job(Frame& F, const Args& A, int blk0) {
    const int lane = F.lane, fr = lane & 15, fq = lane >> 4, rg = F.wave & 3, kh = F.wave >> 2;
    for (int blk = blk0; blk < M / 64; blk += F.G) {
        const int row0 = 64 * blk + 16 * rg;
        const bf16* arow = WSB(WS_XN) + (size_t)(row0 + fr) * D + kh * 512 + 8 * fq;
        const bf16* brow = WSB(WS_WG) + (size_t)fr * D + kh * 512 + 8 * fq;
        f32x4 acc = (f32x4){0.f, 0.f, 0.f, 0.f};
#pragma unroll 8
        for (int kk = 0; kk < 16; ++kk) { const bf16x8 a = *(const bf16x8*)(arow + 32 * kk), b = *(const bf16x8*)(brow + 32 * kk); acc = __builtin_amdgcn_mfma_f32_16x16x32_bf16(a, b, acc, 0, 0, 0); }
        LAS f32x4* scr = (LAS f32x4*)(F.lds + RING_OFF) + rg * 64 + lane;
        if (kh == 1) *scr = acc;
        __syncthreads();
        if (kh == 0) { const f32x4 o = *scr; acc += o;
            const float bias = A_b_f[fr];
#pragma unroll
            for (int i = 0; i < 4; ++i) { const float rr = rsqrtf(WSF(WS_SS)[3 * M + row0 + 4 * fq + i] * (1.f / D) + 1e-6f); const float z = acc[i] * rr + bias; const float lf = fminf(z, 0.f) - log1pf(expf(-fabsf(z)));
                const int tok = row0 + 4 * fq + i, bb = tok >> 11, t = tok & (SEQ - 1);
                WSF(WS_LOGF)[(size_t)(bb * H + fr) * SEQ + t] = lf * 1.4426950408889634f; } }
        __syncthreads();
    }
}

__global__ void __launch_bounds__(NWAVES * 64, 2) yoco_fwd(Args A) {
    extern __shared__ __attribute__((aligned(16))) unsigned char lds[];
    Frame F;
    F.lds = (LAS unsigned char*)lds;
    F.MISC = (volatile LAS unsigned*)(F.lds + MISC_OFF);
    F.tid = threadIdx.x; F.lane = F.tid & 63; F.wave = __builtin_amdgcn_readfirstlane(F.tid >> 6);
    F.G = gridDim.x; { const int bx = blockIdx.x; F.vcu = (F.G % 8 == 0) ? (bx % 8) * (F.G / 8) + bx / 8 : bx; }
    F.ctl = (gu32*)(A.ws + WS_CTL);
    for (int u = F.tid; u < (LDS_BYTES - LDSCTL_OFF) / 4; u += NWAVES * 64) ((LAS unsigned*)(F.lds + LDSCTL_OFF))[u] = 0u;
    __syncthreads();
    const int lo = A.ph_lo, hi = A.ph_hi;
    const bool use_bar = (hi - lo) > 1;
    XcdBarrier bar; bar.bar = (unsigned*)(F.ctl + CW_BAR); bar.x = 0; bar.st = nullptr;
    if (use_bar) { bar = xcd_barrier_post((unsigned*)(F.ctl + CW_BAR), F.MISC + 8, (unsigned)F.G); bar.nowb = (F.G == 256); }
    const int bb = (int)(blockIdx.x & 7); const bool batch_sets = (F.G == 256);
    XcdBarrier sbar = bar;
    if (use_bar && batch_sets) sbar = xcd_barrier_post((unsigned*)(F.ctl + CW_BAR) + (1 + bb) * XCD_BAR_WORDS, F.MISC + 10, 32u);
    const int gj = (int)((blockIdx.x >> 3) & 7), gm = (int)(blockIdx.x >> 6);
    XcdBarrier gbar = sbar;
    if (use_bar && batch_sets) gbar = xcd_barrier_post((unsigned*)(F.ctl + CW_BAR) + (9 + bb * 8 + gj) * XCD_BAR_WORDS, F.MISC + 12, 4u);
    unsigned char* const pnl = A.ws + WS_ACT + (size_t)bb * (16 * MiB) + (size_t)gj * (2 * MiB);
    const size_t rp0 = (size_t)(8 * bb + gj) * 256 * 2048;
    bf16* const ACT_Q = (bf16*)(pnl - rp0); bf16* const ACT_OA = (bf16*)(pnl + 3 * 512 * 1024 - rp0);
    bf16* const ACT_QB = ACT_Q; bf16* const ACT_OB = ACT_Q;
    bf16* const ACT_KVB = WSB(WS_KVB);
    bf16* const ACT_PB = (bf16*)(A.ws + WS_ACT + (size_t)bb * (16 * MiB));
#define IN(k) (lo <= (k) && (k) < hi)
#define SEAM1(k) do { if ((k) == 0) xcd_barrier(bar); else if ((k) == 1 || (k) == 2 || (k) == 6) xcd_barrier(sbar); else xcd_barrier(gbar); } while (0)
#define SEAM(k) do { if (IN(k) && IN((k) + 1)) { SEAM1(k); if ((MK_REP >> 11) & 1) SEAM1(k); } } while (0)
    float* ss1 = WSF(WS_SS); float* ss2 = WSF(WS_SS) + M; float* ss3 = WSF(WS_SS) + 2 * M; float* ss0 = WSF(WS_SS) + 3 * M;
    LAS unsigned char* ring = F.lds + RING_OFF;
    LAS float* const epi_rr = (LAS float*)(F.lds + EPI_RR_OFF); LAS float* const epi_g = (LAS float*)(F.lds + EPI_G_OFF);
    const int my_pm = 8 * bb + gj;
#define STAGE_RR(ssp) do { if (F.tid < 256) epi_rr[F.tid] = rsqrtf((ssp)[my_pm * 256 + F.tid] * (1.f / 1024.f) + 1e-6f); } while (0)
#define STAGE_G(gq_, gk_) do { if (F.tid < 64) epi_g[F.tid] = (gq_)[F.tid] * (gk_)[F.tid] * pg8::QK_C2; } while (0)

    if (IN(0)) { for (int rep = 0; rep < REPN(0); ++rep) p0_prologue(F, A, !(use_bar && batch_sets)); }
    if (use_bar && batch_sets) {
        asm volatile("s_waitcnt vmcnt(0)" ::: "memory"); __syncthreads();
        if (F.tid == 0) __hip_atomic_fetch_add((unsigned*)(F.ctl + CW_CONV_0), 1u, __ATOMIC_RELAXED, __HIP_MEMORY_SCOPE_AGENT);
        p0_rows(F, A, 4 * (8 * bb + gj) + gm);
        copy_slot(F, A, 0, bb);
        asm volatile("s_waitcnt vmcnt(0)" ::: "memory"); __syncthreads();
        if (F.tid == 0) { unsigned sp = 0; while (__hip_atomic_load((unsigned*)(F.ctl + CW_CONV_0), __ATOMIC_RELAXED, __HIP_MEMORY_SCOPE_AGENT) < 256u) { __builtin_amdgcn_s_sleep(2); if (++sp > (1u << 22)) break; } }
        xcd_barrier(gbar);
    } else SEAM(0);
    if (IN(1)) {
        STAGE_RR(ss0); STAGE_G(A_gq_a, A_gk_a);
        gate_job(F, A, (use_bar && batch_sets) ? 4 * (8 * bb + gj) + gm : F.vcu);
        pg8::Gemm g{WSB(WS_XN), WSB(WS_WQKV_A), M, NQKV_A, D}; pg8::StaticOrder S; S.init(M, NQKV_A, F.G, (int)blockIdx.x);
        pg8::EpiHead E{ACT_Q, (size_t)(512 * 1024) / 2, nullptr, epi_g, epi_rr, 0};
        DRYGEMM(1, g, S);
        if ((MK_REP >> 13) & 1) { gate_job(F, A, (use_bar && batch_sets) ? 4 * (8 * bb + gj) + gm : F.vcu); pg8::gemm_phase<pg8::EpiHead, pg8::StaticOrder, PG8_ALIGN, PG8_SP2>(ring, g, S, E); }
        pg8::gemm_phase<pg8::EpiHead, pg8::StaticOrder, PG8_ALIGN, PG8_SP2>(ring, g, S, E);
    } SEAM(1);
    if (IN(1) && use_bar && batch_sets) copy_slot(F, A, 1, bb);
    if (IN(2)) {
        int ln = F.lane; asm volatile("" : "+v"(ln));
        const float gqm = wave_max(fabsf(A_gq_a[ln])), gkm = wave_max(fabsf(A_gk_a[ln]));
        const float nB2 = -(8.f * gqm * gkm * 1.01f * att::LOG2E);
        for (int rep = 0; rep < REPN(2); ++rep)
        for (int c = F.vcu; c < 256; c += F.G) {
            const int bh = c >> 1, s = c & 1;
            att::fox_prepare(bh >> 4, bh & 15, WSF(WS_LOGF), (att::lds_ptr)ring);
            att::fox_cu(bh & 15, s, ACT_PB, (att::lds_ptr)ring, nB2);
        }
    }
    if (IN(2) && use_bar && batch_sets) copy_slot(F, A, 2, bb);
    if (IN(2) && IN(3) && use_bar && batch_sets) {
        if (F.tid == 0) { unsigned sp = 0; while (__hip_atomic_load((unsigned*)(F.ctl + CW_CONV), __ATOMIC_RELAXED, __HIP_MEMORY_SCOPE_AGENT) < 256u) { __builtin_amdgcn_s_sleep(2); if (++sp > (1u << 22)) break; } }
    }
    SEAM(2);
    if (IN(3)) {
        pg8::Gemm g{ACT_OA, WSB(WS_WO_A), M, D, D}; pg8::StaticOrder S; S.init(M, D, F.G, (int)blockIdx.x);
        pg8::EpiResid<1> E{nullptr, WSB(WS_XN), nullptr, ss1, nullptr};
        DRYGEMM(3, g, S);
        pg8::gemm_phase<pg8::EpiResid<1>, pg8::StaticOrder, PG8_ALIGN, PG8_SP2>(ring, g, S, E);
        if (use_bar && batch_sets) copy_slot(F, A, 3, bb);
    } SEAM(3);
    if (IN(4)) {
        pg8::Gemm g{WSB(WS_XN), WSB(WS_WUP0), M, FF, D}; pg8::StaticOrder S; S.init(M, FF, F.G, (int)blockIdx.x);
        STAGE_RR(ss1); __syncthreads();
        pg8::EpiAct E{WSB(WS_H), FF};
        DRYGEMM(4, g, S);
        if ((MK_REP >> 12) & 1) pg8::gemm_phase<pg8::EpiAct, pg8::StaticOrder, PG8_ALIGN, PG8_SP2>(ring, g, S, E);
        pg8::gemm_phase<pg8::EpiAct, pg8::StaticOrder, PG8_ALIGN, PG8_SP2>(ring, g, S, E);
        if (use_bar && batch_sets) copy_slot(F, A, 4, bb);
    } SEAM(4);
    if (IN(5)) {
        pg8::Gemm g{WSB(WS_H), WSB(WS_WDN0), M, D, FF}; pg8::StaticOrder S; S.init(M, D, F.G, (int)blockIdx.x);
        if (!use_bar) { STAGE_RR(ss1); __syncthreads(); }
        pg8::EpiResid<1, true> E{nullptr, WSB(WS_XN), nullptr, ss2, epi_rr};
        DRYGEMM(5, g, S);
        pg8::gemm_phase<pg8::EpiResid<1, true>, pg8::StaticOrder, PG8_ALIGN, PG8_SP2>(ring, g, S, E);
    }
    if (IN(5) && IN(6) && use_bar && batch_sets) {
        if (F.tid == 0) { unsigned sp = 0; while (__hip_atomic_load((unsigned*)(F.ctl + CW_CONV_B), __ATOMIC_RELAXED, __HIP_MEMORY_SCOPE_AGENT) < 256u) { __builtin_amdgcn_s_sleep(2); if (++sp > (1u << 22)) break; } }
    }
    SEAM(5);
    if (IN(6)) {
        pg8::Gemm g{WSB(WS_XN), WSB(WS_WQKV_B), M, NQKV_B, D}; pg8::StaticOrder S; S.init(M, NQKV_B, F.G, (int)blockIdx.x);
        STAGE_RR(ss2); STAGE_G(A_gq_b, A_gk_b); __syncthreads();
        pg8::EpiHead E{ACT_QB, 0, ACT_KVB, epi_g, epi_rr, 1};
        DRYGEMM(6, g, S);
        if ((MK_REP >> 14) & 1) pg8::gemm_phase<pg8::EpiHead, pg8::StaticOrder, PG8_ALIGN, PG8_SP2>(ring, g, S, E);
        pg8::gemm_phase<pg8::EpiHead, pg8::StaticOrder, PG8_ALIGN, PG8_SP2>(ring, g, S, E);
    } SEAM(6);
    if (IN(7)) {
        int ln = F.lane; asm volatile("" : "+v"(ln));
        const float gqm = wave_max(fabsf(A_gq_b[ln])), gkm = wave_max(fabsf(A_gk_b[ln]));
        const float qkb = 8.f * gqm * gkm * 1.01f * att::LOG2E;
        for (int rep = 0; rep < REPN(7); ++rep)
            att::swa_unit(bb, gm >> 1, 2 * gj + (gm & 1), ACT_QB, ACT_KVB, ACT_OB, A_sinks, A_rel_bias, (att::lds_ptr)ring, qkb);
    } SEAM(7);
    if (IN(8)) {
        pg8::Gemm g{ACT_OB, WSB(WS_WO_B), M, D, D}; pg8::StaticOrder S; S.init(M, D, F.G, (int)blockIdx.x);
        pg8::EpiResid<1> E{nullptr, WSB(WS_XN), nullptr, ss3, nullptr};
        DRYGEMM(8, g, S);
        pg8::gemm_phase<pg8::EpiResid<1>, pg8::StaticOrder, PG8_ALIGN, PG8_SP2>(ring, g, S, E);
    } SEAM(8);
    if (IN(9)) {
        pg8::Gemm g{WSB(WS_XN), WSB(WS_WUP1), M, FF, D}; pg8::StaticOrder S; S.init(M, FF, F.G, (int)blockIdx.x);
        STAGE_RR(ss3); __syncthreads();
        pg8::EpiAct E{WSB(WS_H), FF};
        DRYGEMM(9, g, S);
        pg8::gemm_phase<pg8::EpiAct, pg8::StaticOrder, PG8_ALIGN, PG8_SP2>(ring, g, S, E);
    } SEAM(9);
    if (IN(10)) {
        pg8::Gemm g{WSB(WS_H), WSB(WS_WDN1), M, D, FF}; pg8::StaticOrder S; S.init(M, D, F.G, (int)blockIdx.x);
        if (!use_bar) { STAGE_RR(ss3); __syncthreads(); }
        pg8::EpiResid<2, true> E{nullptr, WSB(WS_XN), A.out, nullptr, epi_rr};
        DRYGEMM(10, g, S);
        pg8::gemm_phase<pg8::EpiResid<2, true>, pg8::StaticOrder, PG8_ALIGN, PG8_SP2>(ring, g, S, E);
    }
#undef IN
#undef SEAM
}

extern "C" void kernel_launch(void* const* d_in, const int* in_sizes, int n_in, void* d_out, int out_size, void* d_ws, size_t ws_size, hipStream_t stream) {
    static int grid = 0;
    if (grid == 0) {
        if (n_in != 18 || in_sizes[0] != M * D || out_size != M * D || ws_size < WS_END) { fprintf(stderr, "kernel_launch: unexpected shapes (n_in %d, in0 %d, out %d, ws %zu); nothing launched\n", n_in, n_in > 0 ? in_sizes[0] : -1, out_size, ws_size); grid = -1; return; }
        int dev = 0, cus = 0, per_cu = 0;
        if (hipGetDevice(&dev) != hipSuccess || hipDeviceGetAttribute(&cus, hipDeviceAttributeMultiprocessorCount, dev) != hipSuccess) { grid = -1; return; }
        if (hipFuncSetAttribute((const void*)yoco_fwd, hipFuncAttributeMaxDynamicSharedMemorySize, LDS_BYTES) != hipSuccess) { fprintf(stderr, "kernel_launch: hipFuncSetAttribute failed\n"); grid = -1; return; }
        if (hipOccupancyMaxActiveBlocksPerMultiprocessor(&per_cu, (const void*)yoco_fwd, NWAVES * 64, LDS_BYTES) != hipSuccess || per_cu < 1)
            fprintf(stderr, "kernel_launch: note: occupancy query reports %d workgroups per CU\n", per_cu);
        (void)hipGetLastError();
        grid = cus;
        if (grid != 256) { fprintf(stderr, "kernel_launch: built for a 256-CU device (batch-set unit orders); found %d CUs; nothing launched\n", cus); grid = -1; return; }
    }
    if (grid < 0) return;
    if (hipMemsetAsync((char*)d_ws + WS_CTL, 0, CTL_ZERO_BYTES, stream) != hipSuccess) { fprintf(stderr, "kernel_launch: hipMemsetAsync failed\n"); return; }
    Args a{};
    for (int i = 0; i < 18; ++i) a.in[i] = (const float*)d_in[i];
    a.out = (float*)d_out; a.ws = (unsigned char*)d_ws;
#if MK_SPLIT
    for (int p = 0; p < NPHASE; ++p) { a.ph_lo = p; a.ph_hi = p + 1; hipLaunchKernelGGL(yoco_fwd, dim3(grid), dim3(NWAVES * 64), LDS_BYTES, stream, a); }
#else
    a.ph_lo = 0; a.ph_hi = NPHASE;
    hipLaunchKernelGGL(yoco_fwd, dim3(grid), dim3(NWAVES * 64), LDS_BYTES, stream, a);
#endif
    const hipError_t le = hipPeekAtLastError();
    if (le != hipSuccess) fprintf(stderr, "kernel_launch: launch failed: %s\n", hipGetErrorName(le));
}
```

```cpp
#include <hip/hip_runtime.h>
#include <hip/hip_bf16.h>
#include <cstdio>
#include <cstdint>
#include <cmath>
namespace pg8 {
#define PG8_LAS __attribute__((address_space(3)))
typedef unsigned short bf16_t;
typedef short bf16x8 __attribute__((ext_vector_type(8)));
typedef float f32x4 __attribute__((ext_vector_type(4)));
typedef unsigned u32x4 __attribute__((ext_vector_type(4)));
constexpr int BM = 256, BK = 64, HALF = 128, HTB = HALF * BK * 2  , STAGE_BYTES = 8 * HTB, NXCD = 8, WGM = 8;

__host__ __device__ __forceinline__ int lds_byte(int r, int c) { const int st = (r >> 4) * 2 + (c >> 5), rr = r & 15, cc = c & 31, ob = rr * 64 + cc * 2; return st * 1024 + (ob ^ (((ob >> 9) & 1) << 5)); }
__host__ __device__ __forceinline__ void stage_rc(int b, int& R, int& C) { const int st = b / 1024, sb = b % 1024, swz = sb ^ (((sb >> 9) & 1) << 5); R = (st >> 1) * 16 + swz / 64; C = (st & 1) * 32 + (swz % 64) / 2; }
__host__ __device__ __forceinline__ int perm32(int rho) { const int n = rho >> 4, i = rho & 15; return 8 * (i >> 2) + 4 * n + (i & 3); }

struct Unit { int pm, pn; };
struct Gemm { const bf16_t* A; const bf16_t* Bt; int M, N, K; };

struct StaticOrder {
    int nM, nN, nwg, G, c;
    __host__ __device__ void init(int M, int N, int G_, int c_) { nM = M / BM; nN = N / BM; nwg = nM * nN; G = G_; c = c_; }
    __host__ __device__ bool next(int i, Unit& u) const {
        const long L = (long)i * G + c; if (L >= nwg) return false;
        int wgid = (int)L; { const int q = nwg / NXCD, r = nwg % NXCD, xcd = wgid % NXCD, off = wgid / NXCD; wgid = (xcd < r ? xcd * (q + 1) : r * (q + 1) + (xcd - r) * q) + off; }
        const int nig = WGM * nN, gid = wgid / nig, fm = gid * WGM, gsz = (nM - fm) < WGM ? (nM - fm) : WGM;
        u.pm = fm + ((wgid % nig) % gsz); u.pn = (wgid % nig) / gsz; return true;
    }
    __device__ __forceinline__ void a_ready(const Unit&) const {}
    __device__ __forceinline__ void done(const Unit&) const {}
};
__device__ __forceinline__ unsigned cvt_pk_bf16(float lo, float hi) { unsigned r; asm volatile("v_cvt_pk_bf16_f32 %0, %1, %2" : "=v"(r) : "v"(lo), "v"(hi)); return r; }
typedef unsigned u32x2 __attribute__((ext_vector_type(2)));
constexpr float QK_C2 = 0.125f * 1.4426950408889634f;
constexpr float RMS_EPS = 1e-6f;

__device__ __forceinline__ float sum_fq(float s) {
    { auto r = __builtin_amdgcn_permlane16_swap(__float_as_uint(s), __float_as_uint(s), false, false); s = __uint_as_float(r[0]) + __uint_as_float(r[1]); }
    { auto r = __builtin_amdgcn_permlane32_swap(__float_as_uint(s), __float_as_uint(s), false, false); s = __uint_as_float(r[0]) + __uint_as_float(r[1]); }
    return s;
}
typedef float f32x2 __attribute__((ext_vector_type(2)));
__device__ __forceinline__ float sumsq16(const f32x4& a, const f32x4& b, const f32x4& c, const f32x4& d) {
    f32x2 s = a.xy * a.xy;
    s = __builtin_elementwise_fma(a.zw, a.zw, s); s = __builtin_elementwise_fma(b.xy, b.xy, s); s = __builtin_elementwise_fma(b.zw, b.zw, s);
    s = __builtin_elementwise_fma(c.xy, c.xy, s); s = __builtin_elementwise_fma(c.zw, c.zw, s); s = __builtin_elementwise_fma(d.xy, d.xy, s); s = __builtin_elementwise_fma(d.zw, d.zw, s);
    return s.x + s.y;
}
struct EpiHead {
    static constexpr bool PERM = true, AFTER_DRAIN = false; static constexpr int NST = 32;
    bf16_t* dq; size_t cls_stride; bf16_t* dkv; const PG8_LAS float* gl; const PG8_LAS float* rrl; int layerB;
    __device__ __forceinline__ void operator()(const f32x4 (&acc)[2][2][4][2], const Unit& u, int wr, int wc, int fr0, int fq0) const {
        int ln = fr0 | (fq0 << 4); asm volatile("" : "+v"(ln)); const int fr = ln & 15, fq = ln >> 4;
        bf16_t* base; int ld, colbase, mode;
        if (!layerB) { const int cls = u.pn >> 2; base = dq + (size_t)cls * cls_stride; ld = 1024; colbase = 256 * (u.pn & 3); mode = cls; }
        else if (u.pn < 4) { base = dq; ld = 1024; colbase = 256 * u.pn; mode = 0; }
        else { base = dkv; ld = 256; colbase = 0; mode = wc < 2 ? 1 : 2; }
        const int row0 = u.pm * BM + wr * 64 + fr;
        bf16_t* p0 = base + (size_t)row0 * ld + colbase + 64 * wc + 8 * fq;
        if (mode == 0) {
            f32x4 gv[2][2];
#pragma unroll
            for (int bj = 0; bj < 2; ++bj)
#pragma unroll
                for (int n = 0; n < 2; ++n) gv[bj][n] = *(const PG8_LAS f32x4*)(gl + 32 * bj + 8 * fq + 4 * n);
#pragma unroll
            for (int ai = 0; ai < 2; ++ai)
#pragma unroll
                for (int m = 0; m < 4; ++m) {
                    const float rr = rrl[wr * 64 + fr + ai * HALF + m * 16];
                    const float s = sum_fq(sumsq16(acc[ai][0][m][0], acc[ai][0][m][1], acc[ai][1][m][0], acc[ai][1][m][1]));
                    const float t = rr * __builtin_amdgcn_rsqf(rr * rr * s * (1.f / 64.f) + RMS_EPS);
                    bf16_t* rowp = p0 + (size_t)(ai * HALF + m * 16) * ld;
#pragma unroll
                    for (int bj = 0; bj < 2; ++bj) { const f32x4 v0 = acc[ai][bj][m][0] * gv[bj][0] * t, v1 = acc[ai][bj][m][1] * gv[bj][1] * t;
                        u32x4 w; w.x = cvt_pk_bf16(v0[0], v0[1]); w.y = cvt_pk_bf16(v0[2], v0[3]); w.z = cvt_pk_bf16(v1[0], v1[1]); w.w = cvt_pk_bf16(v1[2], v1[3]);
                        *(u32x4*)(rowp + 32 * bj) = w; }
                }
        } else {
#pragma unroll
            for (int ai = 0; ai < 2; ++ai)
#pragma unroll
                for (int m = 0; m < 4; ++m) {
                    float t = rrl[wr * 64 + fr + ai * HALF + m * 16];
                    if (mode == 1) { const float s = sum_fq(sumsq16(acc[ai][0][m][0], acc[ai][0][m][1], acc[ai][1][m][0], acc[ai][1][m][1])); t = t * __builtin_amdgcn_rsqf(t * t * s * (1.f / 64.f) + RMS_EPS); }
                    bf16_t* rowp = p0 + (size_t)(ai * HALF + m * 16) * ld;
#pragma unroll
                    for (int bj = 0; bj < 2; ++bj) { const f32x4 v0 = acc[ai][bj][m][0] * t, v1 = acc[ai][bj][m][1] * t;
                        u32x4 w; w.x = cvt_pk_bf16(v0[0], v0[1]); w.y = cvt_pk_bf16(v0[2], v0[3]); w.z = cvt_pk_bf16(v1[0], v1[1]); w.w = cvt_pk_bf16(v1[2], v1[3]);
                        *(u32x4*)(rowp + 32 * bj) = w; }
                }
        }
    }
};

struct EpiAct {
    static constexpr bool PERM = true, AFTER_DRAIN = false; static constexpr int NST = 32;
    bf16_t* O; int ldc;
    __device__ __forceinline__ void operator()(const f32x4 (&acc)[2][2][4][2], const Unit& u, int wr, int wc, int fr, int fq) const {
        const int row0 = u.pm * BM + wr * 64 + fr, col0 = u.pn * BM + wc * 32 + 8 * fq;
#pragma unroll
        for (int ai = 0; ai < 2; ++ai)
#pragma unroll
            for (int m = 0; m < 4; ++m) {
                const int row = row0 + ai * HALF + m * 16;
                bf16_t* rowp = O + (size_t)row * ldc + col0;
#pragma unroll
                for (int bj = 0; bj < 2; ++bj) { f32x4 v0 = acc[ai][bj][m][0], v1 = acc[ai][bj][m][1];
#pragma unroll
                    for (int e = 0; e < 4; ++e) { v0[e] = __int_as_float(max(__float_as_int(v0[e]), 0)); v1[e] = __int_as_float(max(__float_as_int(v1[e]), 0)); }
                    v0 = v0 * v0; v1 = v1 * v1;
                    u32x4 w; w.x = cvt_pk_bf16(v0[0], v0[1]); w.y = cvt_pk_bf16(v0[2], v0[3]); w.z = cvt_pk_bf16(v1[0], v1[1]); w.w = cvt_pk_bf16(v1[2], v1[3]);
                    *(u32x4*)(rowp + bj * HALF) = w; }
            }
    }
};

template <int MODE, bool SCALE = false> struct EpiResid {
    static constexpr bool PERM = true, AFTER_DRAIN = false; static constexpr int NST = 0;
    const float* base32; bf16_t* xn; float* out32; float* ss; const PG8_LAS float* rrl;
    __device__ __forceinline__ void operator()(const f32x4 (&acc)[2][2][4][2], const Unit& u, int wr, int wc, int fr, int fq) const {
        const int row0 = u.pm * BM + wr * 64 + fr, col0 = u.pn * BM + wc * 32 + 8 * fq;
#pragma unroll
        for (int ai = 0; ai < 2; ++ai)
#pragma unroll
            for (int m = 0; m < 4; ++m) {
                const int row = row0 + ai * HALF + m * 16; const size_t off = (size_t)row * 1024 + col0;
                float s = 0.f, sc = 1.f;
                if (SCALE) { const float rr = rrl[wr * 64 + fr + ai * HALF + m * 16]; sc = rr * rr; }
#pragma unroll
                for (int bj = 0; bj < 2; ++bj) {
                    f32x4 r0, r1;
                    if (MODE == 0) { r0 = __builtin_nontemporal_load((const f32x4*)(base32 + off + bj * HALF)); r1 = __builtin_nontemporal_load((const f32x4*)(base32 + off + bj * HALF + 4)); }
                    else { const u32x4 w = MODE == 2 ? __builtin_nontemporal_load((const u32x4*)(xn + off + bj * HALF)) : *(const u32x4*)(xn + off + bj * HALF);
                        r0 = (f32x4){__uint_as_float(w.x << 16), __uint_as_float(w.x & 0xffff0000u), __uint_as_float(w.y << 16), __uint_as_float(w.y & 0xffff0000u)};
                        r1 = (f32x4){__uint_as_float(w.z << 16), __uint_as_float(w.z & 0xffff0000u), __uint_as_float(w.w << 16), __uint_as_float(w.w & 0xffff0000u)}; }
                    const f32x4 o0 = SCALE ? r0 + acc[ai][bj][m][0] * sc : r0 + acc[ai][bj][m][0], o1 = SCALE ? r1 + acc[ai][bj][m][1] * sc : r1 + acc[ai][bj][m][1];
                    if (MODE == 2) { __builtin_nontemporal_store(o0, (f32x4*)(out32 + off + bj * HALF)); __builtin_nontemporal_store(o1, (f32x4*)(out32 + off + bj * HALF + 4)); }
                    else { u32x4 w; w.x = cvt_pk_bf16(o0[0], o0[1]); w.y = cvt_pk_bf16(o0[2], o0[3]); w.z = cvt_pk_bf16(o1[0], o1[1]); w.w = cvt_pk_bf16(o1[2], o1[3]);
                        *(u32x4*)(xn + off + bj * HALF) = w;
                        s += ((o0[0] * o0[0] + o0[1] * o0[1]) + (o0[2] * o0[2] + o0[3] * o0[3])) + ((o1[0] * o1[0] + o1[1] * o1[1]) + (o1[2] * o1[2] + o1[3] * o1[3])); }
                }
                if (MODE != 2) { s = sum_fq(s);
                    if (fq == 0) __hip_atomic_fetch_add(ss + row, s, __ATOMIC_RELAXED, __HIP_MEMORY_SCOPE_AGENT); }
                if (m & 1) asm volatile("" ::: "memory");
            }
    }
};

struct EpiDry {
    static constexpr bool PERM = false, AFTER_DRAIN = false; static constexpr int NST = 0;
    __device__ __forceinline__ void operator()(const f32x4 (&acc)[2][2][4][2], const Unit& u, int wr, int wc, int fr, int fq) const {
#pragma unroll
        for (int ai = 0; ai < 2; ++ai)
#pragma unroll
            for (int bj = 0; bj < 2; ++bj)
#pragma unroll
                for (int m = 0; m < 4; ++m)
#pragma unroll
                    for (int n = 0; n < 2; ++n) asm volatile("" :: "v"(acc[ai][bj][m][n]));
    }
};
template <class Epi, class Sched, bool ALIGN_EPI = false, bool SP2 = false>
__device__ __forceinline__ void gemm_phase(PG8_LAS unsigned char* lds, const Gemm g, const Sched& S, const Epi& E) {
    const int tid = threadIdx.x, wid = __builtin_amdgcn_readfirstlane(tid >> 6), lane = tid & 63, wr = wid >> 2, wc = wid & 3, fr = lane & 15, fq = lane >> 4;
    const int K = g.K, nt = K / BK;
    unsigned voffA[2], voffB[2];
#pragma unroll
    for (int i = 0; i < 2; ++i) { int R, C; stage_rc(tid * 16 + i * 8192, R, C); const int Rb = Epi::PERM ? ((R & ~31) + perm32(R & 31)) : R;
        voffA[i] = (unsigned)(R * K + C) * 2u; voffB[i] = (unsigned)(Rb * K + C) * 2u; }
    const size_t kstep = (size_t)(BK * 2);
    const size_t hstep = (size_t)HALF * K * 2;
    const size_t tstep = 2 * hstep;
    const unsigned ldsw = (unsigned)wid * 1024u;
    const int aoff = lds_byte(wr * 64 + fr, fq * 8), boff = lds_byte(wc * 32 + fr, fq * 8);
#define PG8_SA(b, h) (((b) * 2 + (h)) * HTB)
#define PG8_SB(b, h) ((4 + (b) * 2 + (h)) * HTB)
#define PG8_STAGE(bufoff, gbase, voff) do { _Pragma("unroll") for (int _i = 0; _i < 2; ++_i) \
        __builtin_amdgcn_global_load_lds((const unsigned*)((const char*)(gbase) + (voff)[_i]), (PG8_LAS unsigned*)(lds + (bufoff) + ldsw + _i * 8192), 16, 0, 0); } while (0)
#define PG8_LDA(dst, b, h) do { _Pragma("unroll") for (int m = 0; m < 4; ++m) _Pragma("unroll") for (int k = 0; k < 2; ++k) dst[m][k] = *(const PG8_LAS bf16x8*)(lds + PG8_SA(b, h) + aoff + m * 2048 + k * 1024); } while (0)
#define PG8_LDB(dst, b, h) do { _Pragma("unroll") for (int n = 0; n < 2; ++n) _Pragma("unroll") for (int k = 0; k < 2; ++k) dst[n][k] = *(const PG8_LAS bf16x8*)(lds + PG8_SB(b, h) + boff + n * 2048 + k * 1024); } while (0)
#define PG8_MMA(ai, bj, At, Bt) do { __builtin_amdgcn_s_setprio(1); _Pragma("unroll") for (int m = 0; m < 4; ++m) _Pragma("unroll") for (int n = 0; n < 2; ++n) _Pragma("unroll") for (int k = 0; k < 2; ++k) \
        acc[ai][bj][m][n] = __builtin_amdgcn_mfma_f32_16x16x32_bf16(Bt[n][k], At[m][k], acc[ai][bj][m][n], 0, 0, 0); __builtin_amdgcn_s_setprio(0); } while (0)
#define PG8_WAIT_V(n) asm volatile("s_waitcnt vmcnt(" #n ")" ::: "memory")
#define PG8_WAIT_L(n) asm volatile("s_waitcnt lgkmcnt(" #n ")" ::: "memory")
#define PG8_BAR __builtin_amdgcn_s_barrier()
#define PG8_SCHED __builtin_amdgcn_sched_barrier(0)
    Unit cur, nxt; int ui = 0;
    if (!S.next(0, cur)) return;
    f32x4 acc[2][2][4][2];
#pragma unroll
    for (int a = 0; a < 2; ++a)
#pragma unroll
        for (int b = 0; b < 2; ++b)
#pragma unroll
            for (int m = 0; m < 4; ++m)
#pragma unroll
                for (int n = 0; n < 2; ++n) acc[a][b][m][n] = (f32x4){0.f, 0.f, 0.f, 0.f};
    bf16x8 At[4][2], B0[2][2], B1[2][2];
    const char* cA = (const char*)g.A + (size_t)cur.pm * tstep; const char* cB = (const char*)g.Bt + (size_t)cur.pn * tstep;
    S.a_ready(cur);
    if constexpr (SP2) {
        PG8_STAGE(PG8_SB(0, 0), cB, voffB); PG8_STAGE(PG8_SB(0, 1), cB + hstep, voffB); PG8_STAGE(PG8_SA(0, 0), cA, voffA); PG8_STAGE(PG8_SA(0, 1), cA + hstep, voffA);
        if (wr == 1) PG8_BAR;
        PG8_WAIT_V(2); PG8_BAR;
        PG8_STAGE(PG8_SB(1, 0), cB + kstep, voffB); PG8_STAGE(PG8_SA(1, 0), cA + kstep, voffA); PG8_STAGE(PG8_SB(1, 1), cB + hstep + kstep, voffB);
        PG8_WAIT_V(6); PG8_BAR;
    } else {
        PG8_STAGE(PG8_SB(0, 0), cB, voffB); PG8_STAGE(PG8_SA(0, 0), cA, voffA); PG8_STAGE(PG8_SB(0, 1), cB + hstep, voffB); PG8_STAGE(PG8_SA(0, 1), cA + hstep, voffA);
        if (wr == 1) PG8_BAR;
        PG8_WAIT_V(4); PG8_BAR;
        PG8_STAGE(PG8_SB(1, 0), cB + kstep, voffB); PG8_STAGE(PG8_SA(1, 0), cA + kstep, voffA); PG8_STAGE(PG8_SB(1, 1), cB + hstep + kstep, voffB);
        PG8_WAIT_V(6); PG8_BAR;
    }
    for (;;) {
        const bool has_next = S.next(ui + 1, nxt);
        const char* nA = has_next ? (const char*)g.A + (size_t)nxt.pm * tstep : cA; const char* nB = has_next ? (const char*)g.Bt + (size_t)nxt.pn * tstep : cB;
        for (int t = 0; t < nt; t += 2) {
            const bool last = (t == nt - 2);
            const char* a1 = cA + (size_t)(t + 1) * kstep;
            const char* a2 = last ? nA : cA + (size_t)(t + 2) * kstep; const char* b2 = last ? nB : cB + (size_t)(t + 2) * kstep;
            const char* a3 = a2 + kstep; const char* b3 = b2 + kstep;
            if (last && has_next) S.a_ready(nxt);
            if constexpr (SP2) {
            PG8_LDB(B0, 0, 0); PG8_LDB(B1, 0, 1); PG8_SCHED; PG8_LDA(At, 0, 0); PG8_STAGE(PG8_SA(1, 1), a1 + hstep, voffA);
            PG8_WAIT_V(8); PG8_WAIT_L(0); PG8_BAR; PG8_MMA(0, 0, At, B0); PG8_MMA(0, 1, At, B1); PG8_BAR; PG8_SCHED;
            PG8_LDA(At, 0, 1); PG8_STAGE(PG8_SB(0, 0), b2, voffB); PG8_STAGE(PG8_SB(0, 1), b2 + hstep, voffB); PG8_STAGE(PG8_SA(0, 0), a2, voffA);
            PG8_WAIT_V(8); PG8_WAIT_L(0); PG8_BAR; PG8_MMA(1, 0, At, B0); PG8_MMA(1, 1, At, B1); PG8_BAR; PG8_SCHED;
            PG8_LDB(B0, 1, 0); PG8_LDB(B1, 1, 1); PG8_SCHED; PG8_LDA(At, 1, 0); PG8_STAGE(PG8_SA(0, 1), a2 + hstep, voffA);
            PG8_WAIT_V(8); PG8_WAIT_L(0); PG8_BAR; PG8_MMA(0, 0, At, B0); PG8_MMA(0, 1, At, B1); PG8_BAR; PG8_SCHED;
            PG8_LDA(At, 1, 1); PG8_STAGE(PG8_SB(1, 0), b3, voffB); PG8_STAGE(PG8_SB(1, 1), b3 + hstep, voffB); PG8_STAGE(PG8_SA(1, 0), a3, voffA);
            PG8_WAIT_V(8); PG8_WAIT_L(0); PG8_BAR; PG8_MMA(1, 0, At, B0); PG8_MMA(1, 1, At, B1); PG8_BAR; PG8_SCHED;
            } else {
            PG8_LDB(B0, 0, 0); PG8_SCHED; PG8_LDA(At, 0, 0); PG8_STAGE(PG8_SA(1, 1), a1 + hstep, voffA);
            PG8_WAIT_L(8); PG8_BAR; PG8_WAIT_L(0); PG8_MMA(0, 0, At, B0); PG8_BAR; PG8_SCHED;
            PG8_LDB(B1, 0, 1); PG8_STAGE(PG8_SB(0, 0), b2, voffB);
            PG8_BAR; PG8_WAIT_L(0); PG8_MMA(0, 1, At, B1); PG8_BAR;
            PG8_LDA(At, 0, 1); PG8_STAGE(PG8_SA(0, 0), a2, voffA);
            PG8_BAR; PG8_WAIT_L(0); PG8_MMA(1, 0, At, B0); PG8_BAR; PG8_SCHED;
            PG8_STAGE(PG8_SB(0, 1), b2 + hstep, voffB);
            PG8_WAIT_V(6); PG8_BAR; PG8_MMA(1, 1, At, B1); PG8_BAR;
            PG8_LDB(B0, 1, 0); PG8_SCHED; PG8_LDA(At, 1, 0); PG8_STAGE(PG8_SA(0, 1), a2 + hstep, voffA);
            PG8_WAIT_L(8); PG8_BAR; PG8_WAIT_L(0); PG8_MMA(0, 0, At, B0); PG8_BAR; PG8_SCHED;
            PG8_LDB(B1, 1, 1); PG8_STAGE(PG8_SB(1, 0), b3, voffB);
            PG8_BAR; PG8_WAIT_L(0); PG8_MMA(0, 1, At, B1); PG8_BAR;
            PG8_LDA(At, 1, 1); PG8_STAGE(PG8_SA(1, 0), a3, voffA);
            PG8_BAR; PG8_WAIT_L(0); PG8_MMA(1, 0, At, B0); PG8_BAR; PG8_SCHED;
            PG8_STAGE(PG8_SB(1, 1), b3 + hstep, voffB);
            PG8_WAIT_V(6); PG8_BAR; PG8_MMA(1, 1, At, B1); PG8_BAR;
            }
        }
        if constexpr (ALIGN_EPI) { if (wr == 0) PG8_BAR; }
        if constexpr (!Epi::AFTER_DRAIN) { E(acc, cur, wr, wc, fr, fq); S.done(cur); }
        if (!has_next) break;
#pragma unroll
        for (int a = 0; a < 2; ++a)
#pragma unroll
            for (int b = 0; b < 2; ++b)
#pragma unroll
                for (int m = 0; m < 4; ++m)
#pragma unroll
                    for (int n = 0; n < 2; ++n) acc[a][b][m][n] = (f32x4){0.f, 0.f, 0.f, 0.f};
        cur = nxt; cA = nA; cB = nB; ++ui;
        if constexpr (ALIGN_EPI) { if (wr == 1) PG8_BAR; }
    }
    PG8_WAIT_V(0);
    if constexpr (!ALIGN_EPI) { if (wr == 0) PG8_BAR; }
    PG8_BAR;
    if constexpr (Epi::AFTER_DRAIN) { E.fused(acc, cur, wr, wc, fr, fq, lds, wid, lane); S.done(cur); }
#undef PG8_SA
#undef PG8_SB
#undef PG8_STAGE
#undef PG8_LDA
#undef PG8_LDB
#undef PG8_MMA
#undef PG8_WAIT_V
#undef PG8_WAIT_L
#undef PG8_BAR
#undef PG8_SCHED
}
}
namespace att {
typedef unsigned short bf16_t;
typedef short bf16x8 __attribute__((ext_vector_type(8)));
typedef short s16x4 __attribute__((ext_vector_type(4)));
typedef float f32x16 __attribute__((ext_vector_type(16)));
typedef float f32x4 __attribute__((ext_vector_type(4)));
typedef unsigned u32x4 __attribute__((ext_vector_type(4)));
#define ALDS __attribute__((address_space(3)))
typedef ALDS const char* lds_cptr;
typedef ALDS char* lds_ptr;
typedef short v4i16_t __attribute__((ext_vector_type(4)));
constexpr int SEQ = 2048, DM = 1024, SLOTB = 8192;
constexpr float LOG2E = 1.4426950408889634f;
__device__ __forceinline__ int crow(int r, int hi) { return (r & 3) + 8 * (r >> 2) + 4 * hi; }
#define ATT_SBAR() __builtin_amdgcn_sched_barrier(0)
#define ATT_WAIT_BAR(N) asm volatile("s_waitcnt vmcnt(" #N ") lgkmcnt(0)\n\ts_barrier" ::: "memory")
#define ATT_LGKM_BAR() asm volatile("s_waitcnt lgkmcnt(0)\n\ts_barrier" ::: "memory")
__device__ __forceinline__ void glds16(const void* gsrc, unsigned lds_dst) { unsigned keep;
    asm volatile("s_mov_b32 %0, m0\n\ts_mov_b32 m0, %2\n\ts_nop 0\n\tglobal_load_lds_dwordx4 %1, off\n\ts_mov_b32 m0, %0" : "=&s"(keep) : "v"(gsrc), "s"(lds_dst) : "memory"); }
typedef float f32x2_t __attribute__((ext_vector_type(2))); typedef __bf16 bf16x2_t __attribute__((ext_vector_type(2)));
__device__ __forceinline__ unsigned cvtpk_s(float lo, float hi) { f32x2_t v = {lo, hi}; bf16x2_t b = __builtin_convertvector(v, bf16x2_t); return __builtin_bit_cast(unsigned, b); }

__device__ __forceinline__ void qkt2(f32x16& p0, f32x16& p1, lds_cptr kp, const bf16x8* qr, const f32x16& c0, const f32x16& c1) {
#pragma unroll
    for (int d0 = 0; d0 < 4; ++d0) {
        const bf16x8 b0 = *(const ALDS bf16x8*)(kp + d0 * 2048);
        const bf16x8 b1 = *(const ALDS bf16x8*)(kp + d0 * 2048 + 512);
        if (d0 == 0) { p0 = __builtin_amdgcn_mfma_f32_32x32x16_bf16(b0, qr[0], c0, 0, 0, 0); p1 = __builtin_amdgcn_mfma_f32_32x32x16_bf16(b1, qr[0], c1, 0, 0, 0); }
        else { p0 = __builtin_amdgcn_mfma_f32_32x32x16_bf16(b0, qr[d0], p0, 0, 0, 0); p1 = __builtin_amdgcn_mfma_f32_32x32x16_bf16(b1, qr[d0], p1, 0, 0, 0); }
    }
}
__device__ __forceinline__ void pv(f32x16* o, int vb, bf16x8 pa0, bf16x8 pa1, bf16x8 pa2, bf16x8 pa3) {
#pragma unroll
    for (int d0 = 0; d0 < 2; ++d0) { s16x4 lo[4], hi[4];
#pragma unroll
        for (int ks = 0; ks < 4; ++ks) {
            asm volatile("ds_read_b64_tr_b16 %0,%1 offset:%c2" : "=&v"(lo[ks]) : "v"(vb), "i"(d0 * 4096 + ks * 1024) : "memory");
            asm volatile("ds_read_b64_tr_b16 %0,%1 offset:%c2" : "=&v"(hi[ks]) : "v"(vb), "i"(d0 * 4096 + ks * 1024 + 512) : "memory"); }
        asm volatile("s_waitcnt lgkmcnt(0)" ::: "memory"); ATT_SBAR();
#define ATT_PK(k) (bf16x8){lo[k][0], lo[k][1], lo[k][2], lo[k][3], hi[k][0], hi[k][1], hi[k][2], hi[k][3]}
        o[d0] = __builtin_amdgcn_mfma_f32_32x32x16_bf16(pa0, ATT_PK(0), o[d0], 0, 0, 0);
        o[d0] = __builtin_amdgcn_mfma_f32_32x32x16_bf16(pa1, ATT_PK(1), o[d0], 0, 0, 0);
        o[d0] = __builtin_amdgcn_mfma_f32_32x32x16_bf16(pa2, ATT_PK(2), o[d0], 0, 0, 0);
        o[d0] = __builtin_amdgcn_mfma_f32_32x32x16_bf16(pa3, ATT_PK(3), o[d0], 0, 0, 0);
#undef ATT_PK
    }
}
__device__ __forceinline__ void tile_body(f32x16* o, float& l, lds_cptr kp, int vb, const bf16x8* qr, const f32x16& c0, const f32x16& c1) {
    f32x16 p0, p1; qkt2(p0, p1, kp, qr, c0, c1);
#pragma unroll
    for (int r = 0; r < 16; ++r) { p0[r] = __builtin_amdgcn_exp2f(p0[r]); p1[r] = __builtin_amdgcn_exp2f(p1[r]); }
    float s0 = 0.f, s1 = 0.f;
#pragma unroll
    for (int r = 0; r < 16; ++r) { s0 += p0[r]; s1 += p1[r]; }
    l += s0 + s1;
    u32x4 pw0, pw1, pw2, pw3;
    pw0 = (u32x4){cvtpk_s(p0[0], p0[1]), cvtpk_s(p0[2], p0[3]), cvtpk_s(p0[4], p0[5]), cvtpk_s(p0[6], p0[7])};
    pw1 = (u32x4){cvtpk_s(p0[8], p0[9]), cvtpk_s(p0[10], p0[11]), cvtpk_s(p0[12], p0[13]), cvtpk_s(p0[14], p0[15])};
    pw2 = (u32x4){cvtpk_s(p1[0], p1[1]), cvtpk_s(p1[2], p1[3]), cvtpk_s(p1[4], p1[5]), cvtpk_s(p1[6], p1[7])};
    pw3 = (u32x4){cvtpk_s(p1[8], p1[9]), cvtpk_s(p1[10], p1[11]), cvtpk_s(p1[12], p1[13]), cvtpk_s(p1[14], p1[15])};
    pv(o, vb, __builtin_bit_cast(bf16x8, pw0), __builtin_bit_cast(bf16x8, pw1), __builtin_bit_cast(bf16x8, pw2), __builtin_bit_cast(bf16x8, pw3));
}
__device__ __forceinline__ void store_o(const f32x16* o, float l, ALDS float* wsf, ALDS bf16_t* stg, bf16_t* Ow, int lane, int r32, int hi) {
    { auto rr = __builtin_amdgcn_permlane32_swap(__float_as_uint(l), __float_as_uint(l), false, false); l = __uint_as_float(rr[0]) + __uint_as_float(rr[1]); }
    if (hi == 0) wsf[32 + r32] = l;
    asm volatile("s_waitcnt lgkmcnt(0)" ::: "memory");
    float rli[16];
#pragma unroll
    for (int r = 0; r < 16; ++r) rli[r] = __builtin_amdgcn_rcpf(wsf[32 + crow(r, hi)]);
#pragma unroll
    for (int r = 0; r < 16; ++r) { const int orow = crow(r, hi);
#pragma unroll
        for (int d0 = 0; d0 < 2; ++d0) { const float v = o[d0][r] * rli[r]; stg[orow * 64 + d0 * 32 + r32] = (bf16_t)(cvtpk_s(v, v) & 0xffffu); } }
    asm volatile("s_waitcnt lgkmcnt(0)" ::: "memory");
#pragma unroll
    for (int i = 0; i < 4; ++i) { const int row = i * 8 + (lane >> 3), ch = lane & 7; const u32x4 v = *(const ALDS u32x4*)(stg + row * 64 + ch * 8); *(u32x4*)(Ow + (long)row * DM + ch * 8) = v; }
    asm volatile("s_waitcnt lgkmcnt(0)" ::: "memory");
}

__device__ __forceinline__ void store_o2(const f32x16* o, const f32x16& lsum, ALDS bf16_t* stg, bf16_t* Ow, int lane, int r32, int hi) {
#pragma unroll
    for (int r = 0; r < 16; ++r) { const int orow = crow(r, hi); const float rl = __builtin_amdgcn_rcpf(lsum[r]);
#pragma unroll
        for (int d0 = 0; d0 < 2; ++d0) { const float v = o[d0][r] * rl; stg[orow * 64 + d0 * 32 + r32] = (bf16_t)(cvtpk_s(v, v) & 0xffffu); } }
    asm volatile("s_waitcnt lgkmcnt(0)" ::: "memory");
#pragma unroll
    for (int i = 0; i < 4; ++i) { const int row = i * 8 + (lane >> 3), ch = lane & 7; const u32x4 v = *(const ALDS u32x4*)(stg + row * 64 + ch * 8); *(u32x4*)(Ow + (long)row * DM + ch * 8) = v; }
    asm volatile("s_waitcnt lgkmcnt(0)" ::: "memory");
}

constexpr int FX_K = 0, FX_V = 3 * SLOTB, FX_WS = 6 * SLOTB, FX_OST = FX_WS + 2048, FX_C2 = FX_OST + 8 * 4096, FX_WT = FX_C2 + SEQ * 4, FX_KA = FX_WT + 64, FX_Z = FX_KA + SEQ * 16, FX_END = FX_Z + 64;
__device__ __forceinline__ void kload8(bf16x8* kf, lds_cptr kp) {
    kf[0] = *(const ALDS bf16x8*)(kp);        kf[1] = *(const ALDS bf16x8*)(kp + 512);
    kf[2] = *(const ALDS bf16x8*)(kp + 2048); kf[3] = *(const ALDS bf16x8*)(kp + 2560);
    kf[4] = *(const ALDS bf16x8*)(kp + 4096); kf[5] = *(const ALDS bf16x8*)(kp + 4608);
    kf[6] = *(const ALDS bf16x8*)(kp + 6144); kf[7] = *(const ALDS bf16x8*)(kp + 6656);
}
__device__ __forceinline__ void kload2(bf16x8* kf, lds_cptr kp, int j) { kf[2 * j] = *(const ALDS bf16x8*)(kp + j * 2048); kf[2 * j + 1] = *(const ALDS bf16x8*)(kp + j * 2048 + 512); }
__device__ __forceinline__ s16x4 vtr(lds_cptr p) { return __builtin_bit_cast(s16x4, __builtin_amdgcn_ds_read_tr16_b64_v4i16((ALDS v4i16_t*)p)); }
__device__ __forceinline__ void fox_prepare(int b, int h, const float* logf2, lds_ptr shm) {
    int tid = threadIdx.x; asm volatile("" : "+v"(tid));
    const int lane = tid & 63; const int wid = __builtin_amdgcn_readfirstlane(tid >> 6);
    ALDS float* c2s = (ALDS float*)(shm + FX_C2); ALDS float* wtot = (ALDS float*)(shm + FX_WT);
    const float* lf = logf2 + (size_t)(b * 16 + h) * SEQ;
    const f32x4 v = *(const f32x4*)(lf + 4 * tid);
    const float a0 = v[0], a1 = a0 + v[1], a2 = a1 + v[2], a3 = a2 + v[3];
    float x = a3;
#pragma unroll
    for (int ofs = 1; ofs < 64; ofs <<= 1) { const int src = lane >= ofs ? lane - ofs : lane; const float y = __uint_as_float(__builtin_amdgcn_ds_bpermute(src << 2, __float_as_uint(x))); if (lane >= ofs) x += y; }
    if (lane == 63) wtot[wid] = x;
    ATT_WAIT_BAR(0);
    float off = 0.f;
#pragma unroll
    for (int w = 0; w < 8; ++w) { const float tw = wtot[w]; if (w < wid) off += tw; }
    const float ex = off + x - a3;
    *(ALDS f32x4*)(c2s + 4 * tid) = (f32x4){ex + a0, ex + a1, ex + a2, ex + a3};
    { const float cc[4] = {ex + a0, ex + a1, ex + a2, ex + a3};
#pragma unroll
      for (int j = 0; j < 4; ++j) { const float v0 = -cc[j];
          const unsigned h1 = cvtpk_s(v0, 0.f) & 0xffffu; const float r1 = v0 - __uint_as_float(h1 << 16);
          const unsigned h2 = cvtpk_s(r1, 0.f) & 0xffffu; const float r2 = r1 - __uint_as_float(h2 << 16);
          const unsigned h3 = cvtpk_s(r2, 0.f) & 0xffffu;
          *(ALDS u32x4*)(shm + FX_KA + (4 * tid + j) * 16) = (u32x4){h1 | (h2 << 16), h3 | 0x3F800000u, 0x3F803F80u, 0u}; }
      if (tid < 4) *(ALDS unsigned*)(shm + FX_Z + 4 * tid) = 0u; }
    ATT_WAIT_BAR(0);
}
constexpr long PNL = 1048576, SLT = 262144;
__device__ __forceinline__ void fox_cu(int h, int sel, bf16_t* PB, lds_ptr shm, float nB2) {
#define QBOF(i) (sel == 0 ? ((i) == 0 ? 7 : (i) == 1 ? 4 : (i) == 2 ? 3 : 0) : ((i) == 0 ? 6 : (i) == 1 ? 5 : (i) == 2 ? 2 : 1))
#define SLOT(t) ((((s0) + (t)) % 3) * SLOTB)
#define LOADQ(dst, qb_) do { const bf16_t* Qw_ = PB + (qb_) * PNL + (long)(wid * 32) * DM + h * 64; _Pragma("unroll") for (int d0 = 0; d0 < 4; ++d0) dst[d0] = *(const bf16x8*)(Qw_ + (long)r32 * DM + d0 * 16 + hi * 8); } while (0)
    int s0 = 0;
    bf16x8 qr[4];
    for (int ui = 0; ui < 4; ++ui) {
    int tid = threadIdx.x; asm volatile("" : "+v"(tid));
    const int lane = tid & 63, r32 = lane & 31, hi = lane >> 5; const int wid = __builtin_amdgcn_readfirstlane(tid >> 6);
    const bf16_t* Kh = PB + SLT + h * 64; const bf16_t* Vh = PB + 2 * SLT + h * 64;
    const unsigned lds0 = (unsigned)(uintptr_t)shm;
    ALDS float* wsf = (ALDS float*)(shm + FX_WS) + wid * 64;
    const ALDS float* c2s = (const ALDS float*)(shm + FX_C2);
    const bf16_t* ksrc = Kh + (long)lane * DM + wid * 8;
    const bf16_t* vsrc = Vh + (long)(16 * (wid & 3) + (lane >> 2)) * DM + (wid >> 2) * 32 + (lane & 3) * 8;
    const unsigned kdst = lds0 + FX_K + wid * 1024, vdst = lds0 + FX_V + wid * 1024;
#define TOFF(t) ((long)((t) >> 2) * PNL + (long)((t) & 3) * 64 * DM)
#define DMA_K(t, slot) glds16(ksrc + TOFF(t), (unsigned)__builtin_amdgcn_readfirstlane(kdst + (slot)))
#define DMA_V(t, slot) glds16(vsrc + TOFF(t), (unsigned)__builtin_amdgcn_readfirstlane(vdst + (slot)))
    const int vb0 = (int)(lds0 + FX_V) + ((lane >> 4) & 1) * 32 + (lane & 3) * 8 + (4 * hi + ((lane & 15) >> 2)) * 64;
    const lds_cptr shm3 = (lds_cptr)shm; const lds_cptr kp0 = shm3 + FX_K + hi * 1024 + r32 * 16; const lds_cptr vp0 = shm3 + FX_V + ((lane >> 4) & 1) * 32 + (lane & 3) * 8 + (4 * hi + ((lane & 15) >> 2)) * 64;
    bf16x8 kf[8], kaf[2];
    const lds_cptr kab = hi ? shm3 + FX_Z : shm3 + FX_KA + r32 * 16; const int kats = hi ? 0 : 1024, kah = hi ? 0 : 512;
#define KALD(t) do { kaf[0] = *(const ALDS bf16x8*)(kab + (t) * kats); kaf[1] = *(const ALDS bf16x8*)(kab + (t) * kats + kah); } while (0)
    if (ui == 0) { DMA_K(0, SLOT(0)); DMA_V(0, SLOT(0)); DMA_K(1, SLOT(1)); LOADQ(qr, QBOF(0)); DMA_K(2, SLOT(2)); }
    const int qb = QBOF(ui), q0 = qb * 256;
    const int NT = (q0 + 256) / 64;
    f32x16 lacc, o[2];
    bf16x8 ones; { _Pragma("unroll") for (int j = 0; j < 8; ++j) ones[j] = (short)0x3F80; } asm volatile("" : "+v"(ones));
#pragma unroll
    for (int r = 0; r < 16; ++r) { o[0][r] = 0.f; o[1][r] = 0.f; lacc[r] = 0.f; }
    const int qrel = wid * 32 + r32;
    bf16x8 qaug;
    { const float cq = c2s[q0 + qrel] + nB2;
      const unsigned g1 = cvtpk_s(cq, 0.f) & 0xffffu; const float r1 = cq - __uint_as_float(g1 << 16);
      const unsigned g2 = cvtpk_s(r1, 0.f) & 0xffffu; const float r2 = r1 - __uint_as_float(g2 << 16);
      const unsigned g3 = cvtpk_s(r2, 0.f) & 0xffffu;
      qaug = __builtin_bit_cast(bf16x8, (u32x4){0x3F803F80u, 0x3F80u | (g1 << 16), g2 | (g3 << 16), 0u}); }
    const f32x16 zero16 = (f32x16){0.f, 0.f, 0.f, 0.f, 0.f, 0.f, 0.f, 0.f, 0.f, 0.f, 0.f, 0.f, 0.f, 0.f, 0.f, 0.f};
#define THR(t) ((t) >= NT - 4 ? qrel - 4 * hi - 64 * ((t) - (NT - 4)) : 4096)
#define CMASK4(X, B, G, thr_) do { float tf_ = (float)((thr_) + 1); asm volatile("" : "+v"(tf_));   \
      _Pragma("unroll") for (int e = 0; e < 4; ++e) X[(B) + e] *= __builtin_fminf(__builtin_fmaxf(tf_ - (float)(8 * ((G) & 3) + 32 * ((G) >> 2) + e), 0.f), 1.f); } while (0)
    f32x16 pA0, pA1, pB0, pB1;
    int sl_prev = SLOT(0), sl_cur = SLOT(0), sl_next = SLOT(1);
#define ROT() do { sl_prev = sl_cur; sl_cur = sl_next; sl_next = (sl_next == 2 * SLOTB) ? 0 : sl_next + SLOTB; } while (0)
    ATT_WAIT_BAR(3);
    KALD(0);
    { const f32x16 d0_ = __builtin_amdgcn_mfma_f32_32x32x16_bf16(kaf[0], qaug, zero16, 0, 0, 0), d1_ = __builtin_amdgcn_mfma_f32_32x32x16_bf16(kaf[1], qaug, zero16, 0, 0, 0); qkt2(pA0, pA1, kp0 + SLOT(0), qr, d0_, d1_); }
#pragma unroll
    for (int r = 0; r < 16; ++r) { pA0[r] = __builtin_amdgcn_exp2f(pA0[r]); pA1[r] = __builtin_amdgcn_exp2f(pA1[r]); }
    { const int thr0 = THR(0);
#pragma unroll
      for (int g = 0; g < 4; ++g) { CMASK4(pA0, 4 * g, g, thr0); CMASK4(pA1, 4 * g, 4 + g, thr0); } }
    ATT_WAIT_BAR(0);
    DMA_K(3, SLOT(0)); DMA_V(1, SLOT(1));
    ROT();
    kload8(kf, kp0 + sl_cur); KALD(1);
    ATT_WAIT_BAR(2);
    s16x4 vlo[8], vhi[8]; u32x4 pw0, pw1, pw2, pw3;
#define PKW(P, B) cvtpk_s(P[B], P[B + 1])
#define PAF(k) __builtin_bit_cast(bf16x8, pw##k)
#define VFR(i) (bf16x8){vlo[i][0], vlo[i][1], vlo[i][2], vlo[i][3], vhi[i][0], vhi[i][1], vhi[i][2], vhi[i][3]}
#define PIN(x) asm volatile("" : "+v"(x))
#define MFMA32(a, b, c) __builtin_amdgcn_mfma_f32_32x32x16_bf16(a, b, c, 0, 0, 0)
#define GAPA(MF, A0, A1, A2, A3, W0, W1, PW) do { MF; W0; W1; PIN(PW); ATT_SBAR(); } while (0)
#define EX(v) __builtin_amdgcn_exp2f(v)
#define GAPB(MF, X, B, BAND, G) do { MF; X[B] = EX(X[B]); X[B + 1] = EX(X[B + 1]); X[B + 2] = EX(X[B + 2]); X[B + 3] = EX(X[B + 3]); if (BAND) CMASK4(X, B, G, thr_); PIN(X); ATT_SBAR(); } while (0)
#define VRD(i) do { vlo[i] = vtr(vp_ + (((i) >> 2) * 4096 + ((i) & 3) * 1024)); vhi[i] = vtr(vp_ + (((i) >> 2) * 4096 + ((i) & 3) * 1024 + 512)); } while (0)
#define KRD(G, j) do { if (G) { kload2(kf, kp0 + sl_next, j); ATT_SBAR(); } } while (0)
#define STEP(C0, C1, P0, P1, t, GK, GV, GL, BAND) do { ATT_SBAR(); \
    const lds_cptr vp_ = vp0 + sl_prev; \
    C0 = MFMA32(kaf[0], qaug, zero16); C1 = MFMA32(kaf[1], qaug, zero16); \
    VRD(0); ATT_SBAR(); \
    GAPA(C0 = MFMA32(kf[0], qr[0], C0), P0[2], P0[3], P0[4], P0[5],     pw0[0] = PKW(P0, 0), pw0[1] = PKW(P0, 2), pw0); \
    VRD(4); ATT_SBAR(); GAPA(C1 = MFMA32(kf[1], qr[0], C1), P0[6], P0[7], P0[8], P0[9],     pw0[2] = PKW(P0, 4), pw0[3] = PKW(P0, 6), pw0); \
    VRD(1); ATT_SBAR(); GAPA(C0 = MFMA32(kf[2], qr[1], C0),  P0[10], P0[11], P0[12], P0[13], pw1[0] = PKW(P0, 8), pw1[1] = PKW(P0, 10), pw1); \
    VRD(5); ATT_SBAR(); GAPA(C1 = MFMA32(kf[3], qr[1], C1),  P0[14], P0[15], P1[0], P1[1],   pw1[2] = PKW(P0, 12), pw1[3] = PKW(P0, 14), pw1); \
    VRD(2); ATT_SBAR(); GAPA(C0 = MFMA32(kf[4], qr[2], C0),  P1[2], P1[3], P1[4], P1[5],     pw2[0] = PKW(P1, 0), pw2[1] = PKW(P1, 2), pw2); \
    VRD(6); ATT_SBAR(); GAPA(C1 = MFMA32(kf[5], qr[2], C1),  P1[6], P1[7], P1[8], P1[9],     pw2[2] = PKW(P1, 4), pw2[3] = PKW(P1, 6), pw2); \
    VRD(3); ATT_SBAR(); GAPA(C0 = MFMA32(kf[6], qr[3], C0),  P1[10], P1[11], P1[12], P1[13], pw3[0] = PKW(P1, 8), pw3[1] = PKW(P1, 10), pw3); \
    VRD(7); ATT_SBAR(); GAPA(C1 = MFMA32(kf[7], qr[3], C1),  P1[14], P1[15], 0.f, 0.f,       pw3[2] = PKW(P1, 12), pw3[3] = PKW(P1, 14), pw3); \
    if (GK) { DMA_K((t) + 3, sl_cur); } if (GV) { DMA_V((t) + 1, sl_next); } \
    const int thr_ = (BAND) ? THR(t) : 0; \
    ATT_SBAR(); \
    GAPB(o[0] = MFMA32(PAF(0), VFR(0), o[0]), C0, 0, BAND, 0); \
    GAPB(o[1] = MFMA32(PAF(0), VFR(4), o[1]); lacc = MFMA32(PAF(0), ones, lacc), C0, 4, BAND, 1); \
    KRD(GL, 0); GAPB(o[0] = MFMA32(PAF(1), VFR(1), o[0]), C0, 8, BAND, 2); \
    KRD(GL, 1); GAPB(o[1] = MFMA32(PAF(1), VFR(5), o[1]); lacc = MFMA32(PAF(1), ones, lacc), C0, 12, BAND, 3); \
    KRD(GL, 2); GAPB(o[0] = MFMA32(PAF(2), VFR(2), o[0]), C1, 0, BAND, 4); \
    KRD(GL, 3); GAPB(o[1] = MFMA32(PAF(2), VFR(6), o[1]); lacc = MFMA32(PAF(2), ones, lacc), C1, 4, BAND, 5); \
    if (GL) { KALD((t) + 1); ATT_SBAR(); } GAPB(o[0] = MFMA32(PAF(3), VFR(3), o[0]), C1, 8, BAND, 6); \
    GAPB(o[1] = MFMA32(PAF(3), VFR(7), o[1]); lacc = MFMA32(PAF(3), ones, lacc), C1, 12, BAND, 7); \
    } while (0)
    int t = 1;
    for (; t + 5 < NT; t += 2) {
        STEP(pB0, pB1, pA0, pA1, t, true, true, true, false);     ATT_WAIT_BAR(2); ROT();
        STEP(pA0, pA1, pB0, pB1, t + 1, true, true, true, false); ATT_WAIT_BAR(2); ROT();
    }
#define ENDW(tt) do { if ((tt) + 3 < NT) { ATT_WAIT_BAR(2); } else if ((tt) + 2 < NT) { ATT_WAIT_BAR(1); } else { ATT_WAIT_BAR(0); } } while (0)
    for (; t + 1 < NT; t += 2) {
        STEP(pB0, pB1, pA0, pA1, t, (t + 3 < NT), (t + 1 < NT), (t + 1 < NT), true);         ENDW(t);     ROT();
        STEP(pA0, pA1, pB0, pB1, t + 1, (t + 4 < NT), (t + 2 < NT), (t + 2 < NT), true);     ENDW(t + 1); ROT();
    }
    STEP(pB0, pB1, pA0, pA1, NT - 1, false, false, false, true);
    bf16x8 qn[4];
    const int s0n = (s0 + NT) % 3;
    if (ui < 3) { const int s0k = s0; s0 = s0n; DMA_K(0, SLOT(0)); DMA_V(0, SLOT(0)); DMA_K(1, SLOT(1)); LOADQ(qn, QBOF(ui + 1)); DMA_K(2, SLOT(2)); s0 = s0k; }
    {
      pw0 = (u32x4){PKW(pB0, 0), PKW(pB0, 2), PKW(pB0, 4), PKW(pB0, 6)}; pw1 = (u32x4){PKW(pB0, 8), PKW(pB0, 10), PKW(pB0, 12), PKW(pB0, 14)};
      pw2 = (u32x4){PKW(pB1, 0), PKW(pB1, 2), PKW(pB1, 4), PKW(pB1, 6)}; pw3 = (u32x4){PKW(pB1, 8), PKW(pB1, 10), PKW(pB1, 12), PKW(pB1, 14)};
      ATT_SBAR(); pv(o, vb0 + sl_cur, PAF(0), PAF(1), PAF(2), PAF(3));
      lacc = MFMA32(PAF(0), ones, lacc); lacc = MFMA32(PAF(1), ones, lacc); lacc = MFMA32(PAF(2), ones, lacc); lacc = MFMA32(PAF(3), ones, lacc); }
    store_o2(o, lacc, (ALDS bf16_t*)(shm + FX_OST) + wid * 2048, PB + qb * PNL + 3 * SLT + (long)(wid * 32) * DM + h * 64, lane, r32, hi);
    ATT_LGKM_BAR();
    if (ui < 3) {
#pragma unroll
        for (int d0 = 0; d0 < 4; ++d0) qr[d0] = qn[d0];
    }
    s0 = s0n;
    }
#undef QBOF
#undef SLOT
#undef LOADQ
#undef DMA_K
#undef DMA_V
#undef TOFF
#undef KALD
#undef THR
#undef CMASK4

#undef ROT
#undef PKW
#undef PAF
#undef VFR
#undef PIN
#undef MFMA32
#undef GAPA
#undef EX
#undef GAPB
#undef VRD
#undef KRD
#undef STEP
#undef ENDW
}

__device__ __forceinline__ int t5_bucket(int n) {
    if (n < 16) return n;
    int b = 16;
    b += (n >= 19); b += (n >= 21); b += (n >= 24); b += (n >= 27); b += (n >= 31); b += (n >= 35); b += (n >= 40); b += (n >= 46);
    b += (n >= 52); b += (n >= 59); b += (n >= 67); b += (n >= 77); b += (n >= 87); b += (n >= 99); b += (n >= 113);
    return b;
}
constexpr int SW_K = 0, SW_V = 4 * SLOTB, SW_WS = 8 * SLOTB, SW_OST = SW_WS + 2048, SW_TBL = SW_OST + 8 * 4096, SW_MB = SW_TBL + 8 * 384 * 4, SW_END = SW_MB + 64;
template <int R0 = 0, int R1 = 4>
__device__ __forceinline__ void swa_unit(int b, int kvh, int qblk, const bf16_t* Q, const bf16_t* KV, bf16_t* O, const float* sinks, const float* relb, lds_ptr shm, float qkb) {
    int tid = threadIdx.x; asm volatile("" : "+v"(tid));
    const int lane = tid & 63, r32 = lane & 31, hi = lane >> 5; const int wid = __builtin_amdgcn_readfirstlane(tid >> 6);
    const long rowbase = (long)b * SEQ; const int q0 = qblk * 128; const int jt0 = qblk == 0 ? 2 : 0;
    const unsigned lds0 = (unsigned)(uintptr_t)shm;
    const long band0 = rowbase + q0 - 128;
    {
        const long krow = band0 + lane, vrow = band0 + 16 * (wid & 3) + (lane >> 2);
        for (int jt = jt0; jt < 4; ++jt) {
            glds16(KV + (krow + 64 * jt) * 256 + kvh * 64 + wid * 8, (unsigned)__builtin_amdgcn_readfirstlane(lds0 + SW_K + jt * SLOTB + wid * 1024));
            glds16(KV + (vrow + 64 * jt) * 256 + 128 + kvh * 64 + (wid >> 2) * 32 + (lane & 3) * 8, (unsigned)__builtin_amdgcn_readfirstlane(lds0 + SW_V + jt * SLOTB + wid * 1024));
        }
    }
#define SW_LOADQ(dst, round_) do { const bf16_t* Qw_ = Q + (rowbase + q0 + 32 * (wid & 3)) * DM + (kvh * 8 + 2 * (round_) + (wid >> 2)) * 64; \
      _Pragma("unroll") for (int d0 = 0; d0 < 4; ++d0) dst[d0] = *(const bf16x8*)(Qw_ + (long)r32 * DM + d0 * 16 + hi * 8); } while (0)
    bf16x8 qc[4], qn[4];
    SW_LOADQ(qc, R0);
    ALDS float* tbl = (ALDS float*)(shm + SW_TBL); ALDS float* mb = (ALDS float*)(shm + SW_MB);
    if (tid < 8) { const int hh = kvh * 8 + tid; float m = relb[hh];
        for (int bk = 1; bk < 32; ++bk) m = fmaxf(m, relb[bk * 16 + hh]);
        mb[tid] = m * LOG2E; }
    ATT_LGKM_BAR();
    for (int idx = tid; idx < 8 * 384; idx += 512) { const int g = idx / 384, di = idx - g * 384, dist = di - 127;
        float v = -INFINITY; if (dist >= 0 && dist < 128) v = relb[t5_bucket(dist) * 16 + kvh * 8 + g] * LOG2E - (qkb + mb[g]);
        tbl[idx] = v; }
    ATT_WAIT_BAR(0);
    const int wq = wid & 3;
    ALDS float* wsf = (ALDS float*)(shm + SW_WS) + wid * 64;
    const lds_cptr kp0 = (lds_cptr)shm + SW_K + hi * 1024 + r32 * 16;
    const lds_cptr vp0 = (lds_cptr)shm + SW_V + ((lane >> 4) & 1) * 32 + (lane & 3) * 8 + (4 * hi + ((lane & 15) >> 2)) * 64;
    const int jbase = wq >> 1;
#define SW_SCORES(p0, p1, jt_) do { f32x16 c0_, c1_; const ALDS float* tj_ = tb - 64 * (jt_); \
        _Pragma("unroll") for (int r = 0; r < 16; ++r) { c0_[r] = tj_[-((r & 3) + 8 * (r >> 2))]; c1_[r] = tj_[-((r & 3) + 8 * (r >> 2)) - 32]; } \
        qkt2(p0, p1, kp0 + (jt_) * SLOTB, qc, c0_, c1_); } while (0)
#define SW_SOFT(p0, p1) do { \
        _Pragma("unroll") for (int r = 0; r < 16; ++r) { p0[r] = __builtin_amdgcn_exp2f(p0[r]); p1[r] = __builtin_amdgcn_exp2f(p1[r]); } \
        pw[0] = (u32x4){cvtpk_s(p0[0], p0[1]), cvtpk_s(p0[2], p0[3]), cvtpk_s(p0[4], p0[5]), cvtpk_s(p0[6], p0[7])}; \
        pw[1] = (u32x4){cvtpk_s(p0[8], p0[9]), cvtpk_s(p0[10], p0[11]), cvtpk_s(p0[12], p0[13]), cvtpk_s(p0[14], p0[15])}; \
        pw[2] = (u32x4){cvtpk_s(p1[0], p1[1]), cvtpk_s(p1[2], p1[3]), cvtpk_s(p1[4], p1[5]), cvtpk_s(p1[6], p1[7])}; \
        pw[3] = (u32x4){cvtpk_s(p1[8], p1[9]), cvtpk_s(p1[10], p1[11]), cvtpk_s(p1[12], p1[13]), cvtpk_s(p1[14], p1[15])}; } while (0)
#define SW_PV(jt_) do { const lds_cptr vp_ = vp0 + (jt_) * SLOTB; \
        _Pragma("unroll") for (int d0 = 0; d0 < 2; ++d0) { s16x4 vl[4], vh[4]; \
            _Pragma("unroll") for (int ks = 0; ks < 4; ++ks) { vl[ks] = vtr(vp_ + d0 * 4096 + ks * 1024); vh[ks] = vtr(vp_ + d0 * 4096 + ks * 1024 + 512); } \
            _Pragma("unroll") for (int ks = 0; ks < 4; ++ks) o[d0] = __builtin_amdgcn_mfma_f32_32x32x16_bf16(__builtin_bit_cast(bf16x8, pw[ks]), \
                (bf16x8){vl[ks][0], vl[ks][1], vl[ks][2], vl[ks][3], vh[ks][0], vh[ks][1], vh[ks][2], vh[ks][3]}, o[d0], 0, 0, 0); } \
        _Pragma("unroll") for (int ks = 0; ks < 4; ++ks) lacc = __builtin_amdgcn_mfma_f32_32x32x16_bf16(__builtin_bit_cast(bf16x8, pw[ks]), ones, lacc, 0, 0, 0);     \
        } while (0)
    bf16x8 ones; { _Pragma("unroll") for (int j = 0; j < 8; ++j) ones[j] = (short)0x3F80; } asm volatile("" : "+v"(ones));
#pragma unroll
    for (int round = R0; round < R1; ++round) {
        const int g = 2 * round + (wid >> 2), hh = kvh * 8 + g;
        if (round < R1 - 1) SW_LOADQ(qn, round + 1);
        const float B2 = qkb + mb[g];
        const float lsink = __builtin_amdgcn_exp2f(sinks[hh] * LOG2E - B2);
        f32x16 o[2], lacc;
#pragma unroll
        for (int r = 0; r < 16; ++r) { o[0][r] = 0.f; o[1][r] = 0.f; lacc[r] = lsink; }
        const ALDS float* tb = tbl + g * 384 + (255 + 32 * wq + r32 - 4 * hi);
        u32x4 pw[4];
        if (jt0 == 0) {
            f32x16 a0, a1, b0, b1;
            SW_SCORES(a0, a1, jbase); SW_SCORES(b0, b1, jbase + 1);
            SW_SOFT(a0, a1); SW_PV(jbase);
            SW_SCORES(a0, a1, jbase + 2);
            SW_SOFT(b0, b1); SW_PV(jbase + 1);
            SW_SOFT(a0, a1); SW_PV(jbase + 2);
        } else {
#pragma unroll
            for (int k = 0; k < 3; ++k) { const int jt = jbase + k;
                if (jt >= jt0) { f32x16 a0, a1; SW_SCORES(a0, a1, jt); SW_SOFT(a0, a1); SW_PV(jt); } }
        }
        store_o2(o, lacc, (ALDS bf16_t*)(shm + SW_OST) + wid * 2048, O + (rowbase + q0 + 32 * wq) * DM + hh * 64, lane, r32, hi);
        if (round < R1 - 1) {
#pragma unroll
            for (int d0 = 0; d0 < 4; ++d0) qc[d0] = qn[d0];
        }
    }
#undef SW_SCORES
#undef SW_SOFT
#undef SW_PV
#undef SW_LOADQ
    ATT_LGKM_BAR();
}
#undef ALDS
}
#define GAS __attribute__((address_space(1)))
#define LAS __attribute__((address_space(3)))
typedef unsigned short bf16;
typedef unsigned v4u __attribute__((ext_vector_type(4)));
typedef float f32x4 __attribute__((ext_vector_type(4)));
typedef short bf16x8 __attribute__((ext_vector_type(8)));
typedef GAS unsigned gu32;
typedef GAS unsigned long long gu64;
#define RLX_AGENT __ATOMIC_RELAXED, __HIP_MEMORY_SCOPE_AGENT
#define LDS_WAIT() asm volatile("s_waitcnt lgkmcnt(0)" ::: "memory")
#define VM_WAIT() asm volatile("s_waitcnt vmcnt(0)" ::: "memory")
__device__ __forceinline__ unsigned long long rt() { return __builtin_amdgcn_s_memrealtime(); }
__device__ __forceinline__ unsigned f2bf(float f) { unsigned u = __builtin_bit_cast(unsigned, f); return (u + 0x7fffu + ((u >> 16) & 1u)) >> 16; }
__device__ __forceinline__ unsigned pk2(float lo, float hi) { return f2bf(lo) | (f2bf(hi) << 16); }

#define XB_TMO      128
#define XB_XCNT(j)  (256  + 64 * (j))
#define XB_XSUB(j)  (1280 + 64 * (j))
#define XB_XGEN(j)  (2304 + 64 * (j))
#define XB_TOP      3328
#define XB_TOPGEN   3392
#define XCD_BAR_WORDS 3456
#define XB_SPIN_CAP (1u << 18)

__device__ __forceinline__ unsigned xb_ld(unsigned* p)              { return __hip_atomic_load(p, __ATOMIC_RELAXED, __HIP_MEMORY_SCOPE_AGENT); }
__device__ __forceinline__ unsigned xb_add(unsigned* p, unsigned v) { return __hip_atomic_fetch_add(p, v, __ATOMIC_RELAXED, __HIP_MEMORY_SCOPE_AGENT); }
__device__ __forceinline__ unsigned xb_xcc_id() { return (unsigned)__builtin_amdgcn_s_getreg((3 << 11) | 20) & 0xFu; }
#define XB_SPIN(cond, bar) do { unsigned _sp = 0; while (cond) { __builtin_amdgcn_s_sleep(1); \
    if ((++_sp & 255u) == 0u) { if (xb_ld(&(bar)[XB_TMO])) break; if (_sp > XB_SPIN_CAP) { atomicAdd(&(bar)[XB_TMO], 1u); break; } } } } while (0)

struct XcdBarrier {
    unsigned* bar; unsigned x; unsigned G; bool nowb;
    volatile LAS unsigned* st;
};

__device__ __forceinline__ XcdBarrier xcd_barrier_post(unsigned* bar, volatile LAS unsigned* st, unsigned G) {
    XcdBarrier b; b.bar = bar; b.x = xb_xcc_id(); b.st = st; b.G = G; b.nowb = false;
    if (threadIdx.x == 0) (void)xb_add(&bar[XB_XCNT(b.x)], 1u);
    return b;
}
__device__ __forceinline__ void xcd_barrier_complete(unsigned* bar, unsigned x, unsigned G, unsigned& nloc, unsigned& nx) {
    unsigned sum, cnt, mine, sp = 0u;
    for (;;) {
        sum = 0u; cnt = 0u; mine = 0u;
#pragma unroll
        for (unsigned j = 0; j < 16; ++j) { const unsigned c = xb_ld(&bar[XB_XCNT(j)]); sum += c; cnt += (c > 0u) ? 1u : 0u; mine = (j == x) ? c : mine; }
        if (sum == G) break;
        __builtin_amdgcn_s_sleep(1);
        if ((++sp & 255u) == 0u) { if (xb_ld(&bar[XB_TMO])) break; if (sp > XB_SPIN_CAP) { atomicAdd(&bar[XB_TMO], 1u); break; } }
    }
    nloc = mine > 0u ? mine : 1u; nx = cnt > 0u ? cnt : 1u;
}

__device__ __forceinline__ void xcd_barrier(const XcdBarrier& b) {
    asm volatile("s_waitcnt vmcnt(0)" ::: "memory");
    __syncthreads();
    if (threadIdx.x == 0) {
        unsigned* bar = b.bar;
        __builtin_amdgcn_s_waitcnt(0);
        unsigned nloc = b.st[0], nx = b.st[1];
        if (nloc == 0u) { xcd_barrier_complete(bar, b.x, b.G, nloc, nx); b.st[0] = nloc; b.st[1] = nx; }
        const unsigned old = xb_add(&bar[XB_XSUB(b.x)], 1u);
        const unsigned gen = old / nloc;
        if (nx == 1u && b.G <= 32u) {
            const unsigned target = (gen + 1u) * nloc;
            XB_SPIN(xb_ld(&bar[XB_XSUB(b.x)]) < target, bar);
            __builtin_amdgcn_fence(__ATOMIC_ACQUIRE, "agent");
            asm volatile("s_waitcnt vmcnt(0)" ::: "memory");
        } else
        if (old + 1u == (gen + 1u) * nloc) {
            if ((nx > 1u || b.G > 32u) && !b.nowb) {
            __builtin_amdgcn_fence(__ATOMIC_RELEASE, "agent");
            asm volatile("s_waitcnt vmcnt(0)" ::: "memory");
            }
            const unsigned og = xb_add(&bar[XB_TOP], 1u);
            const unsigned tg = og / nx;
            if (og + 1u == (tg + 1u) * nx) xb_add(&bar[XB_TOPGEN], 1u);
            else XB_SPIN(xb_ld(&bar[XB_TOPGEN]) == tg, bar);
            __builtin_amdgcn_fence(__ATOMIC_ACQUIRE, "agent");
            xb_add(&bar[XB_XGEN(b.x)], 1u);
            asm volatile("s_waitcnt vmcnt(0)" ::: "memory");
        } else {
            XB_SPIN(xb_ld(&bar[XB_XGEN(b.x)]) == gen, bar);
            __builtin_amdgcn_fence(__ATOMIC_ACQUIRE, "agent");
            asm volatile("s_waitcnt vmcnt(0)" ::: "memory");
        }
    }
    __syncthreads();
}

constexpr int NWAVES = 8;
#ifndef MK_SPLIT
#define MK_SPLIT 0
#endif
constexpr int NPHASE = 11;
#ifndef MK_REP
#define MK_REP 0
#endif
#define REPN(k) (1 + ((MK_REP >> (k)) & 1))
#define DRYGEMM(k, g, S) do { if ((MK_REP >> (k)) & 1) { pg8::EpiDry Ed; pg8::gemm_phase<pg8::EpiDry, pg8::StaticOrder, PG8_ALIGN, PG8_SP2>(ring, g, S, Ed); } } while (0)
#ifndef PG8_SP2
#define PG8_SP2 true
#endif
#ifndef PG8_ALIGN
#define PG8_ALIGN true
#endif

constexpr int NBATCH = 8, SEQ = 2048, D = 1024, H = 16, HD = 64, FF = 4096, NIN = 3088, KVC = 256;
constexpr int M = NBATCH * SEQ;
constexpr int NQKV_A = 3 * D, NQKV_B = D + KVC;

constexpr size_t MiB = 1u << 20;
constexpr size_t WS_CTL = 0, CTL_ZERO_BYTES = 2 * MiB;
constexpr size_t WS_SS = 1536 * 1024;
constexpr size_t WS_WQKV_A = 2 * MiB, WS_WG = 8 * MiB, WS_WO_A = 9 * MiB, WS_WUP0 = 11 * MiB, WS_WDN0 = 19 * MiB, WS_WQKV_B = 27 * MiB, WS_WO_B = 30 * MiB, WS_WUP1 = 32 * MiB, WS_WDN1 = 40 * MiB;
constexpr size_t WS_KVB = 52 * MiB;
constexpr size_t WS_LOGF = 48 * MiB;
constexpr size_t WS_ACT = 64 * MiB;
constexpr size_t WS_H = 64 * MiB;
constexpr size_t WS_XN = 192 * MiB, WS_END = 224 * MiB;
static_assert(WS_SS + 4 * (size_t)M * 4 <= CTL_ZERO_BYTES && WS_WDN1 + (size_t)D * FF * 2 <= WS_LOGF && WS_LOGF + (size_t)NBATCH * H * SEQ * 4 <= WS_KVB && WS_KVB + (size_t)M * KVC * 2 <= WS_ACT && WS_H == WS_ACT && WS_H + (size_t)M * FF * 2 <= WS_XN && WS_XN + (size_t)M * D * 2 <= WS_END, "d_ws map");
constexpr int CW_CONV = 2048, CW_CONV_B = 2112, CW_CONV_0 = 2176;
constexpr int CW_KVD = 2304, CW_QD = 3328;
static_assert(CW_KVD + 16 * 64 <= CW_QD && CW_QD + 4 * 64 <= 4096, "flag words below the barrier regions");
constexpr int CW_BAR = 4096;
static_assert((size_t)(CW_BAR + 73 * 3456) * 4 <= WS_SS, "barrier regions below the ss accumulators");

constexpr int RING_OFF = 0, RING_BYTES = 131072;
constexpr int LDSCTL_OFF = RING_BYTES, MISC_OFF = LDSCTL_OFF + 320;
constexpr int EPI_RR_OFF = LDSCTL_OFF + 1024, EPI_G_OFF = LDSCTL_OFF + 2048;
constexpr int LDS_BYTES = 147456;
static_assert(att::FX_END <= RING_BYTES && att::SW_END <= RING_BYTES, "attention LDS maps fit the ring region");

struct Frame {
    LAS unsigned char* lds;
    volatile LAS unsigned* MISC;
    gu32* ctl;
    int tid, lane, wave;
    int vcu, G;
};
struct Args { const float* in[18]; float* out; unsigned char* ws; int ph_lo, ph_hi; };
#define A_x        (A.in[0])
#define A_g_attn   (A.in[1])
#define A_g_mlp    (A.in[2])
#define A_w_in_a   (A.in[3])
#define A_b_f      (A.in[4])
#define A_gq_a     (A.in[5])
#define A_gk_a     (A.in[6])
#define A_w_out_a  (A.in[7])
#define A_g_kv     (A.in[8])
#define A_w_kv     (A.in[9])
#define A_gk_b     (A.in[10])
#define A_w_q_b    (A.in[11])
#define A_gq_b     (A.in[12])
#define A_sinks    (A.in[13])
#define A_rel_bias (A.in[14])
#define A_w_out_b  (A.in[15])
#define A_w_up     (A.in[16])
#define A_w_down   (A.in[17])
#define WSB(off)   ((bf16*)(A.ws + (off)))
#define WSF(off)   ((float*)(A.ws + (off)))

__device__ __forceinline__ float wave_sum(float v) {
    v += __builtin_bit_cast(float, __builtin_amdgcn_update_dpp(0, __builtin_bit_cast(int, v), 0xB1, 0xF, 0xF, true));
    v += __builtin_bit_cast(float, __builtin_amdgcn_update_dpp(0, __builtin_bit_cast(int, v), 0x4E, 0xF, 0xF, true));
    v += __builtin_bit_cast(float, __builtin_amdgcn_update_dpp(0, __builtin_bit_cast(int, v), 0x141, 0xF, 0xF, true));
    v += __builtin_bit_cast(float, __builtin_amdgcn_update_dpp(0, __builtin_bit_cast(int, v), 0x140, 0xF, 0xF, true));
    { auto r = __builtin_amdgcn_permlane16_swap(__float_as_uint(v), __float_as_uint(v), false, false); v = __uint_as_float(r[0]) + __uint_as_float(r[1]); }
    { auto r = __builtin_amdgcn_permlane32_swap(__float_as_uint(v), __float_as_uint(v), false, false); v = __uint_as_float(r[0]) + __uint_as_float(r[1]); }
    return v;
}
__device__ __forceinline__ float wave_max(float v) {
#pragma unroll
    for (int o = 1; o < 64; o <<= 1) v = fmaxf(v, __shfl_xor(v, o));
    return v;
}
__device__ __forceinline__ int headperm(int n) { return (n & ~255) + 128 * ((n >> 5) & 1) + 32 * ((n >> 6) & 3) + (n & 31); }
template <bool WT_SC1 = false>
__device__ __forceinline__ void p0_transpose_item(const float* W, int ldw, int coff, int K, int N, bf16* WT, int perm, int row_off, const float* g, LAS float* scr, int item, int lane) {
    const int nblk = N / 32, kb = item / nblk, nb = item % nblk, k0 = 64 * kb, n0 = 32 * nb;
    float wv[32];
#pragma unroll
    for (int i = 0; i < 32; ++i) wv[i] = __builtin_nontemporal_load(W + (size_t)(k0 + 2 * i + (lane >> 5)) * ldw + coff + n0 + (lane & 31));
    if (g) {
#pragma unroll
        for (int i = 0; i < 32; ++i) wv[i] *= g[k0 + 2 * i + (lane >> 5)];
    }
#pragma unroll
    for (int i = 0; i < 32; ++i) scr[(2 * i + (lane >> 5)) * 33 + (lane & 31)] = wv[i];
    LDS_WAIT(); asm volatile("" ::: "memory");
    const int c = lane & 7;
#pragma unroll
    for (int j = 0; j < 4; ++j) { const int n = (lane >> 3) + 8 * j; const LAS float* s = scr + (8 * c) * 33 + n;
        v4u o; o.x = pk2(s[0 * 33], s[1 * 33]); o.y = pk2(s[2 * 33], s[3 * 33]); o.z = pk2(s[4 * 33], s[5 * 33]); o.w = pk2(s[6 * 33], s[7 * 33]);
        const int orow = row_off + (perm ? headperm(n0 + n) : (n0 + n));
        if constexpr (WT_SC1) { const __amdgpu_buffer_rsrc_t rs = __builtin_amdgcn_make_buffer_rsrc((void*)WT, 0, 0x7fffffff, 0x00020000);
            __builtin_amdgcn_raw_buffer_store_b128(o, rs, (int)(((size_t)orow * K + k0 + 8 * c) * 2), 0, 16); }
        else *(GAS v4u*)(WT + (size_t)orow * K + k0 + 8 * c) = o; }
    LDS_WAIT(); asm volatile("" ::: "memory");
}
template <int NR> __device__ __forceinline__ void rows_to_bf16(Frame& F, const float* x, bf16* xn, float* ss0, int m0, int stride) {
    f32x4 v[NR][4];
#pragma unroll
    for (int r = 0; r < NR; ++r) { const GAS f32x4* xr = (const GAS f32x4*)(x + (size_t)(m0 + r * stride) * D) + F.lane;
#pragma unroll
        for (int j = 0; j < 4; ++j) v[r][j] = __builtin_nontemporal_load(xr + 64 * j); }
#pragma unroll
    for (int r = 0; r < NR; ++r) { float s = 0.f;
#pragma unroll
        for (int j = 0; j < 4; ++j) s += (v[r][j].x * v[r][j].x + v[r][j].y * v[r][j].y) + (v[r][j].z * v[r][j].z + v[r][j].w * v[r][j].w);
        s = wave_sum(s);
        if (F.lane == 0) ss0[m0 + r * stride] = s;
        GAS unsigned long long* o8 = (GAS unsigned long long*)(xn + (size_t)(m0 + r * stride) * D) + F.lane;
#pragma unroll
        for (int j = 0; j < 4; ++j) o8[64 * j] = (unsigned long long)pk2(v[r][j].x, v[r][j].y) | ((unsigned long long)pk2(v[r][j].z, v[r][j].w) << 32); }
}
constexpr int P0_I1 = (D / 64) * (D / 32), P0_I2 = (D / 64) * (FF / 32), P0_I3 = (FF / 64) * (D / 32), P0_I5 = (D / 64) * (KVC / 32);
constexpr int P0_NLATE = 3 * P0_I1 + 2 * P0_I2 + 2 * P0_I3 + P0_I5, P0_NLATE_A = P0_I1 + P0_I2 + P0_I3;
#ifndef MK_EARLY
#define MK_EARLY 0
#endif
constexpr int P0_EARLY = MK_EARLY;
static_assert(P0_EARLY == 0, "early items: not with the two-part late list");
__device__ __forceinline__ void p0_late_item(Frame& F, const Args& A, LAS float* scr, int r) {
    const float* W; const float* g = nullptr; int ldw, K, N, perm = 0, row_off = 0; size_t wt;
    if (r < P0_I1) { W = A_w_out_a; ldw = D; K = D; N = D; wt = WS_WO_A; }
    else if ((r -= P0_I1) < P0_I2) { W = A_w_up; ldw = FF; K = D; N = FF; wt = WS_WUP0; g = A_g_mlp; }
    else if ((r -= P0_I2) < P0_I3) { W = A_w_down; ldw = D; K = FF; N = D; wt = WS_WDN0; }
    else if ((r -= P0_I3) < P0_I1) { W = A_w_q_b; ldw = D; K = D; N = D; wt = WS_WQKV_B; perm = 1; g = A_g_attn + D; }
    else if ((r -= P0_I1) < P0_I5) { W = A_w_kv; ldw = KVC; K = D; N = KVC; wt = WS_WQKV_B; perm = 1; row_off = D; g = A_g_kv; }
    else if ((r -= P0_I5) < P0_I1) { W = A_w_out_b; ldw = D; K = D; N = D; wt = WS_WO_B; }
    else if ((r -= P0_I1) < P0_I2) { W = A_w_up + (size_t)D * FF; ldw = FF; K = D; N = FF; wt = WS_WUP1; g = A_g_mlp + D; }
    else { r -= P0_I2; W = A_w_down + (size_t)FF * D; ldw = D; K = FF; N = D; wt = WS_WDN1; }
    p0_transpose_item<true>(W, ldw, 0, K, N, WSB(wt), perm, row_off, g, scr, r, F.lane);
}
__device__ __forceinline__ void p0_prologue(Frame& F, const Args& A, bool late) {
    LAS float* scr = (LAS float*)(F.lds + RING_OFF + F.wave * 16384);
    const int gw = F.vcu * NWAVES + F.wave, NGW = F.G * NWAVES;
    constexpr int I0 = (D / 64) * (NQKV_A / 32);
    for (int it = gw; it < I0; it += NGW) p0_transpose_item<true>(A_w_in_a, NIN, 0, D, NQKV_A, WSB(WS_WQKV_A), 1, 0, A_g_attn, scr, it, F.lane);
    for (int it = gw; it < (late ? P0_NLATE : P0_EARLY); it += NGW) p0_late_item(F, A, scr, it);
    for (int e = (F.vcu * NWAVES + F.wave) * 64 + F.lane; e < 16 * D; e += F.G * NWAVES * 64) { const int n = e >> 10, k = e & 1023; __hip_atomic_store(WSB(WS_WG) + e, (bf16)f2bf(A_w_in_a[(size_t)k * NIN + 3 * D + n] * A_g_attn[k]), __ATOMIC_RELAXED, __HIP_MEMORY_SCOPE_AGENT); }
    if (late) for (int m = gw; m < M; m += NGW) rows_to_bf16<1>(F, A_x, WSB(WS_XN), WSF(WS_SS) + 3 * M, m, NGW);
}
__device__ __forceinline__ void p0_rows(Frame& F, const Args& A, int blk) {
    const int m0 = 64 * blk + F.wave;
    rows_to_bf16<4>(F, A_x, WSB(WS_XN), WSF(WS_SS) + 3 * M, m0, 8);
    rows_to_bf16<4>(F, A_x, WSB(WS_XN), WSF(WS_SS) + 3 * M, m0 + 32, 8);
}
#ifndef MK_SLOTS
#define MK_SLOTS 1
#endif
__device__ __forceinline__ int slot_of(int part, int b) {
#if MK_SLOTS == 0
    return part == 0 ? (b >= 4 ? 0 : 1) : 2 + b % 3;
#else
    return b < 4 ? 1 : 2;
#endif
}
__device__ __forceinline__ void copy_slot(Frame& F, const Args& A, int slot, int bb) {
    constexpr int NA = P0_NLATE_A, NB = P0_NLATE - P0_NLATE_A; static_assert(NA % 8 == 0 && NB % 8 == 0, "even eighths");
#pragma unroll 1
    for (int part = 0; part < 2; ++part) {
        if (slot_of(part, bb) != slot) continue;
        const int lo = part == 0 ? (NA / 8) * bb : NA + (NB / 8) * bb, hi = lo + (part == 0 ? NA / 8 : NB / 8);
        __syncthreads();
        LAS float* scr = (LAS float*)(F.lds + RING_OFF + F.wave * 16384);
        for (int it = lo + (F.vcu & 31) * NWAVES + F.wave; it < hi; it += 32 * NWAVES) p0_late_item(F, A, scr, it);
        asm volatile("s_waitcnt vmcnt(0)" ::: "memory"); __syncthreads();
        if (F.tid == 0) __hip_atomic_fetch_add((unsigned*)(F.ctl + (part == 0 ? CW_CONV : CW_CONV_B)), 1u, __ATOMIC_RELAXED, __HIP_MEMORY_SCOPE_AGENT);
    }
}
__device__ __forceinline__ void gate_job(Frame& F, const Args& A, int blk0) {
    const int lane = F.lane, fr = lane & 15, fq = lane >> 4, rg = F.wave & 3, kh = F.wave >> 2;
    for (int blk = blk0; blk < M / 64; blk += F.G) {
        const int row0 = 64 * blk + 16 * rg;
        const bf16* arow = WSB(WS_XN) + (size_t)(row0 + fr) * D + kh * 512 + 8 * fq;
        const bf16* brow = WSB(WS_WG) + (size_t)fr * D + kh * 512 + 8 * fq;
        f32x4 acc = (f32x4){0.f, 0.f, 0.f, 0.f};
#pragma unroll 8
        for (int kk = 0; kk < 16; ++kk) { const bf16x8 a = *(const bf16x8*)(arow + 32 * kk), b = *(const bf16x8*)(brow + 32 * kk); acc = __builtin_amdgcn_mfma_f32_16x16x32_bf16(a, b, acc, 0, 0, 0); }
        LAS f32x4* scr = (LAS f32x4*)(F.lds + RING_OFF) + rg * 64 + lane;
        if (kh == 1) *scr = acc;
        __syncthreads();
        if (kh == 0) { const f32x4 o = *scr; acc += o;
            const float bias = A_b_f[fr];
#pragma unroll
            for (int i = 0; i < 4; ++i) { const float rr = rsqrtf(WSF(WS_SS)[3 * M + row0 + 4 * fq + i] * (1.f / D) + 1e-6f); const float z = acc[i] * rr + bias; const float lf = fminf(z, 0.f) - log1pf(expf(-fabsf(z)));
                const int tok = row0 + 4 * fq + i, bb = tok >> 11, t = tok & (SEQ - 1);
                WSF(WS_LOGF)[(size_t)(bb * H + fr) * SEQ + t] = lf * 1.4426950408889634f; } }
        __syncthreads();
    }
}

__global__ void __launch_bounds__(NWAVES * 64, 2) yoco_fwd(Args A) {
    extern __shared__ __attribute__((aligned(16))) unsigned char lds[];
    Frame F;
    F.lds = (LAS unsigned char*)lds;
    F.MISC = (volatile LAS unsigned*)(F.lds + MISC_OFF);
    F.tid = threadIdx.x; F.lane = F.tid & 63; F.wave = __builtin_amdgcn_readfirstlane(F.tid >> 6);
    F.G = gridDim.x; { const int bx = blockIdx.x; F.vcu = (F.G % 8 == 0) ? (bx % 8) * (F.G / 8) + bx / 8 : bx; }
    F.ctl = (gu32*)(A.ws + WS_CTL);
    for (int u = F.tid; u < (LDS_BYTES - LDSCTL_OFF) / 4; u += NWAVES * 64) ((LAS unsigned*)(F.lds + LDSCTL_OFF))[u] = 0u;
    __syncthreads();
    const int lo = A.ph_lo, hi = A.ph_hi;
    const bool use_bar = (hi - lo) > 1;
    XcdBarrier bar; bar.bar = (unsigned*)(F.ctl + CW_BAR); bar.x = 0; bar.st = nullptr;
    if (use_bar) { bar = xcd_barrier_post((unsigned*)(F.ctl + CW_BAR), F.MISC + 8, (unsigned)F.G); bar.nowb = (F.G == 256); }
    const int bb = (int)(blockIdx.x & 7); const bool batch_sets = (F.G == 256);
    XcdBarrier sbar = bar;
    if (use_bar && batch_sets) sbar = xcd_barrier_post((unsigned*)(F.ctl + CW_BAR) + (1 + bb) * XCD_BAR_WORDS, F.MISC + 10, 32u);
    const int gj = (int)((blockIdx.x >> 3) & 7), gm = (int)(blockIdx.x >> 6);
    XcdBarrier gbar = sbar;
    if (use_bar && batch_sets) gbar = xcd_barrier_post((unsigned*)(F.ctl + CW_BAR) + (9 + bb * 8 + gj) * XCD_BAR_WORDS, F.MISC + 12, 4u);
    unsigned char* const pnl = A.ws + WS_ACT + (size_t)bb * (16 * MiB) + (size_t)gj * (2 * MiB);
    const size_t rp0 = (size_t)(8 * bb + gj) * 256 * 2048;
    bf16* const ACT_Q = (bf16*)(pnl - rp0); bf16* const ACT_OA = (bf16*)(pnl + 3 * 512 * 1024 - rp0);
    bf16* const ACT_QB = ACT_Q; bf16* const ACT_OB = ACT_Q;
    bf16* const ACT_KVB = WSB(WS_KVB);
    bf16* const ACT_PB = (bf16*)(A.ws + WS_ACT + (size_t)bb * (16 * MiB));
#define IN(k) (lo <= (k) && (k) < hi)
#define SEAM1(k) do { if ((k) == 0) xcd_barrier(bar); else if ((k) == 1 || (k) == 2 || (k) == 6) xcd_barrier(sbar); else xcd_barrier(gbar); } while (0)
#define SEAM(k) do { if (IN(k) && IN((k) + 1)) { SEAM1(k); if ((MK_REP >> 11) & 1) SEAM1(k); } } while (0)
    float* ss1 = WSF(WS_SS); float* ss2 = WSF(WS_SS) + M; float* ss3 = WSF(WS_SS) + 2 * M; float* ss0 = WSF(WS_SS) + 3 * M;
    LAS unsigned char* ring = F.lds + RING_OFF;
    LAS float* const epi_rr = (LAS float*)(F.lds + EPI_RR_OFF); LAS float* const epi_g = (LAS float*)(F.lds + EPI_G_OFF);
    const int my_pm = 8 * bb + gj;
#define STAGE_RR(ssp) do { if (F.tid < 256) epi_rr[F.tid] = rsqrtf((ssp)[my_pm * 256 + F.tid] * (1.f / 1024.f) + 1e-6f); } while (0)
#define STAGE_G(gq_, gk_) do { if (F.tid < 64) epi_g[F.tid] = (gq_)[F.tid] * (gk_)[F.tid] * pg8::QK_C2; } while (0)

    if (IN(0)) { for (int rep = 0; rep < REPN(0); ++rep) p0_prologue(F, A, !(use_bar && batch_sets)); }
    if (use_bar && batch_sets) {
        asm volatile("s_waitcnt vmcnt(0)" ::: "memory"); __syncthreads();
        if (F.tid == 0) __hip_atomic_fetch_add((unsigned*)(F.ctl + CW_CONV_0), 1u, __ATOMIC_RELAXED, __HIP_MEMORY_SCOPE_AGENT);
        p0_rows(F, A, 4 * (8 * bb + gj) + gm);
        copy_slot(F, A, 0, bb);
        asm volatile("s_waitcnt vmcnt(0)" ::: "memory"); __syncthreads();
        if (F.tid == 0) { unsigned sp = 0; while (__hip_atomic_load((unsigned*)(F.ctl + CW_CONV_0), __ATOMIC_RELAXED, __HIP_MEMORY_SCOPE_AGENT) < 256u) { __builtin_amdgcn_s_sleep(2); if (++sp > (1u << 22)) break; } }
        xcd_barrier(gbar);
    } else SEAM(0);
    if (IN(1)) {
        STAGE_RR(ss0); STAGE_G(A_gq_a, A_gk_a);
        gate_job(F, A, (use_bar && batch_sets) ? 4 * (8 * bb + gj) + gm : F.vcu);
        pg8::Gemm g{WSB(WS_XN), WSB(WS_WQKV_A), M, NQKV_A, D}; pg8::StaticOrder S; S.init(M, NQKV_A, F.G, (int)blockIdx.x);
        pg8::EpiHead E{ACT_Q, (size_t)(512 * 1024) / 2, nullptr, epi_g, epi_rr, 0};
        DRYGEMM(1, g, S);
        if ((MK_REP >> 13) & 1) { gate_job(F, A, (use_bar && batch_sets) ? 4 * (8 * bb + gj) + gm : F.vcu); pg8::gemm_phase<pg8::EpiHead, pg8::StaticOrder, PG8_ALIGN, PG8_SP2>(ring, g, S, E); }
        pg8::gemm_phase<pg8::EpiHead, pg8::StaticOrder, PG8_ALIGN, PG8_SP2>(ring, g, S, E);
        if (use_bar && batch_sets) copy_slot(F, A, 1, bb);
    } SEAM(1);
    if (IN(2)) {
        int ln = F.lane; asm volatile("" : "+v"(ln));
        const float gqm = wave_max(fabsf(A_gq_a[ln])), gkm = wave_max(fabsf(A_gk_a[ln]));
        const float nB2 = -(8.f * gqm * gkm * 1.01f * att::LOG2E);
        for (int rep = 0; rep < REPN(2); ++rep)
        for (int c = F.vcu; c < 256; c += F.G) {
            const int bh = c >> 1, s = c & 1;
            att::fox_prepare(bh >> 4, bh & 15, WSF(WS_LOGF), (att::lds_ptr)ring);
            att::fox_cu(bh & 15, s, ACT_PB, (att::lds_ptr)ring, nB2);
        }
    }
    if (IN(2) && use_bar && batch_sets) copy_slot(F, A, 2, bb);
    if (IN(2) && IN(3) && use_bar && batch_sets) {
        if (F.tid == 0) { unsigned sp = 0; while (__hip_atomic_load((unsigned*)(F.ctl + CW_CONV), __ATOMIC_RELAXED, __HIP_MEMORY_SCOPE_AGENT) < 256u) { __builtin_amdgcn_s_sleep(2); if (++sp > (1u << 22)) break; } }
    }
    SEAM(2);
    if (IN(3)) {
        pg8::Gemm g{ACT_OA, WSB(WS_WO_A), M, D, D}; pg8::StaticOrder S; S.init(M, D, F.G, (int)blockIdx.x);
        pg8::EpiResid<1> E{nullptr, WSB(WS_XN), nullptr, ss1, nullptr};
        DRYGEMM(3, g, S);
        pg8::gemm_phase<pg8::EpiResid<1>, pg8::StaticOrder, PG8_ALIGN, PG8_SP2>(ring, g, S, E);
        if (use_bar && batch_sets) copy_slot(F, A, 3, bb);
    } SEAM(3);
    if (IN(4)) {
        pg8::Gemm g{WSB(WS_XN), WSB(WS_WUP0), M, FF, D}; pg8::StaticOrder S; S.init(M, FF, F.G, (int)blockIdx.x);
        STAGE_RR(ss1); __syncthreads();
        pg8::EpiAct E{WSB(WS_H), FF};
        DRYGEMM(4, g, S);
        if ((MK_REP >> 12) & 1) pg8::gemm_phase<pg8::EpiAct, pg8::StaticOrder, PG8_ALIGN, PG8_SP2>(ring, g, S, E);
        pg8::gemm_phase<pg8::EpiAct, pg8::StaticOrder, PG8_ALIGN, PG8_SP2>(ring, g, S, E);
        if (use_bar && batch_sets) copy_slot(F, A, 4, bb);
    } SEAM(4);
    if (IN(5)) {
        pg8::Gemm g{WSB(WS_H), WSB(WS_WDN0), M, D, FF}; pg8::StaticOrder S; S.init(M, D, F.G, (int)blockIdx.x);
        if (!use_bar) { STAGE_RR(ss1); __syncthreads(); }
        pg8::EpiResid<1, true> E{nullptr, WSB(WS_XN), nullptr, ss2, epi_rr};
        DRYGEMM(5, g, S);
        pg8::gemm_phase<pg8::EpiResid<1, true>, pg8::StaticOrder, PG8_ALIGN, PG8_SP2>(ring, g, S, E);
    }
    if (IN(5) && IN(6) && use_bar && batch_sets) {
        if (F.tid == 0) { unsigned sp = 0; while (__hip_atomic_load((unsigned*)(F.ctl + CW_CONV_B), __ATOMIC_RELAXED, __HIP_MEMORY_SCOPE_AGENT) < 256u) { __builtin_amdgcn_s_sleep(2); if (++sp > (1u << 22)) break; } }
    }
    SEAM(5);
    if (IN(6) && IN(7) && use_bar && batch_sets) {
        {
            pg8::Gemm g{WSB(WS_XN), WSB(WS_WQKV_B), M, NQKV_B, D};
            STAGE_RR(ss2); STAGE_G(A_gq_b, A_gk_b); __syncthreads();
            pg8::EpiHead E{ACT_QB, 0, ACT_KVB, epi_g, epi_rr, 1};
            struct KvFirst { int pm, gm; gu32* flag; bool rel;
                __device__ bool next(int i, pg8::Unit& u) const { if (i > (gm == 0 ? 1 : 0)) return false; u.pm = pm; u.pn = (gm == 0) ? (i == 0 ? 4 : 0) : gm; return true; }
                __device__ __forceinline__ void a_ready(const pg8::Unit&) const {}
                __device__ __forceinline__ void done(const pg8::Unit& u) const {
                    if (u.pn == 4) { asm volatile("s_waitcnt vmcnt(0)" ::: "memory"); __syncthreads();
                        if (threadIdx.x == 0) { if (rel) { __builtin_amdgcn_fence(__ATOMIC_RELEASE, "agent"); asm volatile("s_waitcnt vmcnt(0)" ::: "memory"); }
                            __hip_atomic_fetch_add((unsigned*)flag, 1u, __ATOMIC_RELAXED, __HIP_MEMORY_SCOPE_AGENT); } } }
            } S{my_pm, gm, F.ctl + CW_KVD + 16 * my_pm, sbar.st[1] > 1u};
            pg8::gemm_phase<pg8::EpiHead, KvFirst, PG8_ALIGN, PG8_SP2>(ring, g, S, E);
            if (F.tid == 0) { if (sbar.st[1] > 1u) { __builtin_amdgcn_fence(__ATOMIC_RELEASE, "agent"); asm volatile("s_waitcnt vmcnt(0)" ::: "memory"); }
                __hip_atomic_fetch_add((unsigned*)(F.ctl + CW_QD + 4 * my_pm + gm), 1u, __ATOMIC_RELAXED, __HIP_MEMORY_SCOPE_AGENT); }
        }
        int ln = F.lane; asm volatile("" : "+v"(ln));
        const float gqm = wave_max(fabsf(A_gq_b[ln])), gkm = wave_max(fabsf(A_gk_b[ln]));
        const float qkb = 8.f * gqm * gkm * 1.01f * att::LOG2E;
#define WAITF(w_) do { unsigned sp_ = 0; while (__hip_atomic_load((unsigned*)(F.ctl + (w_)), __ATOMIC_RELAXED, __HIP_MEMORY_SCOPE_AGENT) < 1u) { __builtin_amdgcn_s_sleep(1); if (++sp_ > (1u << 22)) break; } } while (0)
#define ACQ() do { __builtin_amdgcn_fence(__ATOMIC_ACQUIRE, "agent"); asm volatile("s_waitcnt vmcnt(0)" ::: "memory"); } while (0)
        if (gm >= 2) {
            if (F.tid == 0) { WAITF(CW_KVD + 16 * my_pm); if (gj > 0 && gm == 2) WAITF(CW_KVD + 16 * (my_pm - 1)); WAITF(CW_QD + 4 * my_pm + 2); WAITF(CW_QD + 4 * my_pm + 3); ACQ(); }
            __syncthreads();
            att::swa_unit<0, 4>(bb, 1, 2 * gj + (gm & 1), ACT_QB, ACT_KVB, ACT_OB, A_sinks, A_rel_bias, (att::lds_ptr)ring, qkb);
        } else if (gm == 1) {
            if (F.tid == 0) { WAITF(CW_KVD + 16 * my_pm); if (gj > 0) WAITF(CW_KVD + 16 * (my_pm - 1)); WAITF(CW_QD + 4 * my_pm + 1); ACQ(); }
            __syncthreads();
#pragma unroll 1
            for (int qh = 0; qh < 2; ++qh) att::swa_unit<2, 4>(bb, 0, 2 * gj + qh, ACT_QB, ACT_KVB, ACT_OB, A_sinks, A_rel_bias, (att::lds_ptr)ring, qkb);
        }
        if (gm == 0 || gm == 2) {
            if (F.tid == 0) { WAITF(CW_KVD + 16 * my_pm); if (gj > 0 && gm == 0) WAITF(CW_KVD + 16 * (my_pm - 1)); WAITF(CW_QD + 4 * my_pm + 0); ACQ(); }
            __syncthreads();
            att::swa_unit<0, 2>(bb, 0, 2 * gj + (gm >> 1), ACT_QB, ACT_KVB, ACT_OB, A_sinks, A_rel_bias, (att::lds_ptr)ring, qkb);
        }
#undef WAITF
#undef ACQ
        xcd_barrier(gbar);
    } else {
    if (IN(6)) {
        pg8::Gemm g{WSB(WS_XN), WSB(WS_WQKV_B), M, NQKV_B, D}; pg8::StaticOrder S; S.init(M, NQKV_B, F.G, (int)blockIdx.x);
        STAGE_RR(ss2); STAGE_G(A_gq_b, A_gk_b); __syncthreads();
        pg8::EpiHead E{ACT_QB, 0, ACT_KVB, epi_g, epi_rr, 1};
        pg8::gemm_phase<pg8::EpiHead, pg8::StaticOrder, PG8_ALIGN, PG8_SP2>(ring, g, S, E);
    } SEAM(6);
    if (IN(7)) {
        int ln = F.lane; asm volatile("" : "+v"(ln));
        const float gqm = wave_max(fabsf(A_gq_b[ln])), gkm = wave_max(fabsf(A_gk_b[ln]));
        const float qkb = 8.f * gqm * gkm * 1.01f * att::LOG2E;
        att::swa_unit<0, 4>(bb, gm >> 1, 2 * gj + (gm & 1), ACT_QB, ACT_KVB, ACT_OB, A_sinks, A_rel_bias, (att::lds_ptr)ring, qkb);
    } SEAM(7);
    }
    if (IN(8)) {
        pg8::Gemm g{ACT_OB, WSB(WS_WO_B), M, D, D}; pg8::StaticOrder S; S.init(M, D, F.G, (int)blockIdx.x);
        pg8::EpiResid<1> E{nullptr, WSB(WS_XN), nullptr, ss3, nullptr};
        DRYGEMM(8, g, S);
        pg8::gemm_phase<pg8::EpiResid<1>, pg8::StaticOrder, PG8_ALIGN, PG8_SP2>(ring, g, S, E);
    } SEAM(8);
    if (IN(9)) {
        pg8::Gemm g{WSB(WS_XN), WSB(WS_WUP1), M, FF, D}; pg8::StaticOrder S; S.init(M, FF, F.G, (int)blockIdx.x);
        STAGE_RR(ss3); __syncthreads();
        pg8::EpiAct E{WSB(WS_H), FF};
        DRYGEMM(9, g, S);
        pg8::gemm_phase<pg8::EpiAct, pg8::StaticOrder, PG8_ALIGN, PG8_SP2>(ring, g, S, E);
    } SEAM(9);
    if (IN(10)) {
        pg8::Gemm g{WSB(WS_H), WSB(WS_WDN1), M, D, FF}; pg8::StaticOrder S; S.init(M, D, F.G, (int)blockIdx.x);
        if (!use_bar) { STAGE_RR(ss3); __syncthreads(); }
        pg8::EpiResid<2, true> E{nullptr, WSB(WS_XN), A.out, nullptr, epi_rr};
        DRYGEMM(10, g, S);
        pg8::gemm_phase<pg8::EpiResid<2, true>, pg8::StaticOrder, PG8_ALIGN, PG8_SP2>(ring, g, S, E);
    }
#undef IN
#undef SEAM
}

extern "C" void kernel_launch(void* const* d_in, const int* in_sizes, int n_in, void* d_out, int out_size, void* d_ws, size_t ws_size, hipStream_t stream) {
    static int grid = 0;
    if (grid == 0) {
        if (n_in != 18 || in_sizes[0] != M * D || out_size != M * D || ws_size < WS_END) { fprintf(stderr, "kernel_launch: unexpected shapes (n_in %d, in0 %d, out %d, ws %zu); nothing launched\n", n_in, n_in > 0 ? in_sizes[0] : -1, out_size, ws_size); grid = -1; return; }
        int dev = 0, cus = 0, per_cu = 0;
        if (hipGetDevice(&dev) != hipSuccess || hipDeviceGetAttribute(&cus, hipDeviceAttributeMultiprocessorCount, dev) != hipSuccess) { grid = -1; return; }
        if (hipFuncSetAttribute((const void*)yoco_fwd, hipFuncAttributeMaxDynamicSharedMemorySize, LDS_BYTES) != hipSuccess) { fprintf(stderr, "kernel_launch: hipFuncSetAttribute failed\n"); grid = -1; return; }
        if (hipOccupancyMaxActiveBlocksPerMultiprocessor(&per_cu, (const void*)yoco_fwd, NWAVES * 64, LDS_BYTES) != hipSuccess || per_cu < 1)
            fprintf(stderr, "kernel_launch: note: occupancy query reports %d workgroups per CU\n", per_cu);
        (void)hipGetLastError();
        grid = cus;
        if (grid != 256) { fprintf(stderr, "kernel_launch: built for a 256-CU device (batch-set unit orders); found %d CUs; nothing launched\n", cus); grid = -1; return; }
    }
    if (grid < 0) return;
    if (hipMemsetAsync((char*)d_ws + WS_CTL, 0, CTL_ZERO_BYTES, stream) != hipSuccess) { fprintf(stderr, "kernel_launch: hipMemsetAsync failed\n"); return; }
    Args a{};
    for (int i = 0; i < 18; ++i) a.in[i] = (const float*)d_in[i];
    a.out = (float*)d_out; a.ws = (unsigned char*)d_ws;
#if MK_SPLIT
    for (int p = 0; p < NPHASE; ++p) { a.ph_lo = p; a.ph_hi = p + 1; hipLaunchKernelGGL(yoco_fwd, dim3(grid), dim3(NWAVES * 64), LDS_BYTES, stream, a); }
#else
    a.ph_lo = 0; a.ph_hi = NPHASE;
    hipLaunchKernelGGL(yoco_fwd, dim3(grid), dim3(NWAVES * 64), LDS_BYTES, stream, a);
#endif
    const hipError_t le = hipPeekAtLastError();
    if (le != hipSuccess) fprintf(stderr, "kernel_launch: launch failed: %s\n", hipGetErrorName(le));
}
```

```cpp
#include <hip/hip_runtime.h>
#include <hip/hip_bf16.h>
#include <cstdio>
#include <cstdint>
#include <cmath>
namespace pg8 {
#define PG8_LAS __attribute__((address_space(3)))
typedef unsigned short bf16_t;
typedef short bf16x8 __attribute__((ext_vector_type(8)));
typedef float f32x4 __attribute__((ext_vector_type(4)));
typedef unsigned u32x4 __attribute__((ext_vector_type(4)));
constexpr int BM = 256, BK = 64, HALF = 128, HTB = HALF * BK * 2  , STAGE_BYTES = 8 * HTB, NXCD = 8, WGM = 8;

__host__ __device__ __forceinline__ int lds_byte(int r, int c) { const int st = (r >> 4) * 2 + (c >> 5), rr = r & 15, cc = c & 31, ob = rr * 64 + cc * 2; return st * 1024 + (ob ^ (((ob >> 9) & 1) << 5)); }
__host__ __device__ __forceinline__ void stage_rc(int b, int& R, int& C) { const int st = b / 1024, sb = b % 1024, swz = sb ^ (((sb >> 9) & 1) << 5); R = (st >> 1) * 16 + swz / 64; C = (st & 1) * 32 + (swz % 64) / 2; }
__host__ __device__ __forceinline__ int perm32(int rho) { const int n = rho >> 4, i = rho & 15; return 8 * (i >> 2) + 4 * n + (i & 3); }

struct Unit { int pm, pn; };
struct Gemm { const bf16_t* A; const bf16_t* Bt; int M, N, K; };

struct StaticOrder {
    int nM, nN, nwg, G, c;
    __host__ __device__ void init(int M, int N, int G_, int c_) { nM = M / BM; nN = N / BM; nwg = nM * nN; G = G_; c = c_; }
    __host__ __device__ bool next(int i, Unit& u) const {
        const long L = (long)i * G + c; if (L >= nwg) return false;
        int wgid = (int)L; { const int q = nwg / NXCD, r = nwg % NXCD, xcd = wgid % NXCD, off = wgid / NXCD; wgid = (xcd < r ? xcd * (q + 1) : r * (q + 1) + (xcd - r) * q) + off; }
        const int nig = WGM * nN, gid = wgid / nig, fm = gid * WGM, gsz = (nM - fm) < WGM ? (nM - fm) : WGM;
        u.pm = fm + ((wgid % nig) % gsz); u.pn = (wgid % nig) / gsz; return true;
    }
    __device__ __forceinline__ void a_ready(const Unit&) const {}
    __device__ __forceinline__ void done(const Unit&) const {}
};
__device__ __forceinline__ unsigned cvt_pk_bf16(float lo, float hi) { unsigned r; asm volatile("v_cvt_pk_bf16_f32 %0, %1, %2" : "=v"(r) : "v"(lo), "v"(hi)); return r; }
typedef unsigned u32x2 __attribute__((ext_vector_type(2)));
constexpr float QK_C2 = 0.125f * 1.4426950408889634f;
constexpr float RMS_EPS = 1e-6f;

__device__ __forceinline__ float sum_fq(float s) {
    { auto r = __builtin_amdgcn_permlane16_swap(__float_as_uint(s), __float_as_uint(s), false, false); s = __uint_as_float(r[0]) + __uint_as_float(r[1]); }
    { auto r = __builtin_amdgcn_permlane32_swap(__float_as_uint(s), __float_as_uint(s), false, false); s = __uint_as_float(r[0]) + __uint_as_float(r[1]); }
    return s;
}
typedef float f32x2 __attribute__((ext_vector_type(2)));
__device__ __forceinline__ float sumsq16(const f32x4& a, const f32x4& b, const f32x4& c, const f32x4& d) {
    f32x2 s = a.xy * a.xy;
    s = __builtin_elementwise_fma(a.zw, a.zw, s); s = __builtin_elementwise_fma(b.xy, b.xy, s); s = __builtin_elementwise_fma(b.zw, b.zw, s);
    s = __builtin_elementwise_fma(c.xy, c.xy, s); s = __builtin_elementwise_fma(c.zw, c.zw, s); s = __builtin_elementwise_fma(d.xy, d.xy, s); s = __builtin_elementwise_fma(d.zw, d.zw, s);
    return s.x + s.y;
}
struct EpiHead {
    static constexpr bool PERM = true, AFTER_DRAIN = false; static constexpr int NST = 32;
    bf16_t* dq; size_t cls_stride; bf16_t* dkv; const PG8_LAS float* gl; const PG8_LAS float* rrl; int layerB;
    __device__ __forceinline__ void operator()(const f32x4 (&acc)[2][2][4][2], const Unit& u, int wr, int wc, int fr0, int fq0) const {
        int ln = fr0 | (fq0 << 4); asm volatile("" : "+v"(ln)); const int fr = ln & 15, fq = ln >> 4;
        bf16_t* base; int ld, colbase, mode;
        if (!layerB) { const int cls = u.pn >> 2; base = dq + (size_t)cls * cls_stride; ld = 1024; colbase = 256 * (u.pn & 3); mode = cls; }
        else if (u.pn < 4) { base = dq; ld = 1024; colbase = 256 * u.pn; mode = 0; }
        else { base = dkv; ld = 256; colbase = 0; mode = wc < 2 ? 1 : 2; }
        const int row0 = u.pm * BM + wr * 64 + fr;
        bf16_t* p0 = base + (size_t)row0 * ld + colbase + 64 * wc + 8 * fq;
        if (mode == 0) {
            f32x4 gv[2][2];
#pragma unroll
            for (int bj = 0; bj < 2; ++bj)
#pragma unroll
                for (int n = 0; n < 2; ++n) gv[bj][n] = *(const PG8_LAS f32x4*)(gl + 32 * bj + 8 * fq + 4 * n);
#pragma unroll
            for (int ai = 0; ai < 2; ++ai)
#pragma unroll
                for (int m = 0; m < 4; ++m) {
                    const float rr = rrl[wr * 64 + fr + ai * HALF + m * 16];
                    const float s = sum_fq(sumsq16(acc[ai][0][m][0], acc[ai][0][m][1], acc[ai][1][m][0], acc[ai][1][m][1]));
                    const float t = rr * __builtin_amdgcn_rsqf(rr * rr * s * (1.f / 64.f) + RMS_EPS);
                    bf16_t* rowp = p0 + (size_t)(ai * HALF + m * 16) * ld;
#pragma unroll
                    for (int bj = 0; bj < 2; ++bj) { const f32x4 v0 = acc[ai][bj][m][0] * gv[bj][0] * t, v1 = acc[ai][bj][m][1] * gv[bj][1] * t;
                        u32x4 w; w.x = cvt_pk_bf16(v0[0], v0[1]); w.y = cvt_pk_bf16(v0[2], v0[3]); w.z = cvt_pk_bf16(v1[0], v1[1]); w.w = cvt_pk_bf16(v1[2], v1[3]);
                        *(u32x4*)(rowp + 32 * bj) = w; }
                }
        } else {
#pragma unroll
            for (int ai = 0; ai < 2; ++ai)
#pragma unroll
                for (int m = 0; m < 4; ++m) {
                    float t = rrl[wr * 64 + fr + ai * HALF + m * 16];
                    if (mode == 1) { const float s = sum_fq(sumsq16(acc[ai][0][m][0], acc[ai][0][m][1], acc[ai][1][m][0], acc[ai][1][m][1])); t = t * __builtin_amdgcn_rsqf(t * t * s * (1.f / 64.f) + RMS_EPS); }
                    bf16_t* rowp = p0 + (size_t)(ai * HALF + m * 16) * ld;
#pragma unroll
                    for (int bj = 0; bj < 2; ++bj) { const f32x4 v0 = acc[ai][bj][m][0] * t, v1 = acc[ai][bj][m][1] * t;
                        u32x4 w; w.x = cvt_pk_bf16(v0[0], v0[1]); w.y = cvt_pk_bf16(v0[2], v0[3]); w.z = cvt_pk_bf16(v1[0], v1[1]); w.w = cvt_pk_bf16(v1[2], v1[3]);
                        *(u32x4*)(rowp + 32 * bj) = w; }
                }
        }
    }
};

struct EpiAct {
    static constexpr bool PERM = true, AFTER_DRAIN = false; static constexpr int NST = 32;
    bf16_t* O; int ldc;
    __device__ __forceinline__ void operator()(const f32x4 (&acc)[2][2][4][2], const Unit& u, int wr, int wc, int fr, int fq) const {
        const int row0 = u.pm * BM + wr * 64 + fr, col0 = u.pn * BM + wc * 32 + 8 * fq;
#pragma unroll
        for (int ai = 0; ai < 2; ++ai)
#pragma unroll
            for (int m = 0; m < 4; ++m) {
                const int row = row0 + ai * HALF + m * 16;
                bf16_t* rowp = O + (size_t)row * ldc + col0;
#pragma unroll
                for (int bj = 0; bj < 2; ++bj) { f32x4 v0 = acc[ai][bj][m][0], v1 = acc[ai][bj][m][1];
#pragma unroll
                    for (int e = 0; e < 4; ++e) { v0[e] = __int_as_float(max(__float_as_int(v0[e]), 0)); v1[e] = __int_as_float(max(__float_as_int(v1[e]), 0)); }
                    v0 = v0 * v0; v1 = v1 * v1;
                    u32x4 w; w.x = cvt_pk_bf16(v0[0], v0[1]); w.y = cvt_pk_bf16(v0[2], v0[3]); w.z = cvt_pk_bf16(v1[0], v1[1]); w.w = cvt_pk_bf16(v1[2], v1[3]);
                    *(u32x4*)(rowp + bj * HALF) = w; }
            }
    }
};

template <int MODE, bool SCALE = false> struct EpiResid {
    static constexpr bool PERM = true, AFTER_DRAIN = false; static constexpr int NST = 0;
    const float* base32; bf16_t* xn; float* out32; float* ss; const PG8_LAS float* rrl;
    __device__ __forceinline__ void operator()(const f32x4 (&acc)[2][2][4][2], const Unit& u, int wr, int wc, int fr, int fq) const {
        const int row0 = u.pm * BM + wr * 64 + fr, col0 = u.pn * BM + wc * 32 + 8 * fq;
#pragma unroll
        for (int ai = 0; ai < 2; ++ai)
#pragma unroll
            for (int m = 0; m < 4; ++m) {
                const int row = row0 + ai * HALF + m * 16; const size_t off = (size_t)row * 1024 + col0;
                float s = 0.f, sc = 1.f;
                if (SCALE) { const float rr = rrl[wr * 64 + fr + ai * HALF + m * 16]; sc = rr * rr; }
#pragma unroll
                for (int bj = 0; bj < 2; ++bj) {
                    f32x4 r0, r1;
                    if (MODE == 0) { r0 = __builtin_nontemporal_load((const f32x4*)(base32 + off + bj * HALF)); r1 = __builtin_nontemporal_load((const f32x4*)(base32 + off + bj * HALF + 4)); }
                    else { const u32x4 w = MODE == 2 ? __builtin_nontemporal_load((const u32x4*)(xn + off + bj * HALF)) : *(const u32x4*)(xn + off + bj * HALF);
                        r0 = (f32x4){__uint_as_float(w.x << 16), __uint_as_float(w.x & 0xffff0000u), __uint_as_float(w.y << 16), __uint_as_float(w.y & 0xffff0000u)};
                        r1 = (f32x4){__uint_as_float(w.z << 16), __uint_as_float(w.z & 0xffff0000u), __uint_as_float(w.w << 16), __uint_as_float(w.w & 0xffff0000u)}; }
                    const f32x4 o0 = SCALE ? r0 + acc[ai][bj][m][0] * sc : r0 + acc[ai][bj][m][0], o1 = SCALE ? r1 + acc[ai][bj][m][1] * sc : r1 + acc[ai][bj][m][1];
                    if (MODE == 2) { __builtin_nontemporal_store(o0, (f32x4*)(out32 + off + bj * HALF)); __builtin_nontemporal_store(o1, (f32x4*)(out32 + off + bj * HALF + 4)); }
                    else { u32x4 w; w.x = cvt_pk_bf16(o0[0], o0[1]); w.y = cvt_pk_bf16(o0[2], o0[3]); w.z = cvt_pk_bf16(o1[0], o1[1]); w.w = cvt_pk_bf16(o1[2], o1[3]);
                        *(u32x4*)(xn + off + bj * HALF) = w;
                        s += ((o0[0] * o0[0] + o0[1] * o0[1]) + (o0[2] * o0[2] + o0[3] * o0[3])) + ((o1[0] * o1[0] + o1[1] * o1[1]) + (o1[2] * o1[2] + o1[3] * o1[3])); }
                }
                if (MODE != 2) { s = sum_fq(s);
                    if (fq == 0) __hip_atomic_fetch_add(ss + row, s, __ATOMIC_RELAXED, __HIP_MEMORY_SCOPE_AGENT); }
                if (m & 1) asm volatile("" ::: "memory");
            }
    }
};

struct EpiDry {
    static constexpr bool PERM = false, AFTER_DRAIN = false; static constexpr int NST = 0;
    __device__ __forceinline__ void operator()(const f32x4 (&acc)[2][2][4][2], const Unit& u, int wr, int wc, int fr, int fq) const {
#pragma unroll
        for (int ai = 0; ai < 2; ++ai)
#pragma unroll
            for (int bj = 0; bj < 2; ++bj)
#pragma unroll
                for (int m = 0; m < 4; ++m)
#pragma unroll
                    for (int n = 0; n < 2; ++n) asm volatile("" :: "v"(acc[ai][bj][m][n]));
    }
};
template <class Epi, class Sched, bool ALIGN_EPI = false, bool SP2 = false>
__device__ __forceinline__ void gemm_phase(PG8_LAS unsigned char* lds, const Gemm g, const Sched& S, const Epi& E) {
    const int tid = threadIdx.x, wid = __builtin_amdgcn_readfirstlane(tid >> 6), lane = tid & 63, wr = wid >> 2, wc = wid & 3, fr = lane & 15, fq = lane >> 4;
    const int K = g.K, nt = K / BK;
    unsigned voffA[2], voffB[2];
#pragma unroll
    for (int i = 0; i < 2; ++i) { int R, C; stage_rc(tid * 16 + i * 8192, R, C); const int Rb = Epi::PERM ? ((R & ~31) + perm32(R & 31)) : R;
        voffA[i] = (unsigned)(R * K + C) * 2u; voffB[i] = (unsigned)(Rb * K + C) * 2u; }
    const size_t kstep = (size_t)(BK * 2);
    const size_t hstep = (size_t)HALF * K * 2;
    const size_t tstep = 2 * hstep;
    const unsigned ldsw = (unsigned)wid * 1024u;
    const int aoff = lds_byte(wr * 64 + fr, fq * 8), boff = lds_byte(wc * 32 + fr, fq * 8);
#define PG8_SA(b, h) (((b) * 2 + (h)) * HTB)
#define PG8_SB(b, h) ((4 + (b) * 2 + (h)) * HTB)
#define PG8_STAGE(bufoff, gbase, voff) do { _Pragma("unroll") for (int _i = 0; _i < 2; ++_i) \
        __builtin_amdgcn_global_load_lds((const unsigned*)((const char*)(gbase) + (voff)[_i]), (PG8_LAS unsigned*)(lds + (bufoff) + ldsw + _i * 8192), 16, 0, 0); } while (0)
#define PG8_LDA(dst, b, h) do { _Pragma("unroll") for (int m = 0; m < 4; ++m) _Pragma("unroll") for (int k = 0; k < 2; ++k) dst[m][k] = *(const PG8_LAS bf16x8*)(lds + PG8_SA(b, h) + aoff + m * 2048 + k * 1024); } while (0)
#define PG8_LDB(dst, b, h) do { _Pragma("unroll") for (int n = 0; n < 2; ++n) _Pragma("unroll") for (int k = 0; k < 2; ++k) dst[n][k] = *(const PG8_LAS bf16x8*)(lds + PG8_SB(b, h) + boff + n * 2048 + k * 1024); } while (0)
#define PG8_MMA(ai, bj, At, Bt) do { __builtin_amdgcn_s_setprio(1); _Pragma("unroll") for (int m = 0; m < 4; ++m) _Pragma("unroll") for (int n = 0; n < 2; ++n) _Pragma("unroll") for (int k = 0; k < 2; ++k) \
        acc[ai][bj][m][n] = __builtin_amdgcn_mfma_f32_16x16x32_bf16(Bt[n][k], At[m][k], acc[ai][bj][m][n], 0, 0, 0); __builtin_amdgcn_s_setprio(0); } while (0)
#define PG8_WAIT_V(n) asm volatile("s_waitcnt vmcnt(" #n ")" ::: "memory")
#define PG8_WAIT_L(n) asm volatile("s_waitcnt lgkmcnt(" #n ")" ::: "memory")
#define PG8_BAR __builtin_amdgcn_s_barrier()
#define PG8_SCHED __builtin_amdgcn_sched_barrier(0)
    Unit cur, nxt; int ui = 0;
    if (!S.next(0, cur)) return;
    f32x4 acc[2][2][4][2];
#pragma unroll
    for (int a = 0; a < 2; ++a)
#pragma unroll
        for (int b = 0; b < 2; ++b)
#pragma unroll
            for (int m = 0; m < 4; ++m)
#pragma unroll
                for (int n = 0; n < 2; ++n) acc[a][b][m][n] = (f32x4){0.f, 0.f, 0.f, 0.f};
    bf16x8 At[4][2], B0[2][2], B1[2][2];
    const char* cA = (const char*)g.A + (size_t)cur.pm * tstep; const char* cB = (const char*)g.Bt + (size_t)cur.pn * tstep;
    S.a_ready(cur);
    if constexpr (SP2) {
        PG8_STAGE(PG8_SB(0, 0), cB, voffB); PG8_STAGE(PG8_SB(0, 1), cB + hstep, voffB); PG8_STAGE(PG8_SA(0, 0), cA, voffA); PG8_STAGE(PG8_SA(0, 1), cA + hstep, voffA);
        if (wr == 1) PG8_BAR;
        PG8_WAIT_V(2); PG8_BAR;
        PG8_STAGE(PG8_SB(1, 0), cB + kstep, voffB); PG8_STAGE(PG8_SA(1, 0), cA + kstep, voffA); PG8_STAGE(PG8_SB(1, 1), cB + hstep + kstep, voffB);
        PG8_WAIT_V(6); PG8_BAR;
    } else {
        PG8_STAGE(PG8_SB(0, 0), cB, voffB); PG8_STAGE(PG8_SA(0, 0), cA, voffA); PG8_STAGE(PG8_SB(0, 1), cB + hstep, voffB); PG8_STAGE(PG8_SA(0, 1), cA + hstep, voffA);
        if (wr == 1) PG8_BAR;
        PG8_WAIT_V(4); PG8_BAR;
        PG8_STAGE(PG8_SB(1, 0), cB + kstep, voffB); PG8_STAGE(PG8_SA(1, 0), cA + kstep, voffA); PG8_STAGE(PG8_SB(1, 1), cB + hstep + kstep, voffB);
        PG8_WAIT_V(6); PG8_BAR;
    }
    for (;;) {
        const bool has_next = S.next(ui + 1, nxt);
        const char* nA = has_next ? (const char*)g.A + (size_t)nxt.pm * tstep : cA; const char* nB = has_next ? (const char*)g.Bt + (size_t)nxt.pn * tstep : cB;
        for (int t = 0; t < nt; t += 2) {
            const bool last = (t == nt - 2);
            const char* a1 = cA + (size_t)(t + 1) * kstep;
            const char* a2 = last ? nA : cA + (size_t)(t + 2) * kstep; const char* b2 = last ? nB : cB + (size_t)(t + 2) * kstep;
            const char* a3 = a2 + kstep; const char* b3 = b2 + kstep;
            if (last && has_next) S.a_ready(nxt);
            if constexpr (SP2) {
            PG8_LDB(B0, 0, 0); PG8_LDB(B1, 0, 1); PG8_SCHED; PG8_LDA(At, 0, 0); PG8_STAGE(PG8_SA(1, 1), a1 + hstep, voffA);
            PG8_WAIT_V(8); PG8_WAIT_L(0); PG8_BAR; PG8_MMA(0, 0, At, B0); PG8_MMA(0, 1, At, B1); PG8_BAR; PG8_SCHED;
            PG8_LDA(At, 0, 1); PG8_STAGE(PG8_SB(0, 0), b2, voffB); PG8_STAGE(PG8_SB(0, 1), b2 + hstep, voffB); PG8_STAGE(PG8_SA(0, 0), a2, voffA);
            PG8_WAIT_V(8); PG8_WAIT_L(0); PG8_BAR; PG8_MMA(1, 0, At, B0); PG8_MMA(1, 1, At, B1); PG8_BAR; PG8_SCHED;
            PG8_LDB(B0, 1, 0); PG8_LDB(B1, 1, 1); PG8_SCHED; PG8_LDA(At, 1, 0); PG8_STAGE(PG8_SA(0, 1), a2 + hstep, voffA);
            PG8_WAIT_V(8); PG8_WAIT_L(0); PG8_BAR; PG8_MMA(0, 0, At, B0); PG8_MMA(0, 1, At, B1); PG8_BAR; PG8_SCHED;
            PG8_LDA(At, 1, 1); PG8_STAGE(PG8_SB(1, 0), b3, voffB); PG8_STAGE(PG8_SB(1, 1), b3 + hstep, voffB); PG8_STAGE(PG8_SA(1, 0), a3, voffA);
            PG8_WAIT_V(8); PG8_WAIT_L(0); PG8_BAR; PG8_MMA(1, 0, At, B0); PG8_MMA(1, 1, At, B1); PG8_BAR; PG8_SCHED;
            } else {
            PG8_LDB(B0, 0, 0); PG8_SCHED; PG8_LDA(At, 0, 0); PG8_STAGE(PG8_SA(1, 1), a1 + hstep, voffA);
            PG8_WAIT_L(8); PG8_BAR; PG8_WAIT_L(0); PG8_MMA(0, 0, At, B0); PG8_BAR; PG8_SCHED;
            PG8_LDB(B1, 0, 1); PG8_STAGE(PG8_SB(0, 0), b2, voffB);
            PG8_BAR; PG8_WAIT_L(0); PG8_MMA(0, 1, At, B1); PG8_BAR;
            PG8_LDA(At, 0, 1); PG8_STAGE(PG8_SA(0, 0), a2, voffA);
            PG8_BAR; PG8_WAIT_L(0); PG8_MMA(1, 0, At, B0); PG8_BAR; PG8_SCHED;
            PG8_STAGE(PG8_SB(0, 1), b2 + hstep, voffB);
            PG8_WAIT_V(6); PG8_BAR; PG8_MMA(1, 1, At, B1); PG8_BAR;
            PG8_LDB(B0, 1, 0); PG8_SCHED; PG8_LDA(At, 1, 0); PG8_STAGE(PG8_SA(0, 1), a2 + hstep, voffA);
            PG8_WAIT_L(8); PG8_BAR; PG8_WAIT_L(0); PG8_MMA(0, 0, At, B0); PG8_BAR; PG8_SCHED;
            PG8_LDB(B1, 1, 1); PG8_STAGE(PG8_SB(1, 0), b3, voffB);
            PG8_BAR; PG8_WAIT_L(0); PG8_MMA(0, 1, At, B1); PG8_BAR;
            PG8_LDA(At, 1, 1); PG8_STAGE(PG8_SA(1, 0), a3, voffA);
            PG8_BAR; PG8_WAIT_L(0); PG8_MMA(1, 0, At, B0); PG8_BAR; PG8_SCHED;
            PG8_STAGE(PG8_SB(1, 1), b3 + hstep, voffB);
            PG8_WAIT_V(6); PG8_BAR; PG8_MMA(1, 1, At, B1); PG8_BAR;
            }
        }
        if constexpr (ALIGN_EPI) { if (wr == 0) PG8_BAR; }
        if constexpr (!Epi::AFTER_DRAIN) { E(acc, cur, wr, wc, fr, fq); S.done(cur); }
        if (!has_next) break;
#pragma unroll
        for (int a = 0; a < 2; ++a)
#pragma unroll
            for (int b = 0; b < 2; ++b)
#pragma unroll
                for (int m = 0; m < 4; ++m)
#pragma unroll
                    for (int n = 0; n < 2; ++n) acc[a][b][m][n] = (f32x4){0.f, 0.f, 0.f, 0.f};
        cur = nxt; cA = nA; cB = nB; ++ui;
        if constexpr (ALIGN_EPI) { if (wr == 1) PG8_BAR; }
    }
    PG8_WAIT_V(0);
    if constexpr (!ALIGN_EPI) { if (wr == 0) PG8_BAR; }
    PG8_BAR;
    if constexpr (Epi::AFTER_DRAIN) { E.fused(acc, cur, wr, wc, fr, fq, lds, wid, lane); S.done(cur); }
#undef PG8_SA
#undef PG8_SB
#undef PG8_STAGE
#undef PG8_LDA
#undef PG8_LDB
#undef PG8_MMA
#undef PG8_WAIT_V
#undef PG8_WAIT_L
#undef PG8_BAR
#undef PG8_SCHED
}
}
namespace att {
typedef unsigned short bf16_t;
typedef short bf16x8 __attribute__((ext_vector_type(8)));
typedef short s16x4 __attribute__((ext_vector_type(4)));
typedef float f32x16 __attribute__((ext_vector_type(16)));
typedef float f32x4 __attribute__((ext_vector_type(4)));
typedef unsigned u32x4 __attribute__((ext_vector_type(4)));
#define ALDS __attribute__((address_space(3)))
typedef ALDS const char* lds_cptr;
typedef ALDS char* lds_ptr;
typedef short v4i16_t __attribute__((ext_vector_type(4)));
constexpr int SEQ = 2048, DM = 1024, SLOTB = 8192;
constexpr float LOG2E = 1.4426950408889634f;
__device__ __forceinline__ int crow(int r, int hi) { return (r & 3) + 8 * (r >> 2) + 4 * hi; }
#define ATT_SBAR() __builtin_amdgcn_sched_barrier(0)
#define ATT_WAIT_BAR(N) asm volatile("s_waitcnt vmcnt(" #N ") lgkmcnt(0)\n\ts_barrier" ::: "memory")
#define ATT_LGKM_BAR() asm volatile("s_waitcnt lgkmcnt(0)\n\ts_barrier" ::: "memory")
__device__ __forceinline__ void glds16(const void* gsrc, unsigned lds_dst) { unsigned keep;
    asm volatile("s_mov_b32 %0, m0\n\ts_mov_b32 m0, %2\n\ts_nop 0\n\tglobal_load_lds_dwordx4 %1, off\n\ts_mov_b32 m0, %0" : "=&s"(keep) : "v"(gsrc), "s"(lds_dst) : "memory"); }
typedef float f32x2_t __attribute__((ext_vector_type(2))); typedef __bf16 bf16x2_t __attribute__((ext_vector_type(2)));
__device__ __forceinline__ unsigned cvtpk_s(float lo, float hi) { f32x2_t v = {lo, hi}; bf16x2_t b = __builtin_convertvector(v, bf16x2_t); return __builtin_bit_cast(unsigned, b); }

__device__ __forceinline__ void qkt2(f32x16& p0, f32x16& p1, lds_cptr kp, const bf16x8* qr, const f32x16& c0, const f32x16& c1) {
#pragma unroll
    for (int d0 = 0; d0 < 4; ++d0) {
        const bf16x8 b0 = *(const ALDS bf16x8*)(kp + d0 * 2048);
        const bf16x8 b1 = *(const ALDS bf16x8*)(kp + d0 * 2048 + 512);
        if (d0 == 0) { p0 = __builtin_amdgcn_mfma_f32_32x32x16_bf16(b0, qr[0], c0, 0, 0, 0); p1 = __builtin_amdgcn_mfma_f32_32x32x16_bf16(b1, qr[0], c1, 0, 0, 0); }
        else { p0 = __builtin_amdgcn_mfma_f32_32x32x16_bf16(b0, qr[d0], p0, 0, 0, 0); p1 = __builtin_amdgcn_mfma_f32_32x32x16_bf16(b1, qr[d0], p1, 0, 0, 0); }
    }
}
__device__ __forceinline__ void pv(f32x16* o, int vb, bf16x8 pa0, bf16x8 pa1, bf16x8 pa2, bf16x8 pa3) {
#pragma unroll
    for (int d0 = 0; d0 < 2; ++d0) { s16x4 lo[4], hi[4];
#pragma unroll
        for (int ks = 0; ks < 4; ++ks) {
            asm volatile("ds_read_b64_tr_b16 %0,%1 offset:%c2" : "=&v"(lo[ks]) : "v"(vb), "i"(d0 * 4096 + ks * 1024) : "memory");
            asm volatile("ds_read_b64_tr_b16 %0,%1 offset:%c2" : "=&v"(hi[ks]) : "v"(vb), "i"(d0 * 4096 + ks * 1024 + 512) : "memory"); }
        asm volatile("s_waitcnt lgkmcnt(0)" ::: "memory"); ATT_SBAR();
#define ATT_PK(k) (bf16x8){lo[k][0], lo[k][1], lo[k][2], lo[k][3], hi[k][0], hi[k][1], hi[k][2], hi[k][3]}
        o[d0] = __builtin_amdgcn_mfma_f32_32x32x16_bf16(pa0, ATT_PK(0), o[d0], 0, 0, 0);
        o[d0] = __builtin_amdgcn_mfma_f32_32x32x16_bf16(pa1, ATT_PK(1), o[d0], 0, 0, 0);
        o[d0] = __builtin_amdgcn_mfma_f32_32x32x16_bf16(pa2, ATT_PK(2), o[d0], 0, 0, 0);
        o[d0] = __builtin_amdgcn_mfma_f32_32x32x16_bf16(pa3, ATT_PK(3), o[d0], 0, 0, 0);
#undef ATT_PK
    }
}
__device__ __forceinline__ void tile_body(f32x16* o, float& l, lds_cptr kp, int vb, const bf16x8* qr, const f32x16& c0, const f32x16& c1) {
    f32x16 p0, p1; qkt2(p0, p1, kp, qr, c0, c1);
#pragma unroll
    for (int r = 0; r < 16; ++r) { p0[r] = __builtin_amdgcn_exp2f(p0[r]); p1[r] = __builtin_amdgcn_exp2f(p1[r]); }
    float s0 = 0.f, s1 = 0.f;
#pragma unroll
    for (int r = 0; r < 16; ++r) { s0 += p0[r]; s1 += p1[r]; }
    l += s0 + s1;
    u32x4 pw0, pw1, pw2, pw3;
    pw0 = (u32x4){cvtpk_s(p0[0], p0[1]), cvtpk_s(p0[2], p0[3]), cvtpk_s(p0[4], p0[5]), cvtpk_s(p0[6], p0[7])};
    pw1 = (u32x4){cvtpk_s(p0[8], p0[9]), cvtpk_s(p0[10], p0[11]), cvtpk_s(p0[12], p0[13]), cvtpk_s(p0[14], p0[15])};
    pw2 = (u32x4){cvtpk_s(p1[0], p1[1]), cvtpk_s(p1[2], p1[3]), cvtpk_s(p1[4], p1[5]), cvtpk_s(p1[6], p1[7])};
    pw3 = (u32x4){cvtpk_s(p1[8], p1[9]), cvtpk_s(p1[10], p1[11]), cvtpk_s(p1[12], p1[13]), cvtpk_s(p1[14], p1[15])};
    pv(o, vb, __builtin_bit_cast(bf16x8, pw0), __builtin_bit_cast(bf16x8, pw1), __builtin_bit_cast(bf16x8, pw2), __builtin_bit_cast(bf16x8, pw3));
}
__device__ __forceinline__ void store_o(const f32x16* o, float l, ALDS float* wsf, ALDS bf16_t* stg, bf16_t* Ow, int lane, int r32, int hi) {
    { auto rr = __builtin_amdgcn_permlane32_swap(__float_as_uint(l), __float_as_uint(l), false, false); l = __uint_as_float(rr[0]) + __uint_as_float(rr[1]); }
    if (hi == 0) wsf[32 + r32] = l;
    asm volatile("s_waitcnt lgkmcnt(0)" ::: "memory");
    float rli[16];
#pragma unroll
    for (int r = 0; r < 16; ++r) rli[r] = __builtin_amdgcn_rcpf(wsf[32 + crow(r, hi)]);
#pragma unroll
    for (int r = 0; r < 16; ++r) { const int orow = crow(r, hi);
#pragma unroll
        for (int d0 = 0; d0 < 2; ++d0) { const float v = o[d0][r] * rli[r]; stg[orow * 64 + d0 * 32 + r32] = (bf16_t)(cvtpk_s(v, v) & 0xffffu); } }
    asm volatile("s_waitcnt lgkmcnt(0)" ::: "memory");
#pragma unroll
    for (int i = 0; i < 4; ++i) { const int row = i * 8 + (lane >> 3), ch = lane & 7; const u32x4 v = *(const ALDS u32x4*)(stg + row * 64 + ch * 8); *(u32x4*)(Ow + (long)row * DM + ch * 8) = v; }
    asm volatile("s_waitcnt lgkmcnt(0)" ::: "memory");
}

__device__ __forceinline__ void store_o2(const f32x16* o, const f32x16& lsum, ALDS bf16_t* stg, bf16_t* Ow, int lane, int r32, int hi) {
#pragma unroll
    for (int r = 0; r < 16; ++r) { const int orow = crow(r, hi); const float rl = __builtin_amdgcn_rcpf(lsum[r]);
#pragma unroll
        for (int d0 = 0; d0 < 2; ++d0) { const float v = o[d0][r] * rl; stg[orow * 64 + d0 * 32 + r32] = (bf16_t)(cvtpk_s(v, v) & 0xffffu); } }
    asm volatile("s_waitcnt lgkmcnt(0)" ::: "memory");
#pragma unroll
    for (int i = 0; i < 4; ++i) { const int row = i * 8 + (lane >> 3), ch = lane & 7; const u32x4 v = *(const ALDS u32x4*)(stg + row * 64 + ch * 8); *(u32x4*)(Ow + (long)row * DM + ch * 8) = v; }
    asm volatile("s_waitcnt lgkmcnt(0)" ::: "memory");
}

constexpr int FX_K = 0, FX_V = 3 * SLOTB, FX_WS = 6 * SLOTB, FX_OST = FX_WS + 2048, FX_C2 = FX_OST + 8 * 4096, FX_WT = FX_C2 + SEQ * 4, FX_KA = FX_WT + 64, FX_Z = FX_KA + SEQ * 16, FX_END = FX_Z + 64;
__device__ __forceinline__ void kload8(bf16x8* kf, lds_cptr kp) {
    kf[0] = *(const ALDS bf16x8*)(kp);        kf[1] = *(const ALDS bf16x8*)(kp + 512);
    kf[2] = *(const ALDS bf16x8*)(kp + 2048); kf[3] = *(const ALDS bf16x8*)(kp + 2560);
    kf[4] = *(const ALDS bf16x8*)(kp + 4096); kf[5] = *(const ALDS bf16x8*)(kp + 4608);
    kf[6] = *(const ALDS bf16x8*)(kp + 6144); kf[7] = *(const ALDS bf16x8*)(kp + 6656);
}
__device__ __forceinline__ void kload2(bf16x8* kf, lds_cptr kp, int j) { kf[2 * j] = *(const ALDS bf16x8*)(kp + j * 2048); kf[2 * j + 1] = *(const ALDS bf16x8*)(kp + j * 2048 + 512); }
__device__ __forceinline__ s16x4 vtr(lds_cptr p) { return __builtin_bit_cast(s16x4, __builtin_amdgcn_ds_read_tr16_b64_v4i16((ALDS v4i16_t*)p)); }
__device__ __forceinline__ void fox_prepare(int b, int h, const float* logf2, lds_ptr shm) {
    int tid = threadIdx.x; asm volatile("" : "+v"(tid));
    const int lane = tid & 63; const int wid = __builtin_amdgcn_readfirstlane(tid >> 6);
    ALDS float* c2s = (ALDS float*)(shm + FX_C2); ALDS float* wtot = (ALDS float*)(shm + FX_WT);
    const float* lf = logf2 + (size_t)(b * 16 + h) * SEQ;
    const f32x4 v = *(const f32x4*)(lf + 4 * tid);
    const float a0 = v[0], a1 = a0 + v[1], a2 = a1 + v[2], a3 = a2 + v[3];
    float x = a3;
#pragma unroll
    for (int ofs = 1; ofs < 64; ofs <<= 1) { const int src = lane >= ofs ? lane - ofs : lane; const float y = __uint_as_float(__builtin_amdgcn_ds_bpermute(src << 2, __float_as_uint(x))); if (lane >= ofs) x += y; }
    if (lane == 63) wtot[wid] = x;
    ATT_WAIT_BAR(0);
    float off = 0.f;
#pragma unroll
    for (int w = 0; w < 8; ++w) { const float tw = wtot[w]; if (w < wid) off += tw; }
    const float ex = off + x - a3;
    *(ALDS f32x4*)(c2s + 4 * tid) = (f32x4){ex + a0, ex + a1, ex + a2, ex + a3};
    { const float cc[4] = {ex + a0, ex + a1, ex + a2, ex + a3};
#pragma unroll
      for (int j = 0; j < 4; ++j) { const float v0 = -cc[j];
          const unsigned h1 = cvtpk_s(v0, 0.f) & 0xffffu; const float r1 = v0 - __uint_as_float(h1 << 16);
          const unsigned h2 = cvtpk_s(r1, 0.f) & 0xffffu; const float r2 = r1 - __uint_as_float(h2 << 16);
          const unsigned h3 = cvtpk_s(r2, 0.f) & 0xffffu;
          *(ALDS u32x4*)(shm + FX_KA + (4 * tid + j) * 16) = (u32x4){h1 | (h2 << 16), h3 | 0x3F800000u, 0x3F803F80u, 0u}; }
      if (tid < 4) *(ALDS unsigned*)(shm + FX_Z + 4 * tid) = 0u; }
    ATT_WAIT_BAR(0);
}
constexpr long PNL = 1048576, SLT = 262144;
__device__ __forceinline__ void fox_cu(int h, int sel, bf16_t* PB, lds_ptr shm, float nB2) {
#define QBOF(i) (sel == 0 ? ((i) == 0 ? 7 : (i) == 1 ? 4 : (i) == 2 ? 3 : 0) : ((i) == 0 ? 6 : (i) == 1 ? 5 : (i) == 2 ? 2 : 1))
#define SLOT(t) ((((s0) + (t)) % 3) * SLOTB)
#define LOADQ(dst, qb_) do { const bf16_t* Qw_ = PB + (qb_) * PNL + (long)(wid * 32) * DM + h * 64; _Pragma("unroll") for (int d0 = 0; d0 < 4; ++d0) dst[d0] = *(const bf16x8*)(Qw_ + (long)r32 * DM + d0 * 16 + hi * 8); } while (0)
    int s0 = 0;
    bf16x8 qr[4];
    for (int ui = 0; ui < 4; ++ui) {
    int tid = threadIdx.x; asm volatile("" : "+v"(tid));
    const int lane = tid & 63, r32 = lane & 31, hi = lane >> 5; const int wid = __builtin_amdgcn_readfirstlane(tid >> 6);
    const bf16_t* Kh = PB + SLT + h * 64; const bf16_t* Vh = PB + 2 * SLT + h * 64;
    const unsigned lds0 = (unsigned)(uintptr_t)shm;
    ALDS float* wsf = (ALDS float*)(shm + FX_WS) + wid * 64;
    const ALDS float* c2s = (const ALDS float*)(shm + FX_C2);
    const bf16_t* ksrc = Kh + (long)lane * DM + wid * 8;
    const bf16_t* vsrc = Vh + (long)(16 * (wid & 3) + (lane >> 2)) * DM + (wid >> 2) * 32 + (lane & 3) * 8;
    const unsigned kdst = lds0 + FX_K + wid * 1024, vdst = lds0 + FX_V + wid * 1024;
#define TOFF(t) ((long)((t) >> 2) * PNL + (long)((t) & 3) * 64 * DM)
#define DMA_K(t, slot) glds16(ksrc + TOFF(t), (unsigned)__builtin_amdgcn_readfirstlane(kdst + (slot)))
#define DMA_V(t, slot) glds16(vsrc + TOFF(t), (unsigned)__builtin_amdgcn_readfirstlane(vdst + (slot)))
    const int vb0 = (int)(lds0 + FX_V) + ((lane >> 4) & 1) * 32 + (lane & 3) * 8 + (4 * hi + ((lane & 15) >> 2)) * 64;
    const lds_cptr shm3 = (lds_cptr)shm; const lds_cptr kp0 = shm3 + FX_K + hi * 1024 + r32 * 16; const lds_cptr vp0 = shm3 + FX_V + ((lane >> 4) & 1) * 32 + (lane & 3) * 8 + (4 * hi + ((lane & 15) >> 2)) * 64;
    bf16x8 kf[8], kaf[2];
    const lds_cptr kab = hi ? shm3 + FX_Z : shm3 + FX_KA + r32 * 16; const int kats = hi ? 0 : 1024, kah = hi ? 0 : 512;
#define KALD(t) do { kaf[0] = *(const ALDS bf16x8*)(kab + (t) * kats); kaf[1] = *(const ALDS bf16x8*)(kab + (t) * kats + kah); } while (0)
    if (ui == 0) { DMA_K(0, SLOT(0)); DMA_V(0, SLOT(0)); DMA_K(1, SLOT(1)); LOADQ(qr, QBOF(0)); DMA_K(2, SLOT(2)); }
    const int qb = QBOF(ui), q0 = qb * 256;
    const int NT = (q0 + 256) / 64;
    f32x16 lacc, o[2];
    bf16x8 ones; { _Pragma("unroll") for (int j = 0; j < 8; ++j) ones[j] = (short)0x3F80; } asm volatile("" : "+v"(ones));
#pragma unroll
    for (int r = 0; r < 16; ++r) { o[0][r] = 0.f; o[1][r] = 0.f; lacc[r] = 0.f; }
    const int qrel = wid * 32 + r32;
    bf16x8 qaug;
    { const float cq = c2s[q0 + qrel] + nB2;
      const unsigned g1 = cvtpk_s(cq, 0.f) & 0xffffu; const float r1 = cq - __uint_as_float(g1 << 16);
      const unsigned g2 = cvtpk_s(r1, 0.f) & 0xffffu; const float r2 = r1 - __uint_as_float(g2 << 16);
      const unsigned g3 = cvtpk_s(r2, 0.f) & 0xffffu;
      qaug = __builtin_bit_cast(bf16x8, (u32x4){0x3F803F80u, 0x3F80u | (g1 << 16), g2 | (g3 << 16), 0u}); }
    const f32x16 zero16 = (f32x16){0.f, 0.f, 0.f, 0.f, 0.f, 0.f, 0.f, 0.f, 0.f, 0.f, 0.f, 0.f, 0.f, 0.f, 0.f, 0.f};
#define THR(t) ((t) >= NT - 4 ? qrel - 4 * hi - 64 * ((t) - (NT - 4)) : 4096)
#define CMASK4(X, B, G, thr_) do { float tf_ = (float)((thr_) + 1); asm volatile("" : "+v"(tf_));   \
      _Pragma("unroll") for (int e = 0; e < 4; ++e) X[(B) + e] *= __builtin_fminf(__builtin_fmaxf(tf_ - (float)(8 * ((G) & 3) + 32 * ((G) >> 2) + e), 0.f), 1.f); } while (0)
    f32x16 pA0, pA1, pB0, pB1;
    int sl_prev = SLOT(0), sl_cur = SLOT(0), sl_next = SLOT(1);
#define ROT() do { sl_prev = sl_cur; sl_cur = sl_next; sl_next = (sl_next == 2 * SLOTB) ? 0 : sl_next + SLOTB; } while (0)
    ATT_WAIT_BAR(3);
    KALD(0);
    { const f32x16 d0_ = __builtin_amdgcn_mfma_f32_32x32x16_bf16(kaf[0], qaug, zero16, 0, 0, 0), d1_ = __builtin_amdgcn_mfma_f32_32x32x16_bf16(kaf[1], qaug, zero16, 0, 0, 0); qkt2(pA0, pA1, kp0 + SLOT(0), qr, d0_, d1_); }
#pragma unroll
    for (int r = 0; r < 16; ++r) { pA0[r] = __builtin_amdgcn_exp2f(pA0[r]); pA1[r] = __builtin_amdgcn_exp2f(pA1[r]); }
    { const int thr0 = THR(0);
#pragma unroll
      for (int g = 0; g < 4; ++g) { CMASK4(pA0, 4 * g, g, thr0); CMASK4(pA1, 4 * g, 4 + g, thr0); } }
    ATT_WAIT_BAR(0);
    DMA_K(3, SLOT(0)); DMA_V(1, SLOT(1));
    ROT();
    kload8(kf, kp0 + sl_cur); KALD(1);
    ATT_WAIT_BAR(2);
    s16x4 vlo[8], vhi[8]; u32x4 pw0, pw1, pw2, pw3;
#define PKW(P, B) cvtpk_s(P[B], P[B + 1])
#define PAF(k) __builtin_bit_cast(bf16x8, pw##k)
#define VFR(i) (bf16x8){vlo[i][0], vlo[i][1], vlo[i][2], vlo[i][3], vhi[i][0], vhi[i][1], vhi[i][2], vhi[i][3]}
#define PIN(x) asm volatile("" : "+v"(x))
#define MFMA32(a, b, c) __builtin_amdgcn_mfma_f32_32x32x16_bf16(a, b, c, 0, 0, 0)
#define GAPA(MF, A0, A1, A2, A3, W0, W1, PW) do { MF; W0; W1; PIN(PW); ATT_SBAR(); } while (0)
#define EX(v) __builtin_amdgcn_exp2f(v)
#define GAPB(MF, X, B, BAND, G) do { MF; X[B] = EX(X[B]); X[B + 1] = EX(X[B + 1]); X[B + 2] = EX(X[B + 2]); X[B + 3] = EX(X[B + 3]); if (BAND) CMASK4(X, B, G, thr_); PIN(X); ATT_SBAR(); } while (0)
#define VRD(i) do { vlo[i] = vtr(vp_ + (((i) >> 2) * 4096 + ((i) & 3) * 1024)); vhi[i] = vtr(vp_ + (((i) >> 2) * 4096 + ((i) & 3) * 1024 + 512)); } while (0)
#define KRD(G, j) do { if (G) { kload2(kf, kp0 + sl_next, j); ATT_SBAR(); } } while (0)
#define STEP(C0, C1, P0, P1, t, GK, GV, GL, BAND) do { ATT_SBAR(); \
    const lds_cptr vp_ = vp0 + sl_prev; \
    C0 = MFMA32(kaf[0], qaug, zero16); C1 = MFMA32(kaf[1], qaug, zero16); \
    VRD(0); ATT_SBAR(); \
    GAPA(C0 = MFMA32(kf[0], qr[0], C0), P0[2], P0[3], P0[4], P0[5],     pw0[0] = PKW(P0, 0), pw0[1] = PKW(P0, 2), pw0); \
    VRD(4); ATT_SBAR(); GAPA(C1 = MFMA32(kf[1], qr[0], C1), P0[6], P0[7], P0[8], P0[9],     pw0[2] = PKW(P0, 4), pw0[3] = PKW(P0, 6), pw0); \
    VRD(1); ATT_SBAR(); GAPA(C0 = MFMA32(kf[2], qr[1], C0),  P0[10], P0[11], P0[12], P0[13], pw1[0] = PKW(P0, 8), pw1[1] = PKW(P0, 10), pw1); \
    VRD(5); ATT_SBAR(); GAPA(C1 = MFMA32(kf[3], qr[1], C1),  P0[14], P0[15], P1[0], P1[1],   pw1[2] = PKW(P0, 12), pw1[3] = PKW(P0, 14), pw1); \
    VRD(2); ATT_SBAR(); GAPA(C0 = MFMA32(kf[4], qr[2], C0),  P1[2], P1[3], P1[4], P1[5],     pw2[0] = PKW(P1, 0), pw2[1] = PKW(P1, 2), pw2); \
    VRD(6); ATT_SBAR(); GAPA(C1 = MFMA32(kf[5], qr[2], C1),  P1[6], P1[7], P1[8], P1[9],     pw2[2] = PKW(P1, 4), pw2[3] = PKW(P1, 6), pw2); \
    VRD(3); ATT_SBAR(); GAPA(C0 = MFMA32(kf[6], qr[3], C0),  P1[10], P1[11], P1[12], P1[13], pw3[0] = PKW(P1, 8), pw3[1] = PKW(P1, 10), pw3); \
    VRD(7); ATT_SBAR(); GAPA(C1 = MFMA32(kf[7], qr[3], C1),  P1[14], P1[15], 0.f, 0.f,       pw3[2] = PKW(P1, 12), pw3[3] = PKW(P1, 14), pw3); \
    if (GK) { DMA_K((t) + 3, sl_cur); } if (GV) { DMA_V((t) + 1, sl_next); } \
    const int thr_ = (BAND) ? THR(t) : 0; \
    ATT_SBAR(); \
    GAPB(o[0] = MFMA32(PAF(0), VFR(0), o[0]), C0, 0, BAND, 0); \
    GAPB(o[1] = MFMA32(PAF(0), VFR(4), o[1]); lacc = MFMA32(PAF(0), ones, lacc), C0, 4, BAND, 1); \
    KRD(GL, 0); GAPB(o[0] = MFMA32(PAF(1), VFR(1), o[0]), C0, 8, BAND, 2); \
    KRD(GL, 1); GAPB(o[1] = MFMA32(PAF(1), VFR(5), o[1]); lacc = MFMA32(PAF(1), ones, lacc), C0, 12, BAND, 3); \
    KRD(GL, 2); GAPB(o[0] = MFMA32(PAF(2), VFR(2), o[0]), C1, 0, BAND, 4); \
    KRD(GL, 3); GAPB(o[1] = MFMA32(PAF(2), VFR(6), o[1]); lacc = MFMA32(PAF(2), ones, lacc), C1, 4, BAND, 5); \
    if (GL) { KALD((t) + 1); ATT_SBAR(); } GAPB(o[0] = MFMA32(PAF(3), VFR(3), o[0]), C1, 8, BAND, 6); \
    GAPB(o[1] = MFMA32(PAF(3), VFR(7), o[1]); lacc = MFMA32(PAF(3), ones, lacc), C1, 12, BAND, 7); \
    } while (0)
    int t = 1;
    for (; t + 5 < NT; t += 2) {
        STEP(pB0, pB1, pA0, pA1, t, true, true, true, false);     ATT_WAIT_BAR(2); ROT();
        STEP(pA0, pA1, pB0, pB1, t + 1, true, true, true, false); ATT_WAIT_BAR(2); ROT();
    }
#define ENDW(tt) do { if ((tt) + 3 < NT) { ATT_WAIT_BAR(2); } else if ((tt) + 2 < NT) { ATT_WAIT_BAR(1); } else { ATT_WAIT_BAR(0); } } while (0)
    for (; t + 1 < NT; t += 2) {
        STEP(pB0, pB1, pA0, pA1, t, (t + 3 < NT), (t + 1 < NT), (t + 1 < NT), true);         ENDW(t);     ROT();
        STEP(pA0, pA1, pB0, pB1, t + 1, (t + 4 < NT), (t + 2 < NT), (t + 2 < NT), true);     ENDW(t + 1); ROT();
    }
    STEP(pB0, pB1, pA0, pA1, NT - 1, false, false, false, true);
    bf16x8 qn[4];
    const int s0n = (s0 + NT) % 3;
    if (ui < 3) { const int s0k = s0; s0 = s0n; DMA_K(0, SLOT(0)); DMA_V(0, SLOT(0)); DMA_K(1, SLOT(1)); LOADQ(qn, QBOF(ui + 1)); DMA_K(2, SLOT(2)); s0 = s0k; }
    {
      pw0 = (u32x4){PKW(pB0, 0), PKW(pB0, 2), PKW(pB0, 4), PKW(pB0, 6)}; pw1 = (u32x4){PKW(pB0, 8), PKW(pB0, 10), PKW(pB0, 12), PKW(pB0, 14)};
      pw2 = (u32x4){PKW(pB1, 0), PKW(pB1, 2), PKW(pB1, 4), PKW(pB1, 6)}; pw3 = (u32x4){PKW(pB1, 8), PKW(pB1, 10), PKW(pB1, 12), PKW(pB1, 14)};
      ATT_SBAR(); pv(o, vb0 + sl_cur, PAF(0), PAF(1), PAF(2), PAF(3));
      lacc = MFMA32(PAF(0), ones, lacc); lacc = MFMA32(PAF(1), ones, lacc); lacc = MFMA32(PAF(2), ones, lacc); lacc = MFMA32(PAF(3), ones, lacc); }
    store_o2(o, lacc, (ALDS bf16_t*)(shm + FX_OST) + wid * 2048, PB + qb * PNL + 3 * SLT + (long)(wid * 32) * DM + h * 64, lane, r32, hi);
    ATT_LGKM_BAR();
    if (ui < 3) {
#pragma unroll
        for (int d0 = 0; d0 < 4; ++d0) qr[d0] = qn[d0];
    }
    s0 = s0n;
    }
#undef QBOF
#undef SLOT
#undef LOADQ
#undef DMA_K
#undef DMA_V
#undef TOFF
#undef KALD
#undef THR
#undef CMASK4

#undef ROT
#undef PKW
#undef PAF
#undef VFR
#undef PIN
#undef MFMA32
#undef GAPA
#undef EX
#undef GAPB
#undef VRD
#undef KRD
#undef STEP
#undef ENDW
}

__device__ __forceinline__ int t5_bucket(int n) {
    if (n < 16) return n;
    int b = 16;
    b += (n >= 19); b += (n >= 21); b += (n >= 24); b += (n >= 27); b += (n >= 31); b += (n >= 35); b += (n >= 40); b += (n >= 46);
    b += (n >= 52); b += (n >= 59); b += (n >= 67); b += (n >= 77); b += (n >= 87); b += (n >= 99); b += (n >= 113);
    return b;
}
constexpr int SW_K = 0, SW_V = 4 * SLOTB, SW_WS = 8 * SLOTB, SW_OST = SW_WS + 2048, SW_TBL = SW_OST + 8 * 4096, SW_MB = SW_TBL + 8 * 384 * 4, SW_END = SW_MB + 64;
template <int R0 = 0, int R1 = 4>
__device__ __forceinline__ void swa_unit(int b, int kvh, int qblk, const bf16_t* Q, const bf16_t* KV, bf16_t* O, const float* sinks, const float* relb, lds_ptr shm, float qkb) {
    int tid = threadIdx.x; asm volatile("" : "+v"(tid));
    const int lane = tid & 63, r32 = lane & 31, hi = lane >> 5; const int wid = __builtin_amdgcn_readfirstlane(tid >> 6);
    const long rowbase = (long)b * SEQ; const int q0 = qblk * 128; const int jt0 = qblk == 0 ? 2 : 0;
    const unsigned lds0 = (unsigned)(uintptr_t)shm;
    const long band0 = rowbase + q0 - 128;
    {
        const long krow = band0 + lane, vrow = band0 + 16 * (wid & 3) + (lane >> 2);
        for (int jt = jt0; jt < 4; ++jt) {
            glds16(KV + (krow + 64 * jt) * 256 + kvh * 64 + wid * 8, (unsigned)__builtin_amdgcn_readfirstlane(lds0 + SW_K + jt * SLOTB + wid * 1024));
            glds16(KV + (vrow + 64 * jt) * 256 + 128 + kvh * 64 + (wid >> 2) * 32 + (lane & 3) * 8, (unsigned)__builtin_amdgcn_readfirstlane(lds0 + SW_V + jt * SLOTB + wid * 1024));
        }
    }
#define SW_LOADQ(dst, round_) do { const bf16_t* Qw_ = Q + (rowbase + q0 + 32 * (wid & 3)) * DM + (kvh * 8 + 2 * (round_) + (wid >> 2)) * 64; \
      _Pragma("unroll") for (int d0 = 0; d0 < 4; ++d0) dst[d0] = *(const bf16x8*)(Qw_ + (long)r32 * DM + d0 * 16 + hi * 8); } while (0)
    bf16x8 qc[4], qn[4];
    SW_LOADQ(qc, R0);
    ALDS float* tbl = (ALDS float*)(shm + SW_TBL); ALDS float* mb = (ALDS float*)(shm + SW_MB);
    if (tid < 8) { const int hh = kvh * 8 + tid; float m = relb[hh];
        for (int bk = 1; bk < 32; ++bk) m = fmaxf(m, relb[bk * 16 + hh]);
        mb[tid] = m * LOG2E; }
    ATT_LGKM_BAR();
    for (int idx = tid; idx < 2 * (R1 - R0) * 384; idx += 512) { const int gl_ = idx / 384, g = 2 * R0 + gl_, di = idx - gl_ * 384, dist = di - 127;
        float v = -INFINITY; if (dist >= 0 && dist < 128) v = relb[t5_bucket(dist) * 16 + kvh * 8 + g] * LOG2E - (qkb + mb[g]);
        tbl[g * 384 + di] = v; }
    ATT_WAIT_BAR(0);
    const int wq = wid & 3;
    ALDS float* wsf = (ALDS float*)(shm + SW_WS) + wid * 64;
    const lds_cptr kp0 = (lds_cptr)shm + SW_K + hi * 1024 + r32 * 16;
    const lds_cptr vp0 = (lds_cptr)shm + SW_V + ((lane >> 4) & 1) * 32 + (lane & 3) * 8 + (4 * hi + ((lane & 15) >> 2)) * 64;
    const int jbase = wq >> 1;
#define SW_SCORES(p0, p1, jt_) do { f32x16 c0_, c1_; const ALDS float* tj_ = tb - 64 * (jt_); \
        _Pragma("unroll") for (int r = 0; r < 16; ++r) { c0_[r] = tj_[-((r & 3) + 8 * (r >> 2))]; c1_[r] = tj_[-((r & 3) + 8 * (r >> 2)) - 32]; } \
        qkt2(p0, p1, kp0 + (jt_) * SLOTB, qc, c0_, c1_); } while (0)
#define SW_SOFT(p0, p1) do { \
        _Pragma("unroll") for (int r = 0; r < 16; ++r) { p0[r] = __builtin_amdgcn_exp2f(p0[r]); p1[r] = __builtin_amdgcn_exp2f(p1[r]); } \
        pw[0] = (u32x4){cvtpk_s(p0[0], p0[1]), cvtpk_s(p0[2], p0[3]), cvtpk_s(p0[4], p0[5]), cvtpk_s(p0[6], p0[7])}; \
        pw[1] = (u32x4){cvtpk_s(p0[8], p0[9]), cvtpk_s(p0[10], p0[11]), cvtpk_s(p0[12], p0[13]), cvtpk_s(p0[14], p0[15])}; \
        pw[2] = (u32x4){cvtpk_s(p1[0], p1[1]), cvtpk_s(p1[2], p1[3]), cvtpk_s(p1[4], p1[5]), cvtpk_s(p1[6], p1[7])}; \
        pw[3] = (u32x4){cvtpk_s(p1[8], p1[9]), cvtpk_s(p1[10], p1[11]), cvtpk_s(p1[12], p1[13]), cvtpk_s(p1[14], p1[15])}; } while (0)
#define SW_PV(jt_) do { const lds_cptr vp_ = vp0 + (jt_) * SLOTB; \
        _Pragma("unroll") for (int d0 = 0; d0 < 2; ++d0) { s16x4 vl[4], vh[4]; \
            _Pragma("unroll") for (int ks = 0; ks < 4; ++ks) { vl[ks] = vtr(vp_ + d0 * 4096 + ks * 1024); vh[ks] = vtr(vp_ + d0 * 4096 + ks * 1024 + 512); } \
            _Pragma("unroll") for (int ks = 0; ks < 4; ++ks) o[d0] = __builtin_amdgcn_mfma_f32_32x32x16_bf16(__builtin_bit_cast(bf16x8, pw[ks]), \
                (bf16x8){vl[ks][0], vl[ks][1], vl[ks][2], vl[ks][3], vh[ks][0], vh[ks][1], vh[ks][2], vh[ks][3]}, o[d0], 0, 0, 0); } \
        _Pragma("unroll") for (int ks = 0; ks < 4; ++ks) lacc = __builtin_amdgcn_mfma_f32_32x32x16_bf16(__builtin_bit_cast(bf16x8, pw[ks]), ones, lacc, 0, 0, 0);     \
        } while (0)
    bf16x8 ones; { _Pragma("unroll") for (int j = 0; j < 8; ++j) ones[j] = (short)0x3F80; } asm volatile("" : "+v"(ones));
#pragma unroll
    for (int round = R0; round < R1; ++round) {
        const int g = 2 * round + (wid >> 2), hh = kvh * 8 + g;
        if (round < R1 - 1) SW_LOADQ(qn, round + 1);
        const float B2 = qkb + mb[g];
        const float lsink = __builtin_amdgcn_exp2f(sinks[hh] * LOG2E - B2);
        f32x16 o[2], lacc;
#pragma unroll
        for (int r = 0; r < 16; ++r) { o[0][r] = 0.f; o[1][r] = 0.f; lacc[r] = lsink; }
        const ALDS float* tb = tbl + g * 384 + (255 + 32 * wq + r32 - 4 * hi);
        u32x4 pw[4];
        if (jt0 == 0) {
            f32x16 a0, a1, b0, b1;
            SW_SCORES(a0, a1, jbase); SW_SCORES(b0, b1, jbase + 1);
            SW_SOFT(a0, a1); SW_PV(jbase);
            SW_SCORES(a0, a1, jbase + 2);
            SW_SOFT(b0, b1); SW_PV(jbase + 1);
            SW_SOFT(a0, a1); SW_PV(jbase + 2);
        } else {
#pragma unroll
            for (int k = 0; k < 3; ++k) { const int jt = jbase + k;
                if (jt >= jt0) { f32x16 a0, a1; SW_SCORES(a0, a1, jt); SW_SOFT(a0, a1); SW_PV(jt); } }
        }
        store_o2(o, lacc, (ALDS bf16_t*)(shm + SW_OST) + wid * 2048, O + (rowbase + q0 + 32 * wq) * DM + hh * 64, lane, r32, hi);
        if (round < R1 - 1) {
#pragma unroll
            for (int d0 = 0; d0 < 4; ++d0) qc[d0] = qn[d0];
        }
    }
#undef SW_SCORES
#undef SW_SOFT
#undef SW_PV
#undef SW_LOADQ
    ATT_LGKM_BAR();
}
#undef ALDS
}
#define GAS __attribute__((address_space(1)))
#define LAS __attribute__((address_space(3)))
typedef unsigned short bf16;
typedef unsigned v4u __attribute__((ext_vector_type(4)));
typedef float f32x4 __attribute__((ext_vector_type(4)));
typedef short bf16x8 __attribute__((ext_vector_type(8)));
typedef GAS unsigned gu32;
typedef GAS unsigned long long gu64;
#define RLX_AGENT __ATOMIC_RELAXED, __HIP_MEMORY_SCOPE_AGENT
#define LDS_WAIT() asm volatile("s_waitcnt lgkmcnt(0)" ::: "memory")
#define VM_WAIT() asm volatile("s_waitcnt vmcnt(0)" ::: "memory")
__device__ __forceinline__ unsigned long long rt() { return __builtin_amdgcn_s_memrealtime(); }
__device__ __forceinline__ unsigned f2bf(float f) { unsigned u = __builtin_bit_cast(unsigned, f); return (u + 0x7fffu + ((u >> 16) & 1u)) >> 16; }
__device__ __forceinline__ unsigned pk2(float lo, float hi) { return f2bf(lo) | (f2bf(hi) << 16); }

#define XB_TMO      128
#define XB_XCNT(j)  (256  + 64 * (j))
#define XB_XSUB(j)  (1280 + 64 * (j))
#define XB_XGEN(j)  (2304 + 64 * (j))
#define XB_TOP      3328
#define XB_TOPGEN   3392
#define XCD_BAR_WORDS 3456
#define XB_SPIN_CAP (1u << 18)

__device__ __forceinline__ unsigned xb_ld(unsigned* p)              { return __hip_atomic_load(p, __ATOMIC_RELAXED, __HIP_MEMORY_SCOPE_AGENT); }
__device__ __forceinline__ unsigned xb_add(unsigned* p, unsigned v) { return __hip_atomic_fetch_add(p, v, __ATOMIC_RELAXED, __HIP_MEMORY_SCOPE_AGENT); }
__device__ __forceinline__ unsigned xb_xcc_id() { return (unsigned)__builtin_amdgcn_s_getreg((3 << 11) | 20) & 0xFu; }
#define XB_SPIN(cond, bar) do { unsigned _sp = 0; while (cond) { __builtin_amdgcn_s_sleep(1); \
    if ((++_sp & 255u) == 0u) { if (xb_ld(&(bar)[XB_TMO])) break; if (_sp > XB_SPIN_CAP) { atomicAdd(&(bar)[XB_TMO], 1u); break; } } } } while (0)

struct XcdBarrier {
    unsigned* bar; unsigned x; unsigned G; bool nowb;
    volatile LAS unsigned* st;
};

__device__ __forceinline__ XcdBarrier xcd_barrier_post(unsigned* bar, volatile LAS unsigned* st, unsigned G) {
    XcdBarrier b; b.bar = bar; b.x = xb_xcc_id(); b.st = st; b.G = G; b.nowb = false;
    if (threadIdx.x == 0) (void)xb_add(&bar[XB_XCNT(b.x)], 1u);
    return b;
}
__device__ __forceinline__ void xcd_barrier_complete(unsigned* bar, unsigned x, unsigned G, unsigned& nloc, unsigned& nx) {
    unsigned sum, cnt, mine, sp = 0u;
    for (;;) {
        sum = 0u; cnt = 0u; mine = 0u;
#pragma unroll
        for (unsigned j = 0; j < 16; ++j) { const unsigned c = xb_ld(&bar[XB_XCNT(j)]); sum += c; cnt += (c > 0u) ? 1u : 0u; mine = (j == x) ? c : mine; }
        if (sum == G) break;
        __builtin_amdgcn_s_sleep(1);
        if ((++sp & 255u) == 0u) { if (xb_ld(&bar[XB_TMO])) break; if (sp > XB_SPIN_CAP) { atomicAdd(&bar[XB_TMO], 1u); break; } }
    }
    nloc = mine > 0u ? mine : 1u; nx = cnt > 0u ? cnt : 1u;
}

__device__ __forceinline__ void xcd_barrier(const XcdBarrier& b) {
    asm volatile("s_waitcnt vmcnt(0)" ::: "memory");
    __syncthreads();
    if (threadIdx.x == 0) {
        unsigned* bar = b.bar;
        __builtin_amdgcn_s_waitcnt(0);
        unsigned nloc = b.st[0], nx = b.st[1];
        if (nloc == 0u) { xcd_barrier_complete(bar, b.x, b.G, nloc, nx); b.st[0] = nloc; b.st[1] = nx; }
        const unsigned old = xb_add(&bar[XB_XSUB(b.x)], 1u);
        const unsigned gen = old / nloc;
        if (nx == 1u && b.G <= 32u) {
            const unsigned target = (gen + 1u) * nloc;
            XB_SPIN(xb_ld(&bar[XB_XSUB(b.x)]) < target, bar);
            __builtin_amdgcn_fence(__ATOMIC_ACQUIRE, "agent");
            asm volatile("s_waitcnt vmcnt(0)" ::: "memory");
        } else
        if (old + 1u == (gen + 1u) * nloc) {
            if ((nx > 1u || b.G > 32u) && !b.nowb) {
            __builtin_amdgcn_fence(__ATOMIC_RELEASE, "agent");
            asm volatile("s_waitcnt vmcnt(0)" ::: "memory");
            }
            const unsigned og = xb_add(&bar[XB_TOP], 1u);
            const unsigned tg = og / nx;
            if (og + 1u == (tg + 1u) * nx) xb_add(&bar[XB_TOPGEN], 1u);
            else XB_SPIN(xb_ld(&bar[XB_TOPGEN]) == tg, bar);
            __builtin_amdgcn_fence(__ATOMIC_ACQUIRE, "agent");
            xb_add(&bar[XB_XGEN(b.x)], 1u);
            asm volatile("s_waitcnt vmcnt(0)" ::: "memory");
        } else {
            XB_SPIN(xb_ld(&bar[XB_XGEN(b.x)]) == gen, bar);
            __builtin_amdgcn_fence(__ATOMIC_ACQUIRE, "agent");
            asm volatile("s_waitcnt vmcnt(0)" ::: "memory");
        }
    }
    __syncthreads();
}

constexpr int NWAVES = 8;
#ifndef MK_SPLIT
#define MK_SPLIT 0
#endif
constexpr int NPHASE = 11;
#ifndef MK_REP
#define MK_REP 0
#endif
#define REPN(k) (1 + ((MK_REP >> (k)) & 1))
#define DRYGEMM(k, g, S) do { if ((MK_REP >> (k)) & 1) { pg8::EpiDry Ed; pg8::gemm_phase<pg8::EpiDry, pg8::StaticOrder, PG8_ALIGN, PG8_SP2>(ring, g, S, Ed); } } while (0)
#ifndef PG8_SP2
#define PG8_SP2 true
#endif
#ifndef PG8_ALIGN
#define PG8_ALIGN true
#endif

constexpr int NBATCH = 8, SEQ = 2048, D = 1024, H = 16, HD = 64, FF = 4096, NIN = 3088, KVC = 256;
constexpr int M = NBATCH * SEQ;
constexpr int NQKV_A = 3 * D, NQKV_B = D + KVC;

constexpr size_t MiB = 1u << 20;
constexpr size_t WS_CTL = 0, CTL_ZERO_BYTES = 2 * MiB;
constexpr size_t WS_SS = 1536 * 1024;
constexpr size_t WS_WQKV_A = 2 * MiB, WS_WG = 8 * MiB, WS_WO_A = 9 * MiB, WS_WUP0 = 11 * MiB, WS_WDN0 = 19 * MiB, WS_WQKV_B = 27 * MiB, WS_WO_B = 30 * MiB, WS_WUP1 = 32 * MiB, WS_WDN1 = 40 * MiB;
constexpr size_t WS_KVB = 52 * MiB;
constexpr size_t WS_LOGF = 48 * MiB;
constexpr size_t WS_ACT = 64 * MiB;
constexpr size_t WS_H = 64 * MiB;
constexpr size_t WS_XN = 192 * MiB, WS_END = 224 * MiB;
static_assert(WS_SS + 4 * (size_t)M * 4 <= CTL_ZERO_BYTES && WS_WDN1 + (size_t)D * FF * 2 <= WS_LOGF && WS_LOGF + (size_t)NBATCH * H * SEQ * 4 <= WS_KVB && WS_KVB + (size_t)M * KVC * 2 <= WS_ACT && WS_H == WS_ACT && WS_H + (size_t)M * FF * 2 <= WS_XN && WS_XN + (size_t)M * D * 2 <= WS_END, "d_ws map");
constexpr int CW_CONV = 2048, CW_CONV_B = 2112, CW_CONV_0 = 2176;
constexpr int CW_KVD = 2304, CW_QD = 3328;
static_assert(CW_KVD + 16 * 64 <= CW_QD && CW_QD + 4 * 64 <= 4096, "flag words below the barrier regions");
constexpr int CW_BAR = 4096;
static_assert((size_t)(CW_BAR + 73 * 3456) * 4 <= WS_SS, "barrier regions below the ss accumulators");

constexpr int RING_OFF = 0, RING_BYTES = 131072;
constexpr int LDSCTL_OFF = RING_BYTES, MISC_OFF = LDSCTL_OFF + 320;
constexpr int EPI_RR_OFF = LDSCTL_OFF + 1024, EPI_G_OFF = LDSCTL_OFF + 2048;
constexpr int LDS_BYTES = 147456;
static_assert(att::FX_END <= RING_BYTES && att::SW_END <= RING_BYTES, "attention LDS maps fit the ring region");

struct Frame {
    LAS unsigned char* lds;
    volatile LAS unsigned* MISC;
    gu32* ctl;
    int tid, lane, wave;
    int vcu, G;
};
struct Args { const float* in[18]; float* out; unsigned char* ws; int ph_lo, ph_hi; };
#define A_x        (A.in[0])
#define A_g_attn   (A.in[1])
#define A_g_mlp    (A.in[2])
#define A_w_in_a   (A.in[3])
#define A_b_f      (A.in[4])
#define A_gq_a     (A.in[5])
#define A_gk_a     (A.in[6])
#define A_w_out_a  (A.in[7])
#define A_g_kv     (A.in[8])
#define A_w_kv     (A.in[9])
#define A_gk_b     (A.in[10])
#define A_w_q_b    (A.in[11])
#define A_gq_b     (A.in[12])
#define A_sinks    (A.in[13])
#define A_rel_bias (A.in[14])
#define A_w_out_b  (A.in[15])
#define A_w_up     (A.in[16])
#define A_w_down   (A.in[17])
#define WSB(off)   ((bf16*)(A.ws + (off)))
#define WSF(off)   ((float*)(A.ws + (off)))

__device__ __forceinline__ float wave_sum(float v) {
    v += __builtin_bit_cast(float, __builtin_amdgcn_update_dpp(0, __builtin_bit_cast(int, v), 0xB1, 0xF, 0xF, true));
    v += __builtin_bit_cast(float, __builtin_amdgcn_update_dpp(0, __builtin_bit_cast(int, v), 0x4E, 0xF, 0xF, true));
    v += __builtin_bit_cast(float, __builtin_amdgcn_update_dpp(0, __builtin_bit_cast(int, v), 0x141, 0xF, 0xF, true));
    v += __builtin_bit_cast(float, __builtin_amdgcn_update_dpp(0, __builtin_bit_cast(int, v), 0x140, 0xF, 0xF, true));
    { auto r = __builtin_amdgcn_permlane16_swap(__float_as_uint(v), __float_as_uint(v), false, false); v = __uint_as_float(r[0]) + __uint_as_float(r[1]); }
    { auto r = __builtin_amdgcn_permlane32_swap(__float_as_uint(v), __float_as_uint(v), false, false); v = __uint_as_float(r[0]) + __uint_as_float(r[1]); }
    return v;
}
__device__ __forceinline__ float wave_max(float v) {
#pragma unroll
    for (int o = 1; o < 64; o <<= 1) v = fmaxf(v, __shfl_xor(v, o));
    return v;
}
__device__ __forceinline__ int headperm(int n) { return (n & ~255) + 128 * ((n >> 5) & 1) + 32 * ((n >> 6) & 3) + (n & 31); }
template <bool WT_SC1 = false>
__device__ __forceinline__ void p0_transpose_item(const float* W, int ldw, int coff, int K, int N, bf16* WT, int perm, int row_off, const float* g, LAS float* scr, int item, int lane) {
    const int nblk = N / 32, kb = item / nblk, nb = item % nblk, k0 = 64 * kb, n0 = 32 * nb;
    float wv[32];
#pragma unroll
    for (int i = 0; i < 32; ++i) wv[i] = __builtin_nontemporal_load(W + (size_t)(k0 + 2 * i + (lane >> 5)) * ldw + coff + n0 + (lane & 31));
    if (g) {
#pragma unroll
        for (int i = 0; i < 32; ++i) wv[i] *= g[k0 + 2 * i + (lane >> 5)];
    }
#pragma unroll
    for (int i = 0; i < 32; ++i) scr[(2 * i + (lane >> 5)) * 33 + (lane & 31)] = wv[i];
    LDS_WAIT(); asm volatile("" ::: "memory");
    const int c = lane & 7;
#pragma unroll
    for (int j = 0; j < 4; ++j) { const int n = (lane >> 3) + 8 * j; const LAS float* s = scr + (8 * c) * 33 + n;
        v4u o; o.x = pk2(s[0 * 33], s[1 * 33]); o.y = pk2(s[2 * 33], s[3 * 33]); o.z = pk2(s[4 * 33], s[5 * 33]); o.w = pk2(s[6 * 33], s[7 * 33]);
        const int orow = row_off + (perm ? headperm(n0 + n) : (n0 + n));
        if constexpr (WT_SC1) { const __amdgpu_buffer_rsrc_t rs = __builtin_amdgcn_make_buffer_rsrc((void*)WT, 0, 0x7fffffff, 0x00020000);
            __builtin_amdgcn_raw_buffer_store_b128(o, rs, (int)(((size_t)orow * K + k0 + 8 * c) * 2), 0, 16); }
        else *(GAS v4u*)(WT + (size_t)orow * K + k0 + 8 * c) = o; }
    LDS_WAIT(); asm volatile("" ::: "memory");
}
template <int NR> __device__ __forceinline__ void rows_to_bf16(Frame& F, const float* x, bf16* xn, float* ss0, int m0, int stride) {
    f32x4 v[NR][4];
#pragma unroll
    for (int r = 0; r < NR; ++r) { const GAS f32x4* xr = (const GAS f32x4*)(x + (size_t)(m0 + r * stride) * D) + F.lane;
#pragma unroll
        for (int j = 0; j < 4; ++j) v[r][j] = __builtin_nontemporal_load(xr + 64 * j); }
#pragma unroll
    for (int r = 0; r < NR; ++r) { float s = 0.f;
#pragma unroll
        for (int j = 0; j < 4; ++j) s += (v[r][j].x * v[r][j].x + v[r][j].y * v[r][j].y) + (v[r][j].z * v[r][j].z + v[r][j].w * v[r][j].w);
        s = wave_sum(s);
        if (F.lane == 0) ss0[m0 + r * stride] = s;
        GAS unsigned long long* o8 = (GAS unsigned long long*)(xn + (size_t)(m0 + r * stride) * D) + F.lane;
#pragma unroll
        for (int j = 0; j < 4; ++j) o8[64 * j] = (unsigned long long)pk2(v[r][j].x, v[r][j].y) | ((unsigned long long)pk2(v[r][j].z, v[r][j].w) << 32); }
}
constexpr int P0_I1 = (D / 64) * (D / 32), P0_I2 = (D / 64) * (FF / 32), P0_I3 = (FF / 64) * (D / 32), P0_I5 = (D / 64) * (KVC / 32);
constexpr int P0_NLATE = 3 * P0_I1 + 2 * P0_I2 + 2 * P0_I3 + P0_I5, P0_NLATE_A = P0_I1 + P0_I2 + P0_I3;
#ifndef MK_EARLY
#define MK_EARLY 0
#endif
constexpr int P0_EARLY = MK_EARLY;
static_assert(P0_EARLY == 0, "early items: not with the two-part late list");
__device__ __forceinline__ void p0_late_item(Frame& F, const Args& A, LAS float* scr, int r) {
    const float* W; const float* g = nullptr; int ldw, K, N, perm = 0, row_off = 0; size_t wt;
    if (r < P0_I1) { W = A_w_out_a; ldw = D; K = D; N = D; wt = WS_WO_A; }
    else if ((r -= P0_I1) < P0_I2) { W = A_w_up; ldw = FF; K = D; N = FF; wt = WS_WUP0; g = A_g_mlp; }
    else if ((r -= P0_I2) < P0_I3) { W = A_w_down; ldw = D; K = FF; N = D; wt = WS_WDN0; }
    else if ((r -= P0_I3) < P0_I1) { W = A_w_q_b; ldw = D; K = D; N = D; wt = WS_WQKV_B; perm = 1; g = A_g_attn + D; }
    else if ((r -= P0_I1) < P0_I5) { W = A_w_kv; ldw = KVC; K = D; N = KVC; wt = WS_WQKV_B; perm = 1; row_off = D; g = A_g_kv; }
    else if ((r -= P0_I5) < P0_I1) { W = A_w_out_b; ldw = D; K = D; N = D; wt = WS_WO_B; }
    else if ((r -= P0_I1) < P0_I2) { W = A_w_up + (size_t)D * FF; ldw = FF; K = D; N = FF; wt = WS_WUP1; g = A_g_mlp + D; }
    else { r -= P0_I2; W = A_w_down + (size_t)FF * D; ldw = D; K = FF; N = D; wt = WS_WDN1; }
    p0_transpose_item<true>(W, ldw, 0, K, N, WSB(wt), perm, row_off, g, scr, r, F.lane);
}
__device__ __forceinline__ void p0_prologue(Frame& F, const Args& A, bool late) {
    LAS float* scr = (LAS float*)(F.lds + RING_OFF + F.wave * 16384);
    const int gw = F.vcu * NWAVES + F.wave, NGW = F.G * NWAVES;
    constexpr int I0 = (D / 64) * (NQKV_A / 32);
    for (int it = gw; it < I0; it += NGW) p0_transpose_item<true>(A_w_in_a, NIN, 0, D, NQKV_A, WSB(WS_WQKV_A), 1, 0, A_g_attn, scr, it, F.lane);
    for (int it = gw; it < (late ? P0_NLATE : P0_EARLY); it += NGW) p0_late_item(F, A, scr, it);
    for (int e = (F.vcu * NWAVES + F.wave) * 64 + F.lane; e < 16 * D; e += F.G * NWAVES * 64) { const int n = e >> 10, k = e & 1023; __hip_atomic_store(WSB(WS_WG) + e, (bf16)f2bf(A_w_in_a[(size_t)k * NIN + 3 * D + n] * A_g_attn[k]), __ATOMIC_RELAXED, __HIP_MEMORY_SCOPE_AGENT); }
    if (late) for (int m = gw; m < M; m += NGW) rows_to_bf16<1>(F, A_x, WSB(WS_XN), WSF(WS_SS) + 3 * M, m, NGW);
}
__device__ __forceinline__ void p0_rows(Frame& F, const Args& A, int blk) {
    const int m0 = 64 * blk + F.wave;
    rows_to_bf16<4>(F, A_x, WSB(WS_XN), WSF(WS_SS) + 3 * M, m0, 8);
    rows_to_bf16<4>(F, A_x, WSB(WS_XN), WSF(WS_SS) + 3 * M, m0 + 32, 8);
}
#ifndef MK_SLOTS
#define MK_SLOTS 1
#endif
__device__ __forceinline__ int slot_of(int part, int b) {
#if MK_SLOTS == 0
    return part == 0 ? (b >= 4 ? 0 : 1) : 2 + b % 3;
#else
    return b < 4 ? 1 : 2;
#endif
}
__device__ __forceinline__ void copy_slot(Frame& F, const Args& A, int slot, int bb) {
    constexpr int NA = P0_NLATE_A, NB = P0_NLATE - P0_NLATE_A; static_assert(NA % 8 == 0 && NB % 8 == 0, "even eighths");
#pragma unroll 1
    for (int part = 0; part < 2; ++part) {
        if (slot_of(part, bb) != slot) continue;
        const int lo = part == 0 ? (NA / 8) * bb : NA + (NB / 8) * bb, hi = lo + (part == 0 ? NA / 8 : NB / 8);
        __syncthreads();
        LAS float* scr = (LAS float*)(F.lds + RING_OFF + F.wave * 16384);
        for (int it = lo + (F.vcu & 31) * NWAVES + F.wave; it < hi; it += 32 * NWAVES) p0_late_item(F, A, scr, it);
        asm volatile("s_waitcnt vmcnt(0)" ::: "memory"); __syncthreads();
        if (F.tid == 0) __hip_atomic_fetch_add((unsigned*)(F.ctl + (part == 0 ? CW_CONV : CW_CONV_B)), 1u, __ATOMIC_RELAXED, __HIP_MEMORY_SCOPE_AGENT);
    }
}
__device__ __forceinline__ void gate_job(Frame& F, const Args& A, int blk0) {
    const int lane = F.lane, fr = lane & 15, fq = lane >> 4, rg = F.wave & 3, kh = F.wave >> 2;
    for (int blk = blk0; blk < M / 64; blk += F.G) {
        const int row0 = 64 * blk + 16 * rg;
        const bf16* arow = WSB(WS_XN) + (size_t)(row0 + fr) * D + kh * 512 + 8 * fq;
        const bf16* brow = WSB(WS_WG) + (size_t)fr * D + kh * 512 + 8 * fq;
        f32x4 acc = (f32x4){0.f, 0.f, 0.f, 0.f};
#pragma unroll 8
        for (int kk = 0; kk < 16; ++kk) { const bf16x8 a = *(const bf16x8*)(arow + 32 * kk), b = *(const bf16x8*)(brow + 32 * kk); acc = __builtin_amdgcn_mfma_f32_16x16x32_bf16(a, b, acc, 0, 0, 0); }
        LAS f32x4* scr = (LAS f32x4*)(F.lds + RING_OFF) + rg * 64 + lane;
        if (kh == 1) *scr = acc;
        __syncthreads();
        if (kh == 0) { const f32x4 o = *scr; acc += o;
            const float bias = A_b_f[fr];
#pragma unroll
            for (int i = 0; i < 4; ++i) { const float rr = rsqrtf(WSF(WS_SS)[3 * M + row0 + 4 * fq + i] * (1.f / D) + 1e-6f); const float z = acc[i] * rr + bias; const float lf = fminf(z, 0.f) - log1pf(expf(-fabsf(z)));
                const int tok = row0 + 4 * fq + i, bb = tok >> 11, t = tok & (SEQ - 1);
                WSF(WS_LOGF)[(size_t)(bb * H + fr) * SEQ + t] = lf * 1.4426950408889634f; } }
        __syncthreads();
    }
}

__global__ void __launch_bounds__(NWAVES * 64, 2) yoco_fwd(Args A) {
    extern __shared__ __attribute__((aligned(16))) unsigned char lds[];
    Frame F;
    F.lds = (LAS unsigned char*)lds;
    F.MISC = (volatile LAS unsigned*)(F.lds + MISC_OFF);
    F.tid = threadIdx.x; F.lane = F.tid & 63; F.wave = __builtin_amdgcn_readfirstlane(F.tid >> 6);
    F.G = gridDim.x; { const int bx = blockIdx.x; F.vcu = (F.G % 8 == 0) ? (bx % 8) * (F.G / 8) + bx / 8 : bx; }
    F.ctl = (gu32*)(A.ws + WS_CTL);
    for (int u = F.tid; u < (LDS_BYTES - LDSCTL_OFF) / 4; u += NWAVES * 64) ((LAS unsigned*)(F.lds + LDSCTL_OFF))[u] = 0u;
    __syncthreads();
    const int lo = A.ph_lo, hi = A.ph_hi;
    const bool use_bar = (hi - lo) > 1;
    XcdBarrier bar; bar.bar = (unsigned*)(F.ctl + CW_BAR); bar.x = 0; bar.st = nullptr;
    if (use_bar) { bar = xcd_barrier_post((unsigned*)(F.ctl + CW_BAR), F.MISC + 8, (unsigned)F.G); bar.nowb = (F.G == 256); }
    const int bb = (int)(blockIdx.x & 7); const bool batch_sets = (F.G == 256);
    XcdBarrier sbar = bar;
    if (use_bar && batch_sets) sbar = xcd_barrier_post((unsigned*)(F.ctl + CW_BAR) + (1 + bb) * XCD_BAR_WORDS, F.MISC + 10, 32u);
    const int gj = (int)((blockIdx.x >> 3) & 7), gm = (int)(blockIdx.x >> 6);
    XcdBarrier gbar = sbar;
    if (use_bar && batch_sets) gbar = xcd_barrier_post((unsigned*)(F.ctl + CW_BAR) + (9 + bb * 8 + gj) * XCD_BAR_WORDS, F.MISC + 12, 4u);
    unsigned char* const pnl = A.ws + WS_ACT + (size_t)bb * (16 * MiB) + (size_t)gj * (2 * MiB);
    const size_t rp0 = (size_t)(8 * bb + gj) * 256 * 2048;
    bf16* const ACT_Q = (bf16*)(pnl - rp0); bf16* const ACT_OA = (bf16*)(pnl + 3 * 512 * 1024 - rp0);
    bf16* const ACT_QB = ACT_Q; bf16* const ACT_OB = ACT_Q;
    bf16* const ACT_KVB = WSB(WS_KVB);
    bf16* const ACT_PB = (bf16*)(A.ws + WS_ACT + (size_t)bb * (16 * MiB));
#define IN(k) (lo <= (k) && (k) < hi)
#define SEAM1(k) do { if ((k) == 0) xcd_barrier(bar); else if ((k) == 1 || (k) == 2 || (k) == 6) xcd_barrier(sbar); else xcd_barrier(gbar); } while (0)
#define SEAM(k) do { if (IN(k) && IN((k) + 1)) { SEAM1(k); if ((MK_REP >> 11) & 1) SEAM1(k); } } while (0)
    float* ss1 = WSF(WS_SS); float* ss2 = WSF(WS_SS) + M; float* ss3 = WSF(WS_SS) + 2 * M; float* ss0 = WSF(WS_SS) + 3 * M;
    LAS unsigned char* ring = F.lds + RING_OFF;
    LAS float* const epi_rr = (LAS float*)(F.lds + EPI_RR_OFF); LAS float* const epi_g = (LAS float*)(F.lds + EPI_G_OFF);
    const int my_pm = 8 * bb + gj;
#define STAGE_RR(ssp) do { if (F.tid < 256) epi_rr[F.tid] = rsqrtf((ssp)[my_pm * 256 + F.tid] * (1.f / 1024.f) + 1e-6f); } while (0)
#define STAGE_G(gq_, gk_) do { if (F.tid < 64) epi_g[F.tid] = (gq_)[F.tid] * (gk_)[F.tid] * pg8::QK_C2; } while (0)

    if (IN(0)) { for (int rep = 0; rep < REPN(0); ++rep) p0_prologue(F, A, !(use_bar && batch_sets)); }
    if (use_bar && batch_sets) {
        asm volatile("s_waitcnt vmcnt(0)" ::: "memory"); __syncthreads();
        if (F.tid == 0) __hip_atomic_fetch_add((unsigned*)(F.ctl + CW_CONV_0), 1u, __ATOMIC_RELAXED, __HIP_MEMORY_SCOPE_AGENT);
        p0_rows(F, A, 4 * (8 * bb + gj) + gm);
        copy_slot(F, A, 0, bb);
        asm volatile("s_waitcnt vmcnt(0)" ::: "memory"); __syncthreads();
        if (F.tid == 0) { unsigned sp = 0; while (__hip_atomic_load((unsigned*)(F.ctl + CW_CONV_0), __ATOMIC_RELAXED, __HIP_MEMORY_SCOPE_AGENT) < 256u) { __builtin_amdgcn_s_sleep(2); if (++sp > (1u << 22)) break; } }
        xcd_barrier(gbar);
    } else SEAM(0);
    if (IN(1)) {
        STAGE_RR(ss0); STAGE_G(A_gq_a, A_gk_a);
        gate_job(F, A, (use_bar && batch_sets) ? 4 * (8 * bb + gj) + gm : F.vcu);
        pg8::Gemm g{WSB(WS_XN), WSB(WS_WQKV_A), M, NQKV_A, D}; pg8::StaticOrder S; S.init(M, NQKV_A, F.G, (int)blockIdx.x);
        pg8::EpiHead E{ACT_Q, (size_t)(512 * 1024) / 2, nullptr, epi_g, epi_rr, 0};
        DRYGEMM(1, g, S);
        if ((MK_REP >> 13) & 1) { gate_job(F, A, (use_bar && batch_sets) ? 4 * (8 * bb + gj) + gm : F.vcu); pg8::gemm_phase<pg8::EpiHead, pg8::StaticOrder, PG8_ALIGN, PG8_SP2>(ring, g, S, E); }
        pg8::gemm_phase<pg8::EpiHead, pg8::StaticOrder, PG8_ALIGN, PG8_SP2>(ring, g, S, E);
        if (use_bar && batch_sets) copy_slot(F, A, 1, bb);
    } SEAM(1);
    if (IN(2)) {
        int ln = F.lane; asm volatile("" : "+v"(ln));
        const float gqm = wave_max(fabsf(A_gq_a[ln])), gkm = wave_max(fabsf(A_gk_a[ln]));
        const float nB2 = -(8.f * gqm * gkm * 1.01f * att::LOG2E);
        for (int rep = 0; rep < REPN(2); ++rep)
        for (int c = F.vcu; c < 256; c += F.G) {
            const int bh = c >> 1, s = c & 1;
            att::fox_prepare(bh >> 4, bh & 15, WSF(WS_LOGF), (att::lds_ptr)ring);
            att::fox_cu(bh & 15, s, ACT_PB, (att::lds_ptr)ring, nB2);
        }
    }
    if (IN(2) && use_bar && batch_sets) copy_slot(F, A, 2, bb);
    if (IN(2) && IN(3) && use_bar && batch_sets) {
        if (F.tid == 0) { unsigned sp = 0; while (__hip_atomic_load((unsigned*)(F.ctl + CW_CONV), __ATOMIC_RELAXED, __HIP_MEMORY_SCOPE_AGENT) < 256u) { __builtin_amdgcn_s_sleep(2); if (++sp > (1u << 22)) break; } }
    }
    SEAM(2);
    if (IN(3)) {
        pg8::Gemm g{ACT_OA, WSB(WS_WO_A), M, D, D}; pg8::StaticOrder S; S.init(M, D, F.G, (int)blockIdx.x);
        pg8::EpiResid<1> E{nullptr, WSB(WS_XN), nullptr, ss1, nullptr};
        DRYGEMM(3, g, S);
        pg8::gemm_phase<pg8::EpiResid<1>, pg8::StaticOrder, PG8_ALIGN, PG8_SP2>(ring, g, S, E);
        if (use_bar && batch_sets) copy_slot(F, A, 3, bb);
    } SEAM(3);
    if (IN(4)) {
        pg8::Gemm g{WSB(WS_XN), WSB(WS_WUP0), M, FF, D}; pg8::StaticOrder S; S.init(M, FF, F.G, (int)blockIdx.x);
        STAGE_RR(ss1); __syncthreads();
        pg8::EpiAct E{WSB(WS_H), FF};
        DRYGEMM(4, g, S);
        if ((MK_REP >> 12) & 1) pg8::gemm_phase<pg8::EpiAct, pg8::StaticOrder, PG8_ALIGN, PG8_SP2>(ring, g, S, E);
        pg8::gemm_phase<pg8::EpiAct, pg8::StaticOrder, PG8_ALIGN, PG8_SP2>(ring, g, S, E);
        if (use_bar && batch_sets) copy_slot(F, A, 4, bb);
    } SEAM(4);
    if (IN(5)) {
        pg8::Gemm g{WSB(WS_H), WSB(WS_WDN0), M, D, FF}; pg8::StaticOrder S; S.init(M, D, F.G, (int)blockIdx.x);
        if (!use_bar) { STAGE_RR(ss1); __syncthreads(); }
        pg8::EpiResid<1, true> E{nullptr, WSB(WS_XN), nullptr, ss2, epi_rr};
        DRYGEMM(5, g, S);
        pg8::gemm_phase<pg8::EpiResid<1, true>, pg8::StaticOrder, PG8_ALIGN, PG8_SP2>(ring, g, S, E);
    }
    if (IN(5) && IN(6) && use_bar && batch_sets) {
        if (F.tid == 0) { unsigned sp = 0; while (__hip_atomic_load((unsigned*)(F.ctl + CW_CONV_B), __ATOMIC_RELAXED, __HIP_MEMORY_SCOPE_AGENT) < 256u) { __builtin_amdgcn_s_sleep(2); if (++sp > (1u << 22)) break; } }
    }
    SEAM(5);
    if (IN(6) && IN(7) && use_bar && batch_sets) {
        {
            pg8::Gemm g{WSB(WS_XN), WSB(WS_WQKV_B), M, NQKV_B, D};
            STAGE_RR(ss2); STAGE_G(A_gq_b, A_gk_b); __syncthreads();
            pg8::EpiHead E{ACT_QB, 0, ACT_KVB, epi_g, epi_rr, 1};
            struct KvFirst { int pm, gm; gu32* flag; bool rel;
                __device__ bool next(int i, pg8::Unit& u) const { if (i > (gm == 0 ? 1 : 0)) return false; u.pm = pm; u.pn = (gm == 0) ? (i == 0 ? 4 : 0) : gm; return true; }
                __device__ __forceinline__ void a_ready(const pg8::Unit&) const {}
                __device__ __forceinline__ void done(const pg8::Unit& u) const {
                    if (u.pn == 4) { asm volatile("s_waitcnt vmcnt(0)" ::: "memory"); __syncthreads();
                        if (threadIdx.x == 0) { if (rel) { __builtin_amdgcn_fence(__ATOMIC_RELEASE, "agent"); asm volatile("s_waitcnt vmcnt(0)" ::: "memory"); }
                            __hip_atomic_fetch_add((unsigned*)flag, 1u, __ATOMIC_RELAXED, __HIP_MEMORY_SCOPE_AGENT); } } }
            } S{my_pm, gm, F.ctl + CW_KVD + 16 * my_pm, sbar.st[1] > 1u};
            pg8::gemm_phase<pg8::EpiHead, KvFirst, PG8_ALIGN, PG8_SP2>(ring, g, S, E);
            if (F.tid == 0) { if (sbar.st[1] > 1u) { __builtin_amdgcn_fence(__ATOMIC_RELEASE, "agent"); asm volatile("s_waitcnt vmcnt(0)" ::: "memory"); }
                __hip_atomic_fetch_add((unsigned*)(F.ctl + CW_QD + 4 * my_pm + gm), 1u, __ATOMIC_RELAXED, __HIP_MEMORY_SCOPE_AGENT); }
        }
        int ln = F.lane; asm volatile("" : "+v"(ln));
        const float gqm = wave_max(fabsf(A_gq_b[ln])), gkm = wave_max(fabsf(A_gk_b[ln]));
        const float qkb = 8.f * gqm * gkm * 1.01f * att::LOG2E;
#define WAITF(w_) do { unsigned sp_ = 0; while (__hip_atomic_load((unsigned*)(F.ctl + (w_)), __ATOMIC_RELAXED, __HIP_MEMORY_SCOPE_AGENT) < 1u) { __builtin_amdgcn_s_sleep(1); if (++sp_ > (1u << 22)) break; } } while (0)
#define ACQ() do { __builtin_amdgcn_fence(__ATOMIC_ACQUIRE, "agent"); asm volatile("s_waitcnt vmcnt(0)" ::: "memory"); } while (0)
        if (gm >= 2) {
            if (F.tid == 0) { WAITF(CW_KVD + 16 * my_pm); if (gj > 0 && gm == 2) WAITF(CW_KVD + 16 * (my_pm - 1)); WAITF(CW_QD + 4 * my_pm + 2); WAITF(CW_QD + 4 * my_pm + 3); ACQ(); }
            __syncthreads();
            att::swa_unit<0, 4>(bb, 1, 2 * gj + (gm & 1), ACT_QB, ACT_KVB, ACT_OB, A_sinks, A_rel_bias, (att::lds_ptr)ring, qkb);
        } else if (gm == 1) {
            if (F.tid == 0) { WAITF(CW_KVD + 16 * my_pm); if (gj > 0) WAITF(CW_KVD + 16 * (my_pm - 1)); WAITF(CW_QD + 4 * my_pm + 1); ACQ(); }
            __syncthreads();
#pragma unroll 1
            for (int qh = 0; qh < 2; ++qh) att::swa_unit<2, 4>(bb, 0, 2 * gj + qh, ACT_QB, ACT_KVB, ACT_OB, A_sinks, A_rel_bias, (att::lds_ptr)ring, qkb);
        }
        if (gm == 0 || gm == 2) {
            if (F.tid == 0) { WAITF(CW_KVD + 16 * my_pm); if (gj > 0 && gm == 0) WAITF(CW_KVD + 16 * (my_pm - 1)); WAITF(CW_QD + 4 * my_pm + 0); ACQ(); }
            __syncthreads();
            att::swa_unit<0, 2>(bb, 0, 2 * gj + (gm >> 1), ACT_QB, ACT_KVB, ACT_OB, A_sinks, A_rel_bias, (att::lds_ptr)ring, qkb);
        }
#undef WAITF
#undef ACQ
        xcd_barrier(gbar);
    } else {
    if (IN(6)) {
        pg8::Gemm g{WSB(WS_XN), WSB(WS_WQKV_B), M, NQKV_B, D}; pg8::StaticOrder S; S.init(M, NQKV_B, F.G, (int)blockIdx.x);
        STAGE_RR(ss2); STAGE_G(A_gq_b, A_gk_b); __syncthreads();
        pg8::EpiHead E{ACT_QB, 0, ACT_KVB, epi_g, epi_rr, 1};
        pg8::gemm_phase<pg8::EpiHead, pg8::StaticOrder, PG8_ALIGN, PG8_SP2>(ring, g, S, E);
    } SEAM(6);
    if (IN(7)) {
        int ln = F.lane; asm volatile("" : "+v"(ln));
        const float gqm = wave_max(fabsf(A_gq_b[ln])), gkm = wave_max(fabsf(A_gk_b[ln]));
        const float qkb = 8.f * gqm * gkm * 1.01f * att::LOG2E;
        att::swa_unit<0, 4>(bb, gm >> 1, 2 * gj + (gm & 1), ACT_QB, ACT_KVB, ACT_OB, A_sinks, A_rel_bias, (att::lds_ptr)ring, qkb);
    } SEAM(7);
    }
    if (IN(8)) {
        pg8::Gemm g{ACT_OB, WSB(WS_WO_B), M, D, D}; pg8::StaticOrder S; S.init(M, D, F.G, (int)blockIdx.x);
        pg8::EpiResid<1> E{nullptr, WSB(WS_XN), nullptr, ss3, nullptr};
        DRYGEMM(8, g, S);
        pg8::gemm_phase<pg8::EpiResid<1>, pg8::StaticOrder, PG8_ALIGN, PG8_SP2>(ring, g, S, E);
    } SEAM(8);
    if (IN(9)) {
        pg8::Gemm g{WSB(WS_XN), WSB(WS_WUP1), M, FF, D}; pg8::StaticOrder S; S.init(M, FF, F.G, (int)blockIdx.x);
        STAGE_RR(ss3); __syncthreads();
        pg8::EpiAct E{WSB(WS_H), FF};
        DRYGEMM(9, g, S);
        pg8::gemm_phase<pg8::EpiAct, pg8::StaticOrder, PG8_ALIGN, PG8_SP2>(ring, g, S, E);
    } SEAM(9);
    if (IN(10)) {
        pg8::Gemm g{WSB(WS_H), WSB(WS_WDN1), M, D, FF}; pg8::StaticOrder S; S.init(M, D, F.G, (int)blockIdx.x);
        if (!use_bar) { STAGE_RR(ss3); __syncthreads(); }
        pg8::EpiResid<2, true> E{nullptr, WSB(WS_XN), A.out, nullptr, epi_rr};
        DRYGEMM(10, g, S);
        pg8::gemm_phase<pg8::EpiResid<2, true>, pg8::StaticOrder, PG8_ALIGN, PG8_SP2>(ring, g, S, E);
    }
#undef IN
#undef SEAM
}

extern "C" void kernel_launch(void* const* d_in, const int* in_sizes, int n_in, void* d_out, int out_size, void* d_ws, size_t ws_size, hipStream_t stream) {
    static int grid = 0;
    if (grid == 0) {
        if (n_in != 18 || in_sizes[0] != M * D || out_size != M * D || ws_size < WS_END) { fprintf(stderr, "kernel_launch: unexpected shapes (n_in %d, in0 %d, out %d, ws %zu); nothing launched\n", n_in, n_in > 0 ? in_sizes[0] : -1, out_size, ws_size); grid = -1; return; }
        int dev = 0, cus = 0, per_cu = 0;
        if (hipGetDevice(&dev) != hipSuccess || hipDeviceGetAttribute(&cus, hipDeviceAttributeMultiprocessorCount, dev) != hipSuccess) { grid = -1; return; }
        if (hipFuncSetAttribute((const void*)yoco_fwd, hipFuncAttributeMaxDynamicSharedMemorySize, LDS_BYTES) != hipSuccess) { fprintf(stderr, "kernel_launch: hipFuncSetAttribute failed\n"); grid = -1; return; }
        if (hipOccupancyMaxActiveBlocksPerMultiprocessor(&per_cu, (const void*)yoco_fwd, NWAVES * 64, LDS_BYTES) != hipSuccess || per_cu < 1)
            fprintf(stderr, "kernel_launch: note: occupancy query reports %d workgroups per CU\n", per_cu);
        (void)hipGetLastError();
        grid = cus;
        if (grid != 256) { fprintf(stderr, "kernel_launch: built for a 256-CU device (batch-set unit orders); found %d CUs; nothing launched\n", cus); grid = -1; return; }
    }
    if (grid < 0) return;
    if (hipMemsetAsync((char*)d_ws + WS_CTL, 0, CTL_ZERO_BYTES, stream) != hipSuccess) { fprintf(stderr, "kernel_launch: hipMemsetAsync failed\n"); return; }
    Args a{};
    for (int i = 0; i < 18; ++i) a.in[i] = (const float*)d_in[i];
    a.out = (float*)d_out; a.ws = (unsigned char*)d_ws;
#if MK_SPLIT
    for (int p = 0; p < NPHASE; ++p) { a.ph_lo = p; a.ph_hi = p + 1; hipLaunchKernelGGL(yoco_fwd, dim3(grid), dim3(NWAVES * 64), LDS_BYTES, stream, a); }
#else
    a.ph_lo = 0; a.ph_hi = NPHASE;
    hipLaunchKernelGGL(yoco_fwd, dim3(grid), dim3(NWAVES * 64), LDS_BYTES, stream, a);
#endif
    const hipError_t le = hipPeekAtLastError();
    if (le != hipSuccess) fprintf(stderr, "kernel_launch: launch failed: %s\n", hipGetErrorName(le));
}
```
